# Optimizing an MI355X kernel written in HIP

```python
import math
import numpy as np
import jax
import jax.numpy as jnp
from jax import lax

D_MODEL = 1024
BATCH = 16
SEQ = 2048
DEPTH = 1

NSA_HEADS = 8
NSA_KV_GROUPS = 2
NSA_REP = NSA_HEADS // NSA_KV_GROUPS
NSA_HD = 64
CMP_LEN = 32
CMP_STRIDE = 16
CMP_HIDDEN = 2 * NSA_HD
SEL_BLOCK = 64
SEL_TOPN = 8
SEL_FORCED_LOCAL = 2
WINDOW = 512
DIFF_HEADS = 8
DIFF_HD = 32
D_MIX = NSA_HEADS * NSA_HD + DIFF_HEADS * 2 * DIFF_HD
REL_BUCKETS = 32
REL_MAX_EXACT = 16
REL_MAX_DIST = 128
N_REL_HEADS = NSA_HEADS + DIFF_HEADS
Q_BLOCK = 128
SEL_Q_BLOCK = 64
MOE_GROUPS = 4
EXPERTS_PER_GROUP = 8
N_EXPERTS = MOE_GROUPS * EXPERTS_PER_GROUP
EXPERT_FF = 256
MOE_TOPK = 2
EPS = 1e-6
NEG = -1e30
NSA_Q = NSA_HEADS * NSA_HD
NSA_KV = NSA_KV_GROUPS * NSA_HD
NSA_GATE = NSA_HEADS * 3
DIFF_QK = DIFF_HEADS * 2 * DIFF_HD
DIFF_V = DIFF_HEADS * 2 * DIFF_HD
IN_SIZES = (NSA_Q, NSA_KV, NSA_KV, NSA_KV, NSA_KV, NSA_KV, NSA_KV, NSA_GATE, DIFF_QK, DIFF_QK, DIFF_V)
D_IN = sum(IN_SIZES)

kernel_name = 'hybrid_nsa_diffattn_hiermoe'


def rmsnorm(x, g):
    xf = x.astype(jnp.float32)
    y = xf * lax.rsqrt(jnp.mean(xf * xf, axis=-1, keepdims=True) + EPS)
    return (y * g.astype(jnp.float32)).astype(x.dtype)


def t5_bucket(dist):
    n = jnp.maximum(dist, 0)
    nf = jnp.maximum(n, 1).astype(jnp.float32)
    large = REL_MAX_EXACT + (jnp.log(nf / REL_MAX_EXACT) / math.log(REL_MAX_DIST / REL_MAX_EXACT)
                             * (REL_BUCKETS - REL_MAX_EXACT)).astype(jnp.int32)
    large = jnp.minimum(large, REL_BUCKETS - 1)
    return jnp.where(n < REL_MAX_EXACT, n, large)


def masked_softmax(s, mask):
    s = jnp.where(mask, s.astype(jnp.float32), NEG)
    p = jax.nn.softmax(s, axis=-1)
    return jnp.where(mask, p, 0.0)


def merge_blocks(out, axis):
    out = jnp.moveaxis(out, 0, axis)
    shp = out.shape
    return out.reshape(shp[:axis] + (shp[axis] * shp[axis + 1],) + shp[axis + 2:])


def nsa_mixer(q, kc, vc, ks, vs, kw, vw, gate_logits, tab_a, pos_k, pos_v, ck1, ck2, cv1, cv2):
    B, S, _ = q.shape
    G, R, hd = NSA_KV_GROUPS, NSA_REP, NSA_HD
    scale = hd ** -0.5
    tpos = jnp.arange(S, dtype=jnp.int32)
    tab = tab_a.reshape(REL_BUCKETS, G, R)
    q = q.reshape(B, S, G, R, hd).transpose(0, 2, 3, 1, 4)

    def kv_heads(t):
        return t.reshape(B, S, G, hd).transpose(0, 2, 1, 3)
    kc, vc, ks, vs, kw, vw = (kv_heads(t) for t in (kc, vc, ks, vs, kw, vw))

    n_cmp = (S - CMP_LEN) // CMP_STRIDE + 1
    starts = np.arange(n_cmp) * CMP_STRIDE
    blk_idx = starts[:, None] + np.arange(CMP_LEN)[None, :]

    def compress(t, pos, w1, w2):
        blocks = (t[:, :, blk_idx] + pos).reshape(B, G, n_cmp, CMP_LEN * hd)
        return jax.nn.gelu(blocks @ w1) @ w2
    k_cmp = compress(kc, pos_k, ck1, ck2)
    v_cmp = compress(vc, pos_v, cv1, cv2)
    cmp_end = jnp.asarray(starts + CMP_LEN - 1, dtype=jnp.int32)
    dist_c = tpos[:, None] - cmp_end[None, :]
    s_c = jnp.einsum('bgrtd,bgcd->bgrtc', q, k_cmp) * scale + tab[t5_bucket(dist_c)].transpose(2, 3, 0, 1)
    p_cmp = masked_softmax(s_c, dist_c >= 0)
    o_cmp = jnp.einsum('bgrtc,bgcd->bgrtd', p_cmp.astype(v_cmp.dtype), v_cmp)

    n_sel = S // SEL_BLOCK
    sel_start = np.arange(n_sel) * SEL_BLOCK
    overlap = ((starts[:, None] <= sel_start[None, :] + SEL_BLOCK - 1)
               & (starts[:, None] + CMP_LEN - 1 >= sel_start[None, :])).astype(np.float32)
    imp = jnp.einsum('bgrtc,cj->bgtj', p_cmp, jnp.asarray(overlap))
    blk = jnp.arange(n_sel, dtype=jnp.int32)[None, :]
    cur = (tpos // SEL_BLOCK)[:, None]
    valid = blk <= cur
    forced = (blk == 0) | ((cur - blk >= 0) & (cur - blk < SEL_FORCED_LOCAL))
    score = jnp.where(valid & forced, 1e9, jnp.where(valid, imp, -1e9))
    n_top = min(SEL_TOPN, n_sel)
    top_val, top_idx = lax.top_k(score, n_top)
    top_ok = top_val > -1e8

    ks_blk = ks.reshape(B, G, n_sel, SEL_BLOCK, hd)
    vs_blk = vs.reshape(B, G, n_sel, SEL_BLOCK, hd)
    bi = jnp.arange(B)[:, None, None, None]
    gi = jnp.arange(G)[None, :, None, None]
    tab_g = tab.transpose(1, 0, 2)

    def sel_block(c):
        t0 = c * SEL_Q_BLOCK
        qc = lax.dynamic_slice_in_dim(q, t0, SEL_Q_BLOCK, axis=3)
        ic = lax.dynamic_slice_in_dim(top_idx, t0, SEL_Q_BLOCK, axis=2)
        okc = lax.dynamic_slice_in_dim(top_ok, t0, SEL_Q_BLOCK, axis=2)
        kg = ks_blk[bi, gi, ic].reshape(B, G, SEL_Q_BLOCK, n_top * SEL_BLOCK, hd)
        vg = vs_blk[bi, gi, ic].reshape(B, G, SEL_Q_BLOCK, n_top * SEL_BLOCK, hd)
        kpos = (ic[..., None] * SEL_BLOCK + jnp.arange(SEL_BLOCK, dtype=jnp.int32)).reshape(
            B, G, SEL_Q_BLOCK, n_top * SEL_BLOCK)
        tq = t0 + jnp.arange(SEL_Q_BLOCK, dtype=jnp.int32)
        dist = tq[None, None, :, None] - kpos
        mask = jnp.repeat(okc, SEL_BLOCK, axis=-1) & (dist >= 0)
        bias = jnp.moveaxis(tab_g[gi, t5_bucket(dist)], -1, 2)
        s = jnp.einsum('bgrqd,bgqkd->bgrqk', qc, kg) * scale + bias
        p = masked_softmax(s, mask[:, :, None])
        return jnp.einsum('bgrqk,bgqkd->bgrqd', p.astype(vg.dtype), vg)
    o_slc = merge_blocks(lax.map(sel_block, jnp.arange(S // SEL_Q_BLOCK)), 3)

    pad = ((0, 0), (0, 0), (WINDOW, 0), (0, 0))
    kw_pad = jnp.pad(kw, pad)
    vw_pad = jnp.pad(vw, pad)
    span = Q_BLOCK + WINDOW

    def win_block(c):
        t0 = c * Q_BLOCK
        qc = lax.dynamic_slice_in_dim(q, t0, Q_BLOCK, axis=3)
        kb = lax.dynamic_slice_in_dim(kw_pad, t0, span, axis=2)
        vb = lax.dynamic_slice_in_dim(vw_pad, t0, span, axis=2)
        tq = t0 + jnp.arange(Q_BLOCK, dtype=jnp.int32)
        kpos = t0 - WINDOW + jnp.arange(span, dtype=jnp.int32)
        dist = tq[:, None] - kpos[None, :]
        mask = (kpos[None, :] >= 0) & (dist >= 0) & (dist < WINDOW)
        bias = tab[t5_bucket(dist)].transpose(2, 3, 0, 1)
        s = jnp.einsum('bgrqd,bgkd->bgrqk', qc, kb) * scale + bias
        p = masked_softmax(s, mask)
        return jnp.einsum('bgrqk,bgkd->bgrqd', p.astype(vb.dtype), vb)
    o_win = merge_blocks(lax.map(win_block, jnp.arange(S // Q_BLOCK)), 3)

    g = jax.nn.sigmoid(gate_logits.astype(jnp.float32)).astype(o_win.dtype)
    g = g.reshape(B, S, G, R, 3).transpose(0, 2, 3, 1, 4)
    o = g[..., 0:1] * o_cmp + g[..., 1:2] * o_slc + g[..., 2:3] * o_win
    return o.transpose(0, 3, 1, 2, 4).reshape(B, S, NSA_HEADS * hd)


def diff_mixer(q, k, v, tab_b, lq1, lk1, lq2, lk2, subln, lambda_init):
    B, S, _ = q.shape
    H, d = DIFF_HEADS, DIFF_HD
    scale = d ** -0.5
    q = q.reshape(B, S, H, 2, d).transpose(3, 0, 2, 1, 4)
    k = k.reshape(B, S, H, 2, d).transpose(3, 0, 2, 1, 4)
    v = v.reshape(B, S, H, 2 * d).transpose(0, 2, 1, 3)
    lam = (jnp.exp(jnp.sum((lq1 * lk1).astype(jnp.float32)))
           - jnp.exp(jnp.sum((lq2 * lk2).astype(jnp.float32))) + lambda_init)
    kpos = jnp.arange(S, dtype=jnp.int32)

    def blk(c):
        t0 = c * Q_BLOCK
        qc = lax.dynamic_slice_in_dim(q, t0, Q_BLOCK, axis=3)
        tq = t0 + jnp.arange(Q_BLOCK, dtype=jnp.int32)
        dist = tq[:, None] - kpos[None, :]
        bias = tab_b[t5_bucket(dist)].transpose(2, 0, 1)
        s = jnp.einsum('ibhqd,ibhkd->ibhqk', qc, k) * scale + bias
        p = masked_softmax(s, dist >= 0)
        a = p[0] - lam * p[1]
        return jnp.einsum('bhqk,bhkd->bhqd', a.astype(v.dtype), v)
    o = merge_blocks(lax.map(blk, jnp.arange(S // Q_BLOCK)), 2)
    o = rmsnorm(o, subln) * (1.0 - lambda_init)
    return o.transpose(0, 2, 1, 3).reshape(B, S, H * 2 * d)


def hier_moe(h, wg, bg, we, be, w_gate, w_up, w_down):
    B, S, D = h.shape
    t = h.reshape(B * S, D)
    T = t.shape[0]
    pg = jax.nn.softmax((t @ wg).astype(jnp.float32) + bg.astype(jnp.float32), axis=-1)
    g_prob, g_idx = lax.top_k(pg, 1)
    e_logit = ((t @ we).astype(jnp.float32) + be.astype(jnp.float32)).reshape(T, MOE_GROUPS, EXPERTS_PER_GROUP)
    e_in = jnp.take_along_axis(e_logit, g_idx[:, :, None], axis=1)[:, 0]
    pe = jax.nn.softmax(e_in, axis=-1)
    e_prob, e_idx = lax.top_k(pe, MOE_TOPK)
    w = g_prob * e_prob / jnp.sum(e_prob, axis=-1, keepdims=True)
    expert_id = g_idx * EXPERTS_PER_GROUP + e_idx
    combine = jnp.sum(jax.nn.one_hot(expert_id, N_EXPERTS, dtype=jnp.float32) * w[..., None], axis=1)
    combine = combine.astype(h.dtype)
    y = jnp.zeros_like(t)
    for gidx in range(MOE_GROUPS):
        sl = slice(gidx * EXPERTS_PER_GROUP, (gidx + 1) * EXPERTS_PER_GROUP)
        hg = jax.nn.silu(jnp.einsum('td,edf->tef', t, w_gate[sl])) * jnp.einsum('td,edf->tef', t, w_up[sl])
        y = y + jnp.einsum('tef,efd->td', hg * combine[:, sl, None], w_down[sl])
    return y.reshape(B, S, D)


def setup_inputs(seed: int = 0) -> dict:
    key = jax.random.key(seed)
    ks = jax.random.split(key, 32)

    def nrm(k, shape, scale):
        return jax.random.normal(k, shape, jnp.float32) * scale

    def gain(k, shape):
        return 1.0 + 0.01 * jax.random.normal(k, shape, jnp.float32)
    return {
        'x': nrm(ks[0], (BATCH, SEQ, D_MODEL), 1.0),
        'rel_bias': nrm(ks[1], (REL_BUCKETS, N_REL_HEADS), 0.5),
        'ln_mix': gain(ks[2], (DEPTH, D_MODEL)),
        'w_in': nrm(ks[3], (DEPTH, D_MODEL, D_IN), D_MODEL ** -0.5),
        'cmp_pos_k': nrm(ks[4], (DEPTH, CMP_LEN, NSA_HD), 0.1),
        'cmp_pos_v': nrm(ks[5], (DEPTH, CMP_LEN, NSA_HD), 0.1),
        'cmp_k_w1': nrm(ks[6], (DEPTH, CMP_LEN * NSA_HD, CMP_HIDDEN), (CMP_LEN * NSA_HD) ** -0.5),
        'cmp_k_w2': nrm(ks[7], (DEPTH, CMP_HIDDEN, NSA_HD), CMP_HIDDEN ** -0.5),
        'cmp_v_w1': nrm(ks[8], (DEPTH, CMP_LEN * NSA_HD, CMP_HIDDEN), (CMP_LEN * NSA_HD) ** -0.5),
        'cmp_v_w2': nrm(ks[9], (DEPTH, CMP_HIDDEN, NSA_HD), CMP_HIDDEN ** -0.5),
        'diff_lq1': nrm(ks[10], (DEPTH, DIFF_HD), 0.1),
        'diff_lk1': nrm(ks[11], (DEPTH, DIFF_HD), 0.1),
        'diff_lq2': nrm(ks[12], (DEPTH, DIFF_HD), 0.1),
        'diff_lk2': nrm(ks[13], (DEPTH, DIFF_HD), 0.1),
        'diff_subln': gain(ks[14], (DEPTH, 2 * DIFF_HD)),
        'w_out': nrm(ks[15], (DEPTH, D_MIX, D_MODEL), D_MIX ** -0.5),
        'ln_ffn': gain(ks[16], (DEPTH, D_MODEL)),
        'router_group_w': nrm(ks[17], (DEPTH, D_MODEL, MOE_GROUPS), D_MODEL ** -0.5),
        'router_group_b': nrm(ks[18], (DEPTH, MOE_GROUPS), 0.01),
        'router_expert_w': nrm(ks[19], (DEPTH, D_MODEL, N_EXPERTS), D_MODEL ** -0.5),
        'router_expert_b': nrm(ks[20], (DEPTH, N_EXPERTS), 0.01),
        'exp_w_gate': nrm(ks[21], (DEPTH, N_EXPERTS, D_MODEL, EXPERT_FF), D_MODEL ** -0.5),
        'exp_w_up': nrm(ks[22], (DEPTH, N_EXPERTS, D_MODEL, EXPERT_FF), D_MODEL ** -0.5),
        'exp_w_down': nrm(ks[23], (DEPTH, N_EXPERTS, EXPERT_FF, D_MODEL), EXPERT_FF ** -0.5),
        'ln_final': gain(ks[24], (D_MODEL,)),
    }


def reference(x, rel_bias, ln_mix, w_in, cmp_pos_k, cmp_pos_v, cmp_k_w1, cmp_k_w2, cmp_v_w1, cmp_v_w2,
              diff_lq1, diff_lk1, diff_lq2, diff_lk2, diff_subln, w_out, ln_ffn,
              router_group_w, router_group_b, router_expert_w, router_expert_b,
              exp_w_gate, exp_w_up, exp_w_down, ln_final):
    split_points = [int(v) for v in np.cumsum(IN_SIZES)[:-1]]
    tab_a = rel_bias[:, :NSA_HEADS]
    tab_b = rel_bias[:, NSA_HEADS:]
    h = x
    for l in range(DEPTH):
        u = rmsnorm(h, ln_mix[l]) @ w_in[l]
        q_a, kc, vc, ks, vs, kw, vw, gates, q_b, k_b, v_b = jnp.split(u, split_points, axis=-1)
        o_a = nsa_mixer(q_a, kc, vc, ks, vs, kw, vw, gates, tab_a, cmp_pos_k[l], cmp_pos_v[l],
                        cmp_k_w1[l], cmp_k_w2[l], cmp_v_w1[l], cmp_v_w2[l])
        lambda_init = 0.8 - 0.6 * math.exp(-0.3 * l)
        o_b = diff_mixer(q_b, k_b, v_b, tab_b, diff_lq1[l], diff_lk1[l], diff_lq2[l], diff_lk2[l],
                         diff_subln[l], lambda_init)
        h = h + jnp.concatenate([o_a, o_b], axis=-1) @ w_out[l]
        h = h + hier_moe(rmsnorm(h, ln_ffn[l]), router_group_w[l], router_group_b[l],
                         router_expert_w[l], router_expert_b[l], exp_w_gate[l], exp_w_up[l], exp_w_down[l])
    return rmsnorm(h, ln_final)
```

```cpp
#include <hip/hip_runtime.h>
#include <cstdio>
#include <cstdint>
#include <cmath>

#ifndef ONE_LAUNCH
#define ONE_LAUNCH 0
#endif

typedef unsigned short bf16_t;

constexpr int D_MODEL = 1024, BATCH = 16, SEQ = 2048, T_TOK = BATCH * SEQ;
constexpr int NSA_HEADS = 8, NSA_G = 2, NSA_HD = 64, CMP_LEN = 32, CMP_STRIDE = 16, CMP_HID = 128, N_CMP = 127;
constexpr int SEL_BLOCK = 64, SEL_TOPN = 8, WINDOW = 512, N_SEL = SEQ / SEL_BLOCK;
constexpr int DIFF_HEADS = 8, DIFF_HD = 32;
constexpr int D_IN = 2840, LDU = 3072;
constexpr int C_QA = 0, C_KC = 512, C_VC = 640, C_KS = 768, C_VS = 896, C_KW = 1024, C_VW = 1152, C_GATE = 1280, C_QB = 1304, C_KB = 1816, C_VB = 2328;
constexpr int N_EXP = 32, EPG = 8, N_GRP = 4, EXP_FF = 256;
constexpr float EPS = 1e-6f;
constexpr int NT = 512;

constexpr size_t MiB = 1024 * 1024;
constexpr size_t OFF_CTL = 0;
constexpr size_t OFF_RSTD = 64 * 1024;
constexpr size_t OFF_BIASD = 192 * 1024;
constexpr size_t OFF_HID = 1 * MiB;
constexpr size_t OFF_KCMP = 5 * MiB;
constexpr size_t OFF_VCMP = 5 * MiB + 512 * 1024;
constexpr size_t OFF_U = 8 * MiB;
constexpr size_t OFF_ATT = 200 * MiB;
constexpr size_t OFF_H = 264 * MiB;
constexpr size_t WS_NEED = 392 * MiB;

struct P {
    const float *x, *rel_bias, *ln_mix, *w_in, *pos_k, *pos_v, *ck1, *ck2, *cv1, *cv2, *lq1, *lk1, *lq2, *lk2, *subln, *w_out, *ln_ffn, *wg, *bg, *we, *be,
        *w_gate, *w_up, *w_down, *ln_final;
    float* out;
    unsigned char* ws;
};

__device__ __forceinline__ float bf2f(bf16_t v) { return __uint_as_float((unsigned)v << 16); }
__device__ __forceinline__ bf16_t f2bf(float f) { unsigned u = __float_as_uint(f); u += 0x7fffu + ((u >> 16) & 1u); return (bf16_t)(u >> 16); }
__device__ __forceinline__ float wave_sum(float v) {
#pragma unroll
    for (int o = 32; o > 0; o >>= 1) v += __shfl_xor(v, o);
    return v;
}
__device__ __forceinline__ float wave_max(float v) {
#pragma unroll
    for (int o = 32; o > 0; o >>= 1) v = fmaxf(v, __shfl_xor(v, o));
    return v;
}
__device__ __forceinline__ int t5_bucket(int n) {
    if (n < 16) return n;
    const float nf = (float)n;
    int large = 16 + (int)(logf(nf / 16.0f) / 2.0794415416798357f * 16.0f);
    return large < 31 ? large : 31;
}
__device__ __forceinline__ float gelu_tanh(float x) { return 0.5f * x * (1.0f + tanhf(0.7978845608028654f * (x + 0.044715f * x * x * x))); }
__device__ __forceinline__ float sigmoidf_(float x) { return 1.0f / (1.0f + expf(-x)); }

__device__ void nv_prologue(const P& p, int bid, int nb) {
    const int tid = threadIdx.x, wave = tid >> 6, lane = tid & 63;
    float* rstd = (float*)(p.ws + OFF_RSTD);
    for (int row = bid * 8 + wave; row < T_TOK; row += nb * 8) {
        const float* xr = p.x + (size_t)row * D_MODEL;
        float s = 0.f;
        for (int k = lane * 4; k < D_MODEL; k += 256) { const float4 v = *(const float4*)(xr + k); s += v.x * v.x + v.y * v.y + v.z * v.z + v.w * v.w; }
        s = wave_sum(s);
        if (lane == 0) rstd[row] = 1.0f / sqrtf(s * (1.0f / D_MODEL) + EPS);
    }
    float* biasd = (float*)(p.ws + OFF_BIASD);
    for (int i = bid * NT + tid; i < 16 * 2048; i += nb * NT) { const int h = i >> 11, d = i & 2047; biasd[i] = p.rel_bias[t5_bucket(d) * 16 + h]; }
    bf16_t* kc = (bf16_t*)(p.ws + OFF_KCMP); bf16_t* vc = (bf16_t*)(p.ws + OFF_VCMP);
    for (int i = bid * NT + tid; i < 32 * 64; i += nb * NT) { const int bg = i >> 6, d = i & 63; kc[(bg * 128 + 127) * 64 + d] = 0; vc[(bg * 128 + 127) * 64 + d] = 0; }
}

template <class AL, class EP>
__device__ void nv_gemm(int M, int N, int K, AL aload, const float* __restrict__ Bm, int ldb, EP epi, float* sm, int tile0, int tstride) {
    const int tid = threadIdx.x;
    float (*As)[132] = (float (*)[132])sm;
    float (*Bs)[68] = (float (*)[68])(sm + 16 * 132);
    const int ntm = (M + 127) / 128, ntn = (N + 63) / 64;
    const int ty = tid >> 4, tx = tid & 15;
    for (int tile = tile0; tile < ntm * ntn; tile += tstride) {
        const int tm = tile / ntn, tn = tile % ntn, m0 = tm * 128, n0 = tn * 64;
        float acc[4][4];
#pragma unroll
        for (int i = 0; i < 4; ++i)
#pragma unroll
            for (int j = 0; j < 4; ++j) acc[i][j] = 0.f;
        for (int k0 = 0; k0 < K; k0 += 16) {
            { const int row = tid >> 2, kq = (tid & 3) * 4; const int gr = m0 + row;
#pragma unroll
              for (int i = 0; i < 4; ++i) As[kq + i][row] = (gr < M) ? aload(gr, k0 + kq + i) : 0.f; }
            if (tid < 256) { const int kr = tid >> 4, nq = (tid & 15) * 4; const int gn = n0 + nq;
                float4 v = make_float4(0.f, 0.f, 0.f, 0.f);
                if (gn < N) v = *(const float4*)(Bm + (size_t)(k0 + kr) * ldb + gn);
                Bs[kr][nq] = v.x; Bs[kr][nq + 1] = v.y; Bs[kr][nq + 2] = v.z; Bs[kr][nq + 3] = v.w; }
            __syncthreads();
#pragma unroll
            for (int k = 0; k < 16; ++k) {
                const float4 a = *(const float4*)&As[k][ty * 4]; const float4 b = *(const float4*)&Bs[k][tx * 4];
                const float av[4] = {a.x, a.y, a.z, a.w}, bv[4] = {b.x, b.y, b.z, b.w};
#pragma unroll
                for (int i = 0; i < 4; ++i)
#pragma unroll
                    for (int j = 0; j < 4; ++j) acc[i][j] = fmaf(av[i], bv[j], acc[i][j]);
            }
            __syncthreads();
        }
#pragma unroll
        for (int i = 0; i < 4; ++i)
#pragma unroll
            for (int j = 0; j < 4; ++j) { const int gr = m0 + ty * 4 + i, gn = n0 + tx * 4 + j; if (gr < M && gn < N) epi(gr, gn, acc[i][j]); }
    }
}

__device__ void nv_inproj(const P& p, int bid, int nb, float* sm) {
    const float* rstd = (const float*)(p.ws + OFF_RSTD); bf16_t* U = (bf16_t*)(p.ws + OFF_U);
    const float* x = p.x; const float* g = p.ln_mix;
    nv_gemm(T_TOK, D_IN, D_MODEL, [=](int r, int k) { return x[(size_t)r * D_MODEL + k] * rstd[r] * g[k]; }, p.w_in, D_IN,
            [=](int r, int n, float v) { U[(size_t)r * LDU + n] = f2bf(v); }, sm, bid, nb);
}

__device__ void nv_cmp1(const P& p, int bid, int nb, float* sm) {
    const bf16_t* U = (const bf16_t*)(p.ws + OFF_U); float* HID = (float*)(p.ws + OFF_HID);
    for (int item = bid; item < 128; item += nb) {
        const int pr = item >> 1;
        const int kv = pr & 1, bg = pr >> 1, b = bg >> 1, g = bg & 1;
        const int col0 = (kv ? C_VC : C_KC) + g * 64; const float* pos = kv ? p.pos_v : p.pos_k; const float* w1 = kv ? p.cv1 : p.ck1;
        float* hid = HID + (size_t)pr * 128 * 128;
        nv_gemm(N_CMP, CMP_HID, CMP_LEN * NSA_HD, [=](int c, int k) { const int i = k >> 6, d = k & 63; return bf2f(U[(size_t)(b * SEQ + 16 * c + i) * LDU + col0 + d]) + pos[i * 64 + d]; },
                w1, CMP_HID, [=](int c, int n, float v) { hid[c * 128 + n] = gelu_tanh(v); }, sm, item & 1, 1 << 20);
    }
}
__device__ void nv_cmp2(const P& p, int bid, int nb, float* sm) {
    const float* HID = (const float*)(p.ws + OFF_HID);
    for (int pr = bid; pr < 64; pr += nb) {
        const int kv = pr & 1, bg = pr >> 1; const float* w2 = kv ? p.cv2 : p.ck2;
        bf16_t* dst = (bf16_t*)(p.ws + (kv ? OFF_VCMP : OFF_KCMP)) + (size_t)bg * 128 * 64;
        const float* hid = HID + (size_t)pr * 128 * 128;
        nv_gemm(N_CMP, NSA_HD, CMP_HID, [=](int c, int k) { return hid[c * 128 + k]; }, w2, NSA_HD, [=](int c, int n, float v) { dst[c * 64 + n] = f2bf(v); }, sm, 0, 1 << 20);
    }
}

template <int NDIM>
__device__ __forceinline__ float dot_row(const bf16_t* krow, const float* qs) {
    float s = 0.f;
#pragma unroll
    for (int c = 0; c < NDIM / 8; ++c) {
        const uint4 v = *(const uint4*)(krow + c * 8);
        const float4 qa = *(const float4*)(qs + c * 8), qb = *(const float4*)(qs + c * 8 + 4);
        s = fmaf(qa.x, __uint_as_float(v.x << 16), s); s = fmaf(qa.y, __uint_as_float(v.x & 0xffff0000u), s);
        s = fmaf(qa.z, __uint_as_float(v.y << 16), s); s = fmaf(qa.w, __uint_as_float(v.y & 0xffff0000u), s);
        s = fmaf(qb.x, __uint_as_float(v.z << 16), s); s = fmaf(qb.y, __uint_as_float(v.z & 0xffff0000u), s);
        s = fmaf(qb.z, __uint_as_float(v.w << 16), s); s = fmaf(qb.w, __uint_as_float(v.w & 0xffff0000u), s);
    }
    return s;
}
__device__ __forceinline__ void chunk_update(float s, bool valid, const bf16_t* v0, float& m, float& l, float& o, int lane) {
    const float sv = valid ? s : -INFINITY;
    const float bm = wave_max(sv);
    if (bm == -INFINITY) return;
    const float mn = fmaxf(m, bm);
    const float sc = expf(m - mn);
    const float pv = valid ? expf(s - mn) : 0.f;
    l = l * sc + wave_sum(pv);
    o *= sc;
#pragma unroll 4
    for (int k = 0; k < 64; ++k) { const float pk = __shfl(pv, k); o = fmaf(pk, bf2f(v0[(size_t)k * LDU + lane]), o); }
    m = mn;
}

__device__ void nv_nsa(const P& p, int bid, int nb, float* sm) {
    const int tid = threadIdx.x, wave = tid >> 6, lane = tid & 63, half = wave >> 2, r = wave & 3;
    float* impsh = sm + half * 128;
    float* qs = sm + 256 + wave * 64;
    const bf16_t* U = (const bf16_t*)(p.ws + OFF_U); bf16_t* ATT = (bf16_t*)(p.ws + OFF_ATT);
    const float* biasd = (const float*)(p.ws + OFF_BIASD);
    const int nunits = BATCH * NSA_G * (SEQ / 2);
    for (int u = bid; u < nunits; u += nb) {
        const int tp = u % (SEQ / 2), bg = u / (SEQ / 2), b = bg >> 1, g = bg & 1;
        const int t = tp * 2 + half, hq = g * 4 + r;
        const size_t row = (size_t)b * SEQ + t;
        const float* bh = biasd + hq * 2048;
        qs[lane] = bf2f(U[row * LDU + C_QA + hq * 64 + lane]);
        __builtin_amdgcn_fence(__ATOMIC_RELEASE, "wavefront"); __builtin_amdgcn_wave_barrier(); __builtin_amdgcn_fence(__ATOMIC_ACQUIRE, "wavefront");
        const bf16_t* kc = (const bf16_t*)(p.ws + OFF_KCMP) + (size_t)bg * 128 * 64; const bf16_t* vc = (const bf16_t*)(p.ws + OFF_VCMP) + (size_t)bg * 128 * 64;
        const int nvalid = (t >= 31) ? ((t - 31) / 16 + 1) : 0;
        float p0 = 0.f, p1 = 0.f, ocmp = 0.f;
        if (nvalid > 0) {
            const int c0 = lane, c1 = lane + 64; const bool v0 = c0 < nvalid, v1 = c1 < nvalid;
            float s0 = -INFINITY, s1 = -INFINITY;
            { const float d0 = dot_row<64>(kc + c0 * 64, qs), d1 = dot_row<64>(kc + c1 * 64, qs);
              if (v0) s0 = d0 * 0.125f + bh[t - 16 * c0 - 31];
              if (v1) s1 = d1 * 0.125f + bh[t - 16 * c1 - 31]; }
            const float m = wave_max(fmaxf(s0, s1));
            const float e0 = v0 ? expf(s0 - m) : 0.f, e1 = v1 ? expf(s1 - m) : 0.f;
            const float l = wave_sum(e0 + e1);
            p0 = e0 / l; p1 = e1 / l;
#pragma unroll 2
            for (int c = 0; c < nvalid; ++c) { const float pc = (c < 64) ? __shfl(p0, c) : __shfl(p1, c - 64); ocmp = fmaf(pc, bf2f(vc[c * 64 + lane]), ocmp); }
        }
        { const int j = lane & 31; float im = 0.f;
#pragma unroll
          for (int mm = -1; mm <= 3; ++mm) { const int c = 4 * j + mm; const float a0 = __shfl(p0, c & 63), a1 = __shfl(p1, c & 63); if (c >= 0 && c < N_CMP) im += (c < 64) ? a0 : a1; }
          __syncthreads();
          if (lane < 32) impsh[r * 32 + j] = im;
          __syncthreads(); }
        const int cur = t >> 6;
        unsigned mask = 0;
        { const int j = lane & 31;
          const float imp = ((impsh[j] + impsh[32 + j]) + impsh[64 + j]) + impsh[96 + j];
          const bool valid = j <= cur, forced = (j == 0) || (cur - j >= 0 && cur - j < 2);
          float sc = (valid && forced) ? 1e9f : (valid ? imp : -1e9f);
          if (lane >= 32) sc = -3.0e38f;
          for (int it = 0; it < SEL_TOPN; ++it) {
              const float mx = wave_max(sc);
              const unsigned long long bal = __ballot(sc == mx);
              const int idx = __ffsll((long long)bal) - 1;
              if (mx > -1e8f) mask |= 1u << idx;
              if (lane == idx) sc = -3.0e38f;
          } }
        float ms = -INFINITY, ls = 0.f, os = 0.f;
        for (int j = 0; j <= cur; ++j) {
            if (!((mask >> j) & 1u)) continue;
            const int kpos = 64 * j + lane; const bool valid = kpos <= t;
            const size_t krow = (size_t)b * SEQ + kpos;
            float s = dot_row<64>(U + krow * LDU + C_KS + g * 64, qs) * 0.125f;
            if (valid) s += bh[t - kpos];
            chunk_update(s, valid, U + ((size_t)b * SEQ + 64 * j) * LDU + C_VS + g * 64, ms, ls, os, lane);
        }
        float mw = -INFINITY, lw = 0.f, ow = 0.f;
        const int lo = (t - (WINDOW - 1)) > 0 ? (t - (WINDOW - 1)) : 0;
        for (int base = lo & ~63; base <= t; base += 64) {
            const int kpos = base + lane; const bool valid = kpos >= lo && kpos <= t;
            const size_t krow = (size_t)b * SEQ + kpos;
            float s = dot_row<64>(U + krow * LDU + C_KW + g * 64, qs) * 0.125f;
            if (valid) s += bh[t - kpos];
            chunk_update(s, valid, U + ((size_t)b * SEQ + base) * LDU + C_VW + g * 64, mw, lw, ow, lane);
        }
        const float g0 = sigmoidf_(bf2f(U[row * LDU + C_GATE + hq * 3 + 0])), g1 = sigmoidf_(bf2f(U[row * LDU + C_GATE + hq * 3 + 1])), g2 = sigmoidf_(bf2f(U[row * LDU + C_GATE + hq * 3 + 2]));
        const float o = g0 * ocmp + g1 * (os / ls) + g2 * (ow / lw);
        ATT[row * D_MODEL + hq * 64 + lane] = f2bf(o);
    }
}

__device__ void nv_diff(const P& p, int bid, int nb, float* sm) {
    const int tid = threadIdx.x, wave = tid >> 6, lane = tid & 63;
    float* qs = sm + wave * 64;
    const bf16_t* U = (const bf16_t*)(p.ws + OFF_U); bf16_t* ATT = (bf16_t*)(p.ws + OFF_ATT);
    const float* biasd = (const float*)(p.ws + OFF_BIASD);
    float lam;
    { const float a = lane < 32 ? p.lq1[lane] * p.lk1[lane] : 0.f, c = lane < 32 ? p.lq2[lane] * p.lk2[lane] : 0.f;
      lam = expf(wave_sum(a)) - expf(wave_sum(c)) + 0.2f; }
    const float scale = 0.17677669529663687f;
    const int nunits = BATCH * DIFF_HEADS * SEQ;
    for (int u = bid * 8 + wave; u < nunits; u += nb * 8) {
        const int t = u % SEQ, bh_ = u / SEQ, h = bh_ % DIFF_HEADS, b = bh_ / DIFF_HEADS;
        const size_t row = (size_t)b * SEQ + t;
        const float* bh = biasd + (8 + h) * 2048;
        qs[lane] = bf2f(U[row * LDU + C_QB + h * 64 + lane]);
        __builtin_amdgcn_fence(__ATOMIC_RELEASE, "wavefront"); __builtin_amdgcn_wave_barrier(); __builtin_amdgcn_fence(__ATOMIC_ACQUIRE, "wavefront");
        float m0 = -INFINITY, l0 = 0.f, o0 = 0.f, m1 = -INFINITY, l1 = 0.f, o1 = 0.f;
        for (int base = 0; base <= t; base += 64) {
            const int kpos = base + lane; const bool valid = kpos <= t;
            const bf16_t* kr = U + ((size_t)b * SEQ + kpos) * LDU + C_KB + h * 64;
            float s0 = dot_row<32>(kr, qs) * scale, s1 = dot_row<32>(kr + 32, qs + 32) * scale;
            if (valid) { const float bb = bh[t - kpos]; s0 += bb; s1 += bb; }
            const bf16_t* v0 = U + ((size_t)b * SEQ + base) * LDU + C_VB + h * 64;
            chunk_update(s0, valid, v0, m0, l0, o0, lane);
            chunk_update(s1, valid, v0, m1, l1, o1, lane);
        }
        float o = o0 / l0 - lam * (o1 / l1);
        const float ms = wave_sum(o * o) * (1.0f / 64.0f);
        o = o * (1.0f / sqrtf(ms + EPS)) * p.subln[lane] * 0.8f;
        ATT[row * D_MODEL + 512 + h * 64 + lane] = f2bf(o);
    }
}

__device__ void nv_outproj(const P& p, int bid, int nb, float* sm) {
    const bf16_t* ATT = (const bf16_t*)(p.ws + OFF_ATT); float* H = (float*)(p.ws + OFF_H); const float* x = p.x;
    nv_gemm(T_TOK, D_MODEL, D_MODEL, [=](int r, int k) { return bf2f(ATT[(size_t)r * D_MODEL + k]); }, p.w_out, D_MODEL,
            [=](int r, int n, float v) { H[(size_t)r * D_MODEL + n] = x[(size_t)r * D_MODEL + n] + v; }, sm, bid, nb);
}

__device__ __forceinline__ float block_sum(float v, float* red, int tid) {
    v = wave_sum(v);
    __syncthreads();
    if ((tid & 63) == 0) red[tid >> 6] = v;
    __syncthreads();
    return ((red[0] + red[1]) + (red[2] + red[3])) + ((red[4] + red[5]) + (red[6] + red[7]));
}

__device__ void nv_moe(const P& p, int bid, int nb, float* sm) {
    const int tid = threadIdx.x, wave = tid >> 6, lane = tid & 63;
    float* hs = sm;
    float* tn = sm + 1024;
    float* gu = sm + 2048;
    float* hg = sm + 2560;
    float* lg = sm + 2816;
    float* red = sm + 2880;
    int* eid = (int*)(sm + 2896); float* ew = sm + 2900;
    const float* H = (const float*)(p.ws + OFF_H);
    for (int t = bid; t < T_TOK; t += nb) {
        const float* hr = H + (size_t)t * D_MODEL;
        const float h0 = hr[tid], h1 = hr[tid + 512];
        const float ss = block_sum(h0 * h0 + h1 * h1, red, tid);
        const float rs = 1.0f / sqrtf(ss * (1.0f / D_MODEL) + EPS);
        hs[tid] = h0; hs[tid + 512] = h1; tn[tid] = h0 * rs * p.ln_ffn[tid]; tn[tid + 512] = h1 * rs * p.ln_ffn[tid + 512];
        __syncthreads();
        for (int c = wave; c < 36; c += 8) {
            float s = 0.f;
            if (c < 4) { for (int k = lane; k < D_MODEL; k += 64) s = fmaf(tn[k], p.wg[k * 4 + c], s); }
            else { const int e = c - 4; for (int k = lane; k < D_MODEL; k += 64) s = fmaf(tn[k], p.we[k * 32 + e], s); }
            s = wave_sum(s);
            if (lane == 0) lg[c] = s + (c < 4 ? p.bg[c] : p.be[c - 4]);
        }
        __syncthreads();
        if (tid == 0) {
            float mx = lg[0]; int gi = 0;
            for (int i = 1; i < 4; ++i) if (lg[i] > mx) { mx = lg[i]; gi = i; }
            float den = 0.f; for (int i = 0; i < 4; ++i) den += expf(lg[i] - mx);
            const float gprob = 1.0f / den;
            const float* el = lg + 4 + gi * 8;
            float emx = el[0]; int e0 = 0;
            for (int i = 1; i < 8; ++i) if (el[i] > emx) { emx = el[i]; e0 = i; }
            float e2 = -INFINITY; int e1 = -1;
            for (int i = 0; i < 8; ++i) if (i != e0 && el[i] > e2) { e2 = el[i]; e1 = i; }
            float eden = 0.f; for (int i = 0; i < 8; ++i) eden += expf(el[i] - emx);
            const float pa = 1.0f / eden, pb = expf(e2 - emx) / eden;
            eid[0] = gi * 8 + e0; eid[1] = gi * 8 + e1; ew[0] = gprob * pa / (pa + pb); ew[1] = gprob * pb / (pa + pb);
        }
        __syncthreads();
        float y0 = 0.f, y1 = 0.f;
        for (int kx = 0; kx < 2; ++kx) {
            const int e = eid[kx]; const float wgt = ew[kx];
            { const int f = tid & 255, which = tid >> 8;
              const float* W = (which ? p.w_up : p.w_gate) + (size_t)e * D_MODEL * EXP_FF + f;
              float a = 0.f;
#pragma unroll 8
              for (int k = 0; k < D_MODEL; ++k) a = fmaf(tn[k], W[(size_t)k * EXP_FF], a);
              gu[tid] = a; }
            __syncthreads();
            if (tid < 256) { const float gt = gu[tid], up = gu[256 + tid]; hg[tid] = (gt / (1.0f + expf(-gt))) * up * wgt; }
            __syncthreads();
            { const float* W = p.w_down + (size_t)e * EXP_FF * D_MODEL;
              float a0 = 0.f, a1 = 0.f;
#pragma unroll 8
              for (int f = 0; f < EXP_FF; ++f) { const float hv = hg[f]; a0 = fmaf(hv, W[(size_t)f * D_MODEL + tid], a0); a1 = fmaf(hv, W[(size_t)f * D_MODEL + tid + 512], a1); }
              y0 += a0; y1 += a1; }
            __syncthreads();
        }
        const float z0 = hs[tid] + y0, z1 = hs[tid + 512] + y1;
        const float s2 = block_sum(z0 * z0 + z1 * z1, red, tid);
        const float r2 = 1.0f / sqrtf(s2 * (1.0f / D_MODEL) + EPS);
        p.out[(size_t)t * D_MODEL + tid] = z0 * r2 * p.ln_final[tid];
        p.out[(size_t)t * D_MODEL + tid + 512] = z1 * r2 * p.ln_final[tid + 512];
        __syncthreads();
    }
}

extern __shared__ __attribute__((aligned(16))) unsigned char dyn_smem[];
template <int PH> __global__ void __launch_bounds__(NT, 2) k_phase(P p) {
    float* sm = (float*)dyn_smem;
    const int bid = blockIdx.x, nb = gridDim.x;
    if constexpr (PH == 0) nv_prologue(p, bid, nb);
    if constexpr (PH == 1) nv_inproj(p, bid, nb, sm);
    if constexpr (PH == 2) nv_cmp1(p, bid, nb, sm);
    if constexpr (PH == 3) nv_cmp2(p, bid, nb, sm);
    if constexpr (PH == 4) nv_nsa(p, bid, nb, sm);
    if constexpr (PH == 5) nv_diff(p, bid, nb, sm);
    if constexpr (PH == 6) nv_outproj(p, bid, nb, sm);
    if constexpr (PH == 7) nv_moe(p, bid, nb, sm);
}

extern "C" void kernel_launch(void* const* d_in, const int* in_sizes, int n_in, void* d_out, int out_size, void* d_ws, size_t ws_size, hipStream_t stream) {
    if (ws_size < WS_NEED) { fprintf(stderr, "kernel_launch: workspace too small (%zu < %zu)\n", ws_size, WS_NEED); return; }
    P p{};
    const float** f = (const float**)&p;
    for (int i = 0; i < 25; ++i) f[i] = (const float*)d_in[i];
    p.out = (float*)d_out; p.ws = (unsigned char*)d_ws;
    const int grid = 1024, lds = 16384;
    hipLaunchKernelGGL(k_phase<0>, dim3(grid), dim3(NT), lds, stream, p);
    hipLaunchKernelGGL(k_phase<1>, dim3(grid), dim3(NT), lds, stream, p);
    hipLaunchKernelGGL(k_phase<2>, dim3(grid), dim3(NT), lds, stream, p);
    hipLaunchKernelGGL(k_phase<3>, dim3(grid), dim3(NT), lds, stream, p);
    hipLaunchKernelGGL(k_phase<4>, dim3(grid), dim3(NT), lds, stream, p);
    hipLaunchKernelGGL(k_phase<5>, dim3(grid), dim3(NT), lds, stream, p);
    hipLaunchKernelGGL(k_phase<6>, dim3(grid), dim3(NT), lds, stream, p);
    hipLaunchKernelGGL(k_phase<7>, dim3(grid), dim3(NT), lds, stream, p);
}
```

```cpp
#include <hip/hip_runtime.h>
#include <cstdio>
#include <cstdint>
#include <cmath>


typedef unsigned short bf16_t;
__device__ __forceinline__ int ltid() { int t = threadIdx.x; asm volatile("" : "+v"(t)); return t; }

constexpr int D_MODEL = 1024, BATCH = 16, SEQ = 2048, T_TOK = BATCH * SEQ;
constexpr int NSA_HEADS = 8, NSA_G = 2, NSA_HD = 64, CMP_LEN = 32, CMP_STRIDE = 16, CMP_HID = 128, N_CMP = 127;
constexpr int SEL_BLOCK = 64, SEL_TOPN = 8, WINDOW = 512, N_SEL = SEQ / SEL_BLOCK;
constexpr int DIFF_HEADS = 8, DIFF_HD = 32;
constexpr int D_IN = 2840, LDU = 3072;
constexpr int C_QA = 0, C_KC = 512, C_VC = 640, C_KS = 768, C_VS = 896, C_KW = 1024, C_VW = 1152, C_GATE = 1280, C_QB = 1304, C_KB = 1816, C_VB = 2328;
constexpr int N_EXP = 32, EPG = 8, N_GRP = 4, EXP_FF = 256;
constexpr float EPS = 1e-6f;
constexpr int NT = 512;

constexpr size_t MiB = 1024 * 1024;
constexpr size_t OFF_CTL = 0;
constexpr size_t OFF_RSTD = 64 * 1024;
constexpr size_t OFF_BIASD = 192 * 1024;
constexpr size_t OFF_HID = 1 * MiB;
constexpr size_t OFF_KCMP = 5 * MiB;
constexpr size_t OFF_VCMP = 5 * MiB + 512 * 1024;
constexpr size_t OFF_U = 8 * MiB;
constexpr size_t OFF_ATT = 200 * MiB;
constexpr size_t OFF_H = 264 * MiB;
constexpr size_t OFF_XN = OFF_ATT;
constexpr size_t OFF_WIN_T = 392 * MiB;
constexpr size_t OFF_WOUT_T = 398 * MiB;
constexpr size_t OFF_RW_HI = 6 * MiB;
constexpr size_t OFF_RW_LO = 6 * MiB + 128 * 1024;
constexpr size_t OFF_TOK_EP = 6 * MiB + 512 * 1024;
constexpr size_t OFF_TOK_W = 6 * MiB + 768 * 1024;
constexpr size_t OFF_LIST = 400 * MiB;
constexpr size_t OFF_SLR = 404 * MiB;
constexpr size_t OFF_W13_T = 408 * MiB;
constexpr size_t OFF_WD_T = 440 * MiB;
constexpr size_t OFF_HB = OFF_U;
constexpr size_t OFF_YC = OFF_U + 64 * MiB;
constexpr size_t OFF_HG = OFF_ATT + 16 * MiB;
constexpr size_t OFF_W1T = 7 * MiB;
constexpr size_t OFF_W2T = 1 * MiB;
constexpr size_t OFF_B1 = 1 * MiB + 64 * 1024;
constexpr size_t CTL_PANEL = 65536;
constexpr int CTL_CNT = 8192;
constexpr size_t WS_NEED = 456 * MiB;

struct P {
    const float *x, *rel_bias, *ln_mix, *w_in, *pos_k, *pos_v, *ck1, *ck2, *cv1, *cv2, *lq1, *lk1, *lq2, *lk2, *subln, *w_out, *ln_ffn, *wg, *bg, *we, *be,
        *w_gate, *w_up, *w_down, *ln_final;
    float* out;
    unsigned char* ws;
};

__device__ __forceinline__ float bf2f(bf16_t v) { return __uint_as_float((unsigned)v << 16); }
__device__ __forceinline__ bf16_t f2bf(float f) { unsigned u = __float_as_uint(f); u += 0x7fffu + ((u >> 16) & 1u); return (bf16_t)(u >> 16); }
#define DPP_F(v, ctrl) __uint_as_float((unsigned)__builtin_amdgcn_update_dpp(0, (int)__float_as_uint(v), ctrl, 0xf, 0xf, true))
__device__ __forceinline__ float pl16_sum(float v) { const auto rr = __builtin_amdgcn_permlane16_swap(__float_as_uint(v), __float_as_uint(v), false, false); return __uint_as_float(rr[0]) + __uint_as_float(rr[1]); }
__device__ __forceinline__ float pl16_max(float v) { const auto rr = __builtin_amdgcn_permlane16_swap(__float_as_uint(v), __float_as_uint(v), false, false); return fmaxf(__uint_as_float(rr[0]), __uint_as_float(rr[1])); }
__device__ __forceinline__ float pl32_sum(float v) { const auto rr = __builtin_amdgcn_permlane32_swap(__float_as_uint(v), __float_as_uint(v), false, false); return __uint_as_float(rr[0]) + __uint_as_float(rr[1]); }
__device__ __forceinline__ float pl32_max(float v) { const auto rr = __builtin_amdgcn_permlane32_swap(__float_as_uint(v), __float_as_uint(v), false, false); return fmaxf(__uint_as_float(rr[0]), __uint_as_float(rr[1])); }
__device__ __forceinline__ float pl32_other(float v) { const unsigned u = __float_as_uint(v); const auto rr = __builtin_amdgcn_permlane32_swap(u, u, false, false); return __uint_as_float(rr[0] != u ? rr[0] : rr[1]); }
__device__ __forceinline__ float wave_sum(float v) {
    v += DPP_F(v, 0xB1); v += DPP_F(v, 0x4E); v += DPP_F(v, 0x141); v += DPP_F(v, 0x140);
    return pl32_sum(pl16_sum(v));
}
__device__ __forceinline__ float wave_max(float v) {
    v = fmaxf(v, DPP_F(v, 0xB1)); v = fmaxf(v, DPP_F(v, 0x4E)); v = fmaxf(v, DPP_F(v, 0x141)); v = fmaxf(v, DPP_F(v, 0x140));
    return pl32_max(pl16_max(v));
}
__device__ __forceinline__ int t5_bucket(int n) {
    if (n < 16) return n;
    const float nf = (float)n;
    int large = 16 + (int)(logf(nf / 16.0f) / 2.0794415416798357f * 16.0f);
    return large < 31 ? large : 31;
}
__device__ __forceinline__ float gelu_tanh(float x) { return 0.5f * x * (1.0f + tanhf(0.7978845608028654f * (x + 0.044715f * x * x * x))); }
__device__ __forceinline__ float sigmoidf_(float x) { return 1.0f / (1.0f + expf(-x)); }

namespace pg8 {
#define PG8_LAS __attribute__((address_space(3)))
typedef unsigned short bf16_t;
typedef short bf16x8 __attribute__((ext_vector_type(8)));
typedef float f32x4 __attribute__((ext_vector_type(4)));
typedef unsigned u32x4 __attribute__((ext_vector_type(4)));
constexpr int BM = 256, BK = 64, HALF = 128, HTB = HALF * BK * 2  , STAGE_BYTES = 8 * HTB, NXCD = 8, WGM = 8;

__host__ __device__ __forceinline__ int lds_byte(int r, int c) { const int st = (r >> 4) * 2 + (c >> 5), rr = r & 15, cc = c & 31, ob = rr * 64 + cc * 2; return st * 1024 + (ob ^ (((ob >> 9) & 1) << 5)); }
__host__ __device__ __forceinline__ void stage_rc(int b, int& R, int& C) { const int st = b / 1024, sb = b % 1024, swz = sb ^ (((sb >> 9) & 1) << 5); R = (st >> 1) * 16 + swz / 64; C = (st & 1) * 32 + (swz % 64) / 2; }
__host__ __device__ __forceinline__ int perm32(int rho) { const int n = rho >> 4, i = rho & 15; return 8 * (i >> 2) + 4 * n + (i & 3); }

struct Unit { int pm, pn; };
struct Gemm { const bf16_t* A; const bf16_t* Bt; int M, N, K; };

struct StaticOrder {
    int nM, nN, nwg, G, c;
    __host__ __device__ void init(int M, int N, int G_, int c_) { nM = M / BM; nN = N / BM; nwg = nM * nN; G = G_; c = c_; }
    __host__ __device__ bool next(int i, Unit& u) const {
        const long L = (long)i * G + c; if (L >= nwg) return false;
        int wgid = (int)L; { const int q = nwg / NXCD, r = nwg % NXCD, xcd = wgid % NXCD, off = wgid / NXCD; wgid = (xcd < r ? xcd * (q + 1) : r * (q + 1) + (xcd - r) * q) + off; }
        const int nig = WGM * nN, gid = wgid / nig, fm = gid * WGM, gsz = (nM - fm) < WGM ? (nM - fm) : WGM;
        u.pm = fm + ((wgid % nig) % gsz); u.pn = (wgid % nig) / gsz; return true;
    }
    __device__ __forceinline__ void a_ready(const Unit&) const {}
    __device__ __forceinline__ unsigned peek(const Unit&) const { return 0u; }
    __device__ __forceinline__ void a_ready(const Unit&, unsigned) const {}
    __device__ __forceinline__ void done(const Unit&) const {}
};

__device__ __forceinline__ unsigned cvt_pk_bf16(float lo, float hi) { unsigned r; asm volatile("v_cvt_pk_bf16_f32 %0, %1, %2" : "=v"(r) : "v"(lo), "v"(hi)); return r; }
typedef float f32x2 __attribute__((ext_vector_type(2)));
__device__ __forceinline__ f32x2 gelu_pk(f32x2 v) {
    const f32x2 av = __builtin_elementwise_abs(v), d = av * 0.2316418882f + 1.0f;
    f32x2 t; t.x = __builtin_amdgcn_rcpf(d.x); t.y = __builtin_amdgcn_rcpf(d.y);
    f32x2 q = t * 0.5307027145f + (-0.7265760135f); q = q * t + 0.7107068705f; q = q * t + (-0.142248368f); q = q * t + 0.127414796f; q = q * t;
    const f32x2 s = (v * v) * (-0.72134752044f);
    f32x2 e; e.x = __builtin_amdgcn_exp2f(s.x); e.y = __builtin_amdgcn_exp2f(s.y);
    const f32x2 m = v * (q * e), r = v - m;
    f32x2 o; o.x = v.x < 0.f ? m.x : r.x; o.y = v.y < 0.f ? m.y : r.y; return o;
}

template <int ACT  > struct EpiBf16 {
    static constexpr bool PERM = true, AFTER_DRAIN = false; static_assert(ACT == 0 || ACT == 1, "EpiBf16: ACT is 0 (none) or 1 (gelu_pk)");
    bf16_t* O; int ldc; const float* bias; int split_cols; size_t split_stride; float scale0;
    __device__ __forceinline__ void operator()(const f32x4 (&acc)[2][2][4][2], const Unit& u, int wr, int wc, int fr, int fq) const {
        const int row0 = u.pm * BM + wr * 64 + fr; int colt = u.pn * BM; bf16_t* base = O;
        float sc = 1.f; if (split_cols) { const int t = colt / split_cols; base += (size_t)t * split_stride; colt -= t * split_cols; if (t == 0) sc = scale0; }
        const int col0 = colt + wc * 32 + 8 * fq, bcol0 = u.pn * BM + wc * 32 + 8 * fq;
        f32x4 bv[2][2];
#pragma unroll
        for (int bj = 0; bj < 2; ++bj)
#pragma unroll
            for (int n = 0; n < 2; ++n) bv[bj][n] = bias ? *(const f32x4*)(bias + bcol0 + bj * HALF + 4 * n) : (f32x4){0.f, 0.f, 0.f, 0.f};
#pragma unroll
        for (int ai = 0; ai < 2; ++ai)
#pragma unroll
            for (int m = 0; m < 4; ++m) { bf16_t* rowp = base + (size_t)(row0 + ai * HALF + m * 16) * ldc + col0;
#pragma unroll
                for (int bj = 0; bj < 2; ++bj) { f32x4 v0 = acc[ai][bj][m][0] + bv[bj][0], v1 = acc[ai][bj][m][1] + bv[bj][1];
                    if (ACT == 1) { f32x2 a = gelu_pk((f32x2){v0[0], v0[1]}), b = gelu_pk((f32x2){v0[2], v0[3]}), c = gelu_pk((f32x2){v1[0], v1[1]}), d = gelu_pk((f32x2){v1[2], v1[3]});
                        v0 = (f32x4){a.x, a.y, b.x, b.y}; v1 = (f32x4){c.x, c.y, d.x, d.y}; }
                    v0 = v0 * sc; v1 = v1 * sc; u32x4 w; w.x = cvt_pk_bf16(v0[0], v0[1]); w.y = cvt_pk_bf16(v0[2], v0[3]); w.z = cvt_pk_bf16(v1[0], v1[1]); w.w = cvt_pk_bf16(v1[2], v1[3]);
                    *(u32x4*)(rowp + bj * HALF) = w; } }
    }
};
template <class Epi, class Sched, bool ALIGN_EPI = false, bool SP2 = false>
__device__ __forceinline__ void gemm_phase(PG8_LAS unsigned char* lds, const Gemm g, const Sched& S, const Epi& E) {
    const int tid = ltid(), wid = __builtin_amdgcn_readfirstlane(tid >> 6), lane = tid & 63, wr = wid >> 2, wc = wid & 3, fr = lane & 15, fq = lane >> 4;
    const int K = g.K, nt = K / BK;
    unsigned voffA[2], voffB[2];
#pragma unroll
    for (int i = 0; i < 2; ++i) { int R, C; stage_rc(tid * 16 + i * 8192, R, C); const int Rb = Epi::PERM ? ((R & ~31) + perm32(R & 31)) : R;
        voffA[i] = (unsigned)(R * K + C) * 2u; voffB[i] = (unsigned)(Rb * K + C) * 2u; }
    const size_t kstep = (size_t)(BK * 2);
    const size_t hstep = (size_t)HALF * K * 2;
    const size_t tstep = 2 * hstep;
    const unsigned ldsw = (unsigned)wid * 1024u;
    const int aoff = lds_byte(wr * 64 + fr, fq * 8), boff = lds_byte(wc * 32 + fr, fq * 8);
#define PG8_SA(b, h) (((b) * 2 + (h)) * HTB)
#define PG8_SB(b, h) ((4 + (b) * 2 + (h)) * HTB)
#define PG8_STAGE(bufoff, gbase, voff) do { _Pragma("unroll") for (int _i = 0; _i < 2; ++_i) \
        __builtin_amdgcn_global_load_lds((const unsigned*)((const char*)(gbase) + (voff)[_i]), (PG8_LAS unsigned*)(lds + (bufoff) + ldsw + _i * 8192), 16, 0, 0); } while (0)
#define PG8_LDA(dst, b, h) do { _Pragma("unroll") for (int m = 0; m < 4; ++m) _Pragma("unroll") for (int k = 0; k < 2; ++k) dst[m][k] = *(const PG8_LAS bf16x8*)(lds + PG8_SA(b, h) + aoff + m * 2048 + k * 1024); } while (0)
#define PG8_LDB(dst, b, h) do { _Pragma("unroll") for (int n = 0; n < 2; ++n) _Pragma("unroll") for (int k = 0; k < 2; ++k) dst[n][k] = *(const PG8_LAS bf16x8*)(lds + PG8_SB(b, h) + boff + n * 2048 + k * 1024); } while (0)
#define PG8_MMA(ai, bj, At, Bt) do { __builtin_amdgcn_s_setprio(1); _Pragma("unroll") for (int m = 0; m < 4; ++m) _Pragma("unroll") for (int n = 0; n < 2; ++n) _Pragma("unroll") for (int k = 0; k < 2; ++k) \
        acc[ai][bj][m][n] = __builtin_amdgcn_mfma_f32_16x16x32_bf16(Bt[n][k], At[m][k], acc[ai][bj][m][n], 0, 0, 0); __builtin_amdgcn_s_setprio(0); } while (0)
#define PG8_WAIT_V(n) asm volatile("s_waitcnt vmcnt(" #n ")" ::: "memory")
#define PG8_WAIT_L(n) asm volatile("s_waitcnt lgkmcnt(" #n ")" ::: "memory")
#define PG8_BAR __builtin_amdgcn_s_barrier()
#define PG8_SCHED __builtin_amdgcn_sched_barrier(0)
    Unit cur, nxt; int ui = 0;
    if (!S.next(0, cur)) return;
    f32x4 acc[2][2][4][2];
#pragma unroll
    for (int a = 0; a < 2; ++a)
#pragma unroll
        for (int b = 0; b < 2; ++b)
#pragma unroll
            for (int m = 0; m < 4; ++m)
#pragma unroll
                for (int n = 0; n < 2; ++n) acc[a][b][m][n] = (f32x4){0.f, 0.f, 0.f, 0.f};
    bf16x8 At[4][2], B0[2][2], B1[2][2];
    const char* cA = (const char*)g.A + (size_t)cur.pm * tstep; const char* cB = (const char*)g.Bt + (size_t)cur.pn * tstep;
    S.a_ready(cur);
    if constexpr (SP2) {
        PG8_STAGE(PG8_SB(0, 0), cB, voffB); PG8_STAGE(PG8_SB(0, 1), cB + hstep, voffB); PG8_STAGE(PG8_SA(0, 0), cA, voffA); PG8_STAGE(PG8_SA(0, 1), cA + hstep, voffA);
        if (wr == 1) PG8_BAR;
        PG8_WAIT_V(2); PG8_BAR;
        PG8_STAGE(PG8_SB(1, 0), cB + kstep, voffB); PG8_STAGE(PG8_SA(1, 0), cA + kstep, voffA); PG8_STAGE(PG8_SB(1, 1), cB + hstep + kstep, voffB);
        PG8_WAIT_V(6); PG8_BAR;
    } else {
        PG8_STAGE(PG8_SB(0, 0), cB, voffB); PG8_STAGE(PG8_SA(0, 0), cA, voffA); PG8_STAGE(PG8_SB(0, 1), cB + hstep, voffB); PG8_STAGE(PG8_SA(0, 1), cA + hstep, voffA);
        if (wr == 1) PG8_BAR;
        PG8_WAIT_V(4); PG8_BAR;
        PG8_STAGE(PG8_SB(1, 0), cB + kstep, voffB); PG8_STAGE(PG8_SA(1, 0), cA + kstep, voffA); PG8_STAGE(PG8_SB(1, 1), cB + hstep + kstep, voffB);
        PG8_WAIT_V(6); PG8_BAR;
    }
    for (;;) {
        const bool has_next = S.next(ui + 1, nxt);
        const unsigned pk_ = has_next ? S.peek(nxt) : 0u;
        const char* nA = has_next ? (const char*)g.A + (size_t)nxt.pm * tstep : cA; const char* nB = has_next ? (const char*)g.Bt + (size_t)nxt.pn * tstep : cB;
#pragma nounroll
        for (int t = 0; t < nt; t += 2) {
            const bool last = (t == nt - 2);
            const char* a1 = cA + (size_t)(t + 1) * kstep;
            const char* a2 = last ? nA : cA + (size_t)(t + 2) * kstep; const char* b2 = last ? nB : cB + (size_t)(t + 2) * kstep;
            const char* a3 = a2 + kstep; const char* b3 = b2 + kstep;
            if (last && has_next) S.a_ready(nxt, pk_);
            if constexpr (SP2) {
            PG8_LDB(B0, 0, 0); PG8_LDB(B1, 0, 1); PG8_SCHED; PG8_LDA(At, 0, 0); PG8_STAGE(PG8_SA(1, 1), a1 + hstep, voffA);
            PG8_WAIT_V(8); PG8_WAIT_L(0); PG8_BAR; PG8_MMA(0, 0, At, B0); PG8_MMA(0, 1, At, B1); PG8_BAR; PG8_SCHED;
            PG8_LDA(At, 0, 1); PG8_STAGE(PG8_SB(0, 0), b2, voffB); PG8_STAGE(PG8_SB(0, 1), b2 + hstep, voffB); PG8_STAGE(PG8_SA(0, 0), a2, voffA);
            PG8_WAIT_V(8); PG8_WAIT_L(0); PG8_BAR; PG8_MMA(1, 0, At, B0); PG8_MMA(1, 1, At, B1); PG8_BAR; PG8_SCHED;
            PG8_LDB(B0, 1, 0); PG8_LDB(B1, 1, 1); PG8_SCHED; PG8_LDA(At, 1, 0); PG8_STAGE(PG8_SA(0, 1), a2 + hstep, voffA);
            PG8_WAIT_V(8); PG8_WAIT_L(0); PG8_BAR; PG8_MMA(0, 0, At, B0); PG8_MMA(0, 1, At, B1); PG8_BAR; PG8_SCHED;
            PG8_LDA(At, 1, 1); PG8_STAGE(PG8_SB(1, 0), b3, voffB); PG8_STAGE(PG8_SB(1, 1), b3 + hstep, voffB); PG8_STAGE(PG8_SA(1, 0), a3, voffA);
            PG8_WAIT_V(8); PG8_WAIT_L(0); PG8_BAR; PG8_MMA(1, 0, At, B0); PG8_MMA(1, 1, At, B1); PG8_BAR; PG8_SCHED;
            } else {
            PG8_LDB(B0, 0, 0); PG8_SCHED; PG8_LDA(At, 0, 0); PG8_STAGE(PG8_SA(1, 1), a1 + hstep, voffA);
            PG8_WAIT_L(8); PG8_BAR; PG8_WAIT_L(0); PG8_MMA(0, 0, At, B0); PG8_BAR; PG8_SCHED;
            PG8_LDB(B1, 0, 1); PG8_STAGE(PG8_SB(0, 0), b2, voffB);
            PG8_BAR; PG8_WAIT_L(0); PG8_MMA(0, 1, At, B1); PG8_BAR;
            PG8_LDA(At, 0, 1); PG8_STAGE(PG8_SA(0, 0), a2, voffA);
            PG8_BAR; PG8_WAIT_L(0); PG8_MMA(1, 0, At, B0); PG8_BAR; PG8_SCHED;
            PG8_STAGE(PG8_SB(0, 1), b2 + hstep, voffB);
            PG8_WAIT_V(6); PG8_BAR; PG8_MMA(1, 1, At, B1); PG8_BAR;
            PG8_LDB(B0, 1, 0); PG8_SCHED; PG8_LDA(At, 1, 0); PG8_STAGE(PG8_SA(0, 1), a2 + hstep, voffA);
            PG8_WAIT_L(8); PG8_BAR; PG8_WAIT_L(0); PG8_MMA(0, 0, At, B0); PG8_BAR; PG8_SCHED;
            PG8_LDB(B1, 1, 1); PG8_STAGE(PG8_SB(1, 0), b3, voffB);
            PG8_BAR; PG8_WAIT_L(0); PG8_MMA(0, 1, At, B1); PG8_BAR;
            PG8_LDA(At, 1, 1); PG8_STAGE(PG8_SA(1, 0), a3, voffA);
            PG8_BAR; PG8_WAIT_L(0); PG8_MMA(1, 0, At, B0); PG8_BAR; PG8_SCHED;
            PG8_STAGE(PG8_SB(1, 1), b3 + hstep, voffB);
            PG8_WAIT_V(6); PG8_BAR; PG8_MMA(1, 1, At, B1); PG8_BAR;
            }
        }
        if constexpr (ALIGN_EPI) { if (wr == 0) PG8_BAR; }
        if constexpr (!Epi::AFTER_DRAIN) { int fr2 = fr, fq2 = fq; asm volatile("" : "+v"(fr2), "+v"(fq2)); E(acc, cur, wr, wc, fr2, fq2); S.done(cur); }
        if (!has_next) break;
#pragma unroll
        for (int a = 0; a < 2; ++a)
#pragma unroll
            for (int b = 0; b < 2; ++b)
#pragma unroll
                for (int m = 0; m < 4; ++m)
#pragma unroll
                    for (int n = 0; n < 2; ++n) acc[a][b][m][n] = (f32x4){0.f, 0.f, 0.f, 0.f};
        cur = nxt; cA = nA; cB = nB; ++ui;
        if constexpr (ALIGN_EPI) { if (wr == 1) PG8_BAR; }
    }
    PG8_WAIT_V(0);
    if constexpr (!ALIGN_EPI) { if (wr == 0) PG8_BAR; }
    PG8_BAR;
    if constexpr (Epi::AFTER_DRAIN) { E.fused(acc, cur, wr, wc, fr, fq, lds, wid, lane); S.done(cur); }
#undef PG8_SA
#undef PG8_SB
#undef PG8_STAGE
#undef PG8_LDA
#undef PG8_LDB
#undef PG8_MMA
#undef PG8_WAIT_V
#undef PG8_WAIT_L
#undef PG8_BAR
#undef PG8_SCHED
}
}

namespace pg8 {
struct EpiResF32 {
    static constexpr bool PERM = true, AFTER_DRAIN = false;
    const float* base; bf16_t* hb; int ldc;
    __device__ __forceinline__ void operator()(const f32x4 (&acc)[2][2][4][2], const Unit& u, int wr, int wc, int fr, int fq) const {
        const int row0 = u.pm * BM + wr * 64 + fr, col0 = u.pn * BM + wc * 32 + 8 * fq;
#pragma unroll
        for (int ai = 0; ai < 2; ++ai)
#pragma unroll
            for (int m = 0; m < 4; ++m) { const size_t off = (size_t)(row0 + ai * HALF + m * 16) * ldc + col0;
#pragma unroll
                for (int bj = 0; bj < 2; ++bj) { const f32x4 h0 = *(const f32x4*)(base + off + bj * HALF) + acc[ai][bj][m][0], h1 = *(const f32x4*)(base + off + bj * HALF + 4) + acc[ai][bj][m][1];
                    u32x4 w; w.x = cvt_pk_bf16(h0[0], h0[1]); w.y = cvt_pk_bf16(h0[2], h0[3]); w.z = cvt_pk_bf16(h1[0], h1[1]); w.w = cvt_pk_bf16(h1[2], h1[3]);
                    *(u32x4*)(hb + off + bj * HALF) = w; } }
    }
};

struct EpiBf16Lean {
    static constexpr bool PERM = true, AFTER_DRAIN = false;
    bf16_t* O; int ldc; int pnmask;
    __device__ __forceinline__ void operator()(const f32x4 (&acc)[2][2][4][2], const Unit& u, int wr, int wc, int fr, int fq) const {
        bf16_t* base = O + (size_t)(u.pm * BM + wr * 64 + fr) * ldc + (u.pn & pnmask) * BM + wc * 32 + 8 * fq;
#pragma unroll
        for (int ai = 0; ai < 2; ++ai)
#pragma unroll
            for (int m = 0; m < 4; ++m) { bf16_t* rowp = base + (size_t)(ai * HALF + m * 16) * ldc;
#pragma unroll
                for (int bj = 0; bj < 2; ++bj) { const f32x4 v0 = acc[ai][bj][m][0], v1 = acc[ai][bj][m][1];
                    u32x4 w; w.x = cvt_pk_bf16(v0[0], v0[1]); w.y = cvt_pk_bf16(v0[2], v0[3]); w.z = cvt_pk_bf16(v1[0], v1[1]); w.w = cvt_pk_bf16(v1[2], v1[3]);
                    *(u32x4*)(rowp + bj * HALF) = w; } }
    }
};

template <class Epi, class Sched, bool ALIGN_EPI, bool GATHER>
__device__ __forceinline__ void gemm_phase_g(PG8_LAS unsigned char* lds, const Gemm g, const Sched& S, const Epi& E) {
    const int tid = ltid(), wid = __builtin_amdgcn_readfirstlane(tid >> 6), lane = tid & 63, wr = wid >> 2, wc = wid & 3, fr = lane & 15, fq = lane >> 4;
    const int K = g.K, nt = K / BK;
    unsigned voffB[2];
#pragma unroll
    for (int i = 0; i < 2; ++i) { int R, C; stage_rc(tid * 16 + i * 8192, R, C); const int Rb = Epi::PERM ? ((R & ~31) + perm32(R & 31)) : R; voffB[i] = (unsigned)(Rb * K + C) * 2u; }
    const size_t kstep = (size_t)(BK * 2), hstep = (size_t)HALF * K * 2, tstep = 2 * hstep;
    const unsigned ldsw = (unsigned)wid * 1024u;
    const int aoff = lds_byte(wr * 64 + fr, fq * 8), boff = lds_byte(wc * 32 + fr, fq * 8);
#define PG8_SA(b, h) (((b) * 2 + (h)) * HTB)
#define PG8_SB(b, h) ((4 + (b) * 2 + (h)) * HTB)
#define PG8_STAGE(bufoff, gbase, voff) do { _Pragma("unroll") for (int _i = 0; _i < 2; ++_i) \
        __builtin_amdgcn_global_load_lds((const unsigned*)((const char*)(gbase) + (voff)[_i]), (PG8_LAS unsigned*)(lds + (bufoff) + ldsw + _i * 8192), 16, 0, 0); } while (0)
#define PG8_LDA(dst, b, h) do { _Pragma("unroll") for (int m = 0; m < 4; ++m) _Pragma("unroll") for (int k = 0; k < 2; ++k) dst[m][k] = *(const PG8_LAS bf16x8*)(lds + PG8_SA(b, h) + aoff + m * 2048 + k * 1024); } while (0)
#define PG8_LDB(dst, b, h) do { _Pragma("unroll") for (int n = 0; n < 2; ++n) _Pragma("unroll") for (int k = 0; k < 2; ++k) dst[n][k] = *(const PG8_LAS bf16x8*)(lds + PG8_SB(b, h) + boff + n * 2048 + k * 1024); } while (0)
#define PG8_MMA(ai, bj, At, Bt) do { __builtin_amdgcn_s_setprio(1); _Pragma("unroll") for (int m = 0; m < 4; ++m) _Pragma("unroll") for (int n = 0; n < 2; ++n) _Pragma("unroll") for (int k = 0; k < 2; ++k) \
        acc[ai][bj][m][n] = __builtin_amdgcn_mfma_f32_16x16x32_bf16(Bt[n][k], At[m][k], acc[ai][bj][m][n], 0, 0, 0); __builtin_amdgcn_s_setprio(0); } while (0)
#define PG8_WAIT_V(n) asm volatile("s_waitcnt vmcnt(" #n ")" ::: "memory")
#define PG8_WAIT_L(n) asm volatile("s_waitcnt lgkmcnt(" #n ")" ::: "memory")
#define PG8_BAR __builtin_amdgcn_s_barrier()
#define PG8_SCHED __builtin_amdgcn_sched_barrier(0)
#define PG8_OFFS(u, o) do { _Pragma("unroll") for (int _h = 0; _h < 2; ++_h) _Pragma("unroll") for (int _i = 0; _i < 2; ++_i) { int R_, C_; stage_rc(tid * 16 + _i * 8192, R_, C_); \
        if constexpr (GATHER) o[_h][_i] = S.rowoff(u, _h * HALF + R_) + (unsigned)C_ * 2u; else o[_h][_i] = (unsigned)((_h * HALF + R_) * K + C_) * 2u; } } while (0)
    Unit cur, nxt; int ui = 0;
    if (!S.next(0, cur)) return;
    f32x4 acc[2][2][4][2];
#pragma unroll
    for (int a = 0; a < 2; ++a)
#pragma unroll
        for (int b = 0; b < 2; ++b)
#pragma unroll
            for (int m = 0; m < 4; ++m)
#pragma unroll
                for (int n = 0; n < 2; ++n) acc[a][b][m][n] = (f32x4){0.f, 0.f, 0.f, 0.f};
    bf16x8 At[4][2], B0[2][2], B1[2][2];
    unsigned vo[2][2], nvo[2][2];
    const char* cA = GATHER ? (const char*)g.A : (const char*)g.A + (size_t)cur.pm * tstep; const char* cB = (const char*)g.Bt + (size_t)cur.pn * tstep;
    PG8_OFFS(cur, vo);
    PG8_STAGE(PG8_SB(0, 0), cB, voffB); PG8_STAGE(PG8_SB(0, 1), cB + hstep, voffB); PG8_STAGE(PG8_SA(0, 0), cA, vo[0]); PG8_STAGE(PG8_SA(0, 1), cA, vo[1]);
    if (wr == 1) PG8_BAR;
    PG8_WAIT_V(2); PG8_BAR;
    PG8_STAGE(PG8_SB(1, 0), cB + kstep, voffB); PG8_STAGE(PG8_SA(1, 0), cA + kstep, vo[0]); PG8_STAGE(PG8_SB(1, 1), cB + hstep + kstep, voffB);
    PG8_WAIT_V(6); PG8_BAR;
    for (;;) {
        const bool has_next = S.next(ui + 1, nxt);
        const char* nA = has_next ? (GATHER ? (const char*)g.A : (const char*)g.A + (size_t)nxt.pm * tstep) : cA; const char* nB = has_next ? (const char*)g.Bt + (size_t)nxt.pn * tstep : cB;
        if constexpr (GATHER) { if (has_next) { PG8_OFFS(nxt, nvo); } else { nvo[0][0] = vo[0][0]; nvo[0][1] = vo[0][1]; nvo[1][0] = vo[1][0]; nvo[1][1] = vo[1][1]; } }
#pragma nounroll
        for (int t = 0; t < nt; t += 2) {
            const bool last = (t == nt - 2);
            const char* a1 = cA + (size_t)(t + 1) * kstep;
            const char* a2 = last ? nA : cA + (size_t)(t + 2) * kstep; const char* b2 = last ? nB : cB + (size_t)(t + 2) * kstep;
            const char* a3 = a2 + kstep; const char* b3 = b2 + kstep;
            PG8_LDB(B0, 0, 0); PG8_LDB(B1, 0, 1); PG8_SCHED; PG8_LDA(At, 0, 0); PG8_STAGE(PG8_SA(1, 1), a1, vo[1]);
            if constexpr (GATHER) { if (last) { vo[0][0] = nvo[0][0]; vo[0][1] = nvo[0][1]; vo[1][0] = nvo[1][0]; vo[1][1] = nvo[1][1]; } }
            PG8_WAIT_V(8); PG8_WAIT_L(0); PG8_BAR; PG8_MMA(0, 0, At, B0); PG8_MMA(0, 1, At, B1); PG8_BAR; PG8_SCHED;
            PG8_LDA(At, 0, 1); PG8_STAGE(PG8_SB(0, 0), b2, voffB); PG8_STAGE(PG8_SB(0, 1), b2 + hstep, voffB); PG8_STAGE(PG8_SA(0, 0), a2, vo[0]);
            PG8_WAIT_V(8); PG8_WAIT_L(0); PG8_BAR; PG8_MMA(1, 0, At, B0); PG8_MMA(1, 1, At, B1); PG8_BAR; PG8_SCHED;
            PG8_LDB(B0, 1, 0); PG8_LDB(B1, 1, 1); PG8_SCHED; PG8_LDA(At, 1, 0); PG8_STAGE(PG8_SA(0, 1), a2, vo[1]);
            PG8_WAIT_V(8); PG8_WAIT_L(0); PG8_BAR; PG8_MMA(0, 0, At, B0); PG8_MMA(0, 1, At, B1); PG8_BAR; PG8_SCHED;
            PG8_LDA(At, 1, 1); PG8_STAGE(PG8_SB(1, 0), b3, voffB); PG8_STAGE(PG8_SB(1, 1), b3 + hstep, voffB); PG8_STAGE(PG8_SA(1, 0), a3, vo[0]);
            PG8_WAIT_V(8); PG8_WAIT_L(0); PG8_BAR; PG8_MMA(1, 0, At, B0); PG8_MMA(1, 1, At, B1); PG8_BAR; PG8_SCHED;
        }
        if constexpr (ALIGN_EPI) { if (wr == 0) PG8_BAR; }
        { int fr2 = fr, fq2 = fq; asm volatile("" : "+v"(fr2), "+v"(fq2)); E(acc, cur, wr, wc, fr2, fq2); S.done(cur); }
        if (!has_next) break;
#pragma unroll
        for (int a = 0; a < 2; ++a)
#pragma unroll
            for (int b = 0; b < 2; ++b)
#pragma unroll
                for (int m = 0; m < 4; ++m)
#pragma unroll
                    for (int n = 0; n < 2; ++n) acc[a][b][m][n] = (f32x4){0.f, 0.f, 0.f, 0.f};
        cur = nxt; cA = nA; cB = nB; ++ui;
        if constexpr (ALIGN_EPI) { if (wr == 1) PG8_BAR; }
    }
    PG8_WAIT_V(0);
    if constexpr (!ALIGN_EPI) { if (wr == 0) PG8_BAR; }
    PG8_BAR;
#undef PG8_SA
#undef PG8_SB
#undef PG8_STAGE
#undef PG8_LDA
#undef PG8_LDB
#undef PG8_MMA
#undef PG8_WAIT_V
#undef PG8_WAIT_L
#undef PG8_BAR
#undef PG8_SCHED
#undef PG8_OFFS
}

struct MoeTab { const PG8_LAS int* ncnt; const PG8_LAS int* tbase; const PG8_LAS int* tile_e; };
struct MoeOrder {
    MoeTab tb; int sh  , ntot, G, c; const int* list; unsigned rowbytes;
    __device__ __forceinline__ bool next(int i, Unit& u) const {
        const int L = i * G + c; if (L >= (ntot << sh)) return false;
        const int pm = L >> sh, pl = L & ((1 << sh) - 1); u.pm = pm; u.pn = (tb.tile_e[pm] << sh) + pl; return true;
    }
    __device__ __forceinline__ unsigned rowoff(const Unit& u, int r) const {
        const int e = tb.tile_e[u.pm]; int pos = (u.pm - tb.tbase[e]) * BM + r; const int n = tb.ncnt[e]; pos = pos < n ? pos : n - 1;
        return (unsigned)list[(size_t)e * 32768 + pos] * rowbytes;
    }
    __device__ __forceinline__ void a_ready(const Unit&) const {}
    __device__ __forceinline__ unsigned peek(const Unit&) const { return 0u; }
    __device__ __forceinline__ void a_ready(const Unit&, unsigned) const {}
    __device__ __forceinline__ void done(const Unit&) const {}
};
struct MoeOrderP : MoeOrder {
    unsigned* ready;
    __device__ __forceinline__ void done(const Unit& u) const {
        asm volatile("s_waitcnt vmcnt(0)" ::: "memory");
        if ((threadIdx.x & 63) == 0) __hip_atomic_fetch_add(ready + 64 * u.pm, 1u, __ATOMIC_RELAXED, __HIP_MEMORY_SCOPE_AGENT);
    }
};
struct MoeOrderC : MoeOrder {
    const unsigned* ready; unsigned need; int nh, sk;
    __device__ __forceinline__ bool next(int i, Unit& u) const {
        const int nl = G - nh, heavy = c < nh, ra = heavy ? nl + c : c - nh;
        int L;
        if (heavy) L = sk * nl + i * G + ra; else L = (i < sk) ? i * nl + ra : sk * nl + (i - sk) * G + ra;
        if (L >= (ntot << sh)) return false;
        const int pm = L >> sh, pl = L & ((1 << sh) - 1); u.pm = pm; u.pn = (tb.tile_e[pm] << sh) + pl; return true;
    }
    __device__ __forceinline__ unsigned peek(const Unit& u) const {
        unsigned v = 0u; if (threadIdx.x < 64) v = __hip_atomic_load(ready + 64 * u.pm, __ATOMIC_RELAXED, __HIP_MEMORY_SCOPE_AGENT); return v;
    }
    __device__ __forceinline__ void a_ready(const Unit& u, unsigned peeked) const {
        if (threadIdx.x < 64) {
            unsigned polls = 0, pa = peeked;
            while ((unsigned)__builtin_amdgcn_readfirstlane(pa) < need) {
                if (++polls > (1u << 22)) break;
                __builtin_amdgcn_s_sleep(2); pa = __hip_atomic_load(ready + 64 * u.pm, __ATOMIC_RELAXED, __HIP_MEMORY_SCOPE_AGENT); }
            __builtin_amdgcn_fence(__ATOMIC_ACQUIRE, "agent");
            asm volatile("s_waitcnt vmcnt(0)" ::: "memory");
        }
        asm volatile("" ::: "memory"); __builtin_amdgcn_s_barrier(); asm volatile("" ::: "memory");
    }
    __device__ __forceinline__ void a_ready(const Unit& u) const { a_ready(u, 0u); }
};
struct EpiSwiglu {
    static constexpr bool PERM = false, AFTER_DRAIN = false;
    bf16_t* HG; const float* slr; MoeTab tb;
    __device__ __forceinline__ void operator()(const f32x4 (&acc)[2][2][4][2], const Unit& u, int wr, int wc, int fr, int fq) const {
        const int e = tb.tile_e[u.pm], pl = u.pn & 1, ne = tb.ncnt[e], pos0 = (u.pm - tb.tbase[e]) * BM;
#pragma unroll
        for (int ai = 0; ai < 2; ++ai)
#pragma unroll
            for (int m = 0; m < 4; ++m) {
                const int r = ai * HALF + wr * 64 + m * 16 + fr; int pos = pos0 + r; pos = pos < ne ? pos : ne - 1;
                const float rs = slr[(size_t)e * 32768 + pos];
                bf16_t* dst = HG + (size_t)(u.pm * BM + r) * 256 + pl * 128 + wc * 32 + 4 * fq;
#pragma unroll
                for (int n = 0; n < 2; ++n) { const f32x4 gt = acc[ai][0][m][n] * rs, up = acc[ai][1][m][n] * rs; float hv[4];
#pragma unroll
                    for (int j = 0; j < 4; ++j) hv[j] = gt[j] / (1.0f + __expf(-gt[j])) * up[j];
                    const unsigned long long w = (unsigned long long)cvt_pk_bf16(hv[0], hv[1]) | ((unsigned long long)cvt_pk_bf16(hv[2], hv[3]) << 32);
                    __hip_atomic_store((__attribute__((address_space(1))) unsigned long long*)(dst + n * 16), w, __ATOMIC_RELAXED, __HIP_MEMORY_SCOPE_AGENT); }
            }
    }
};
}
#define LASP __attribute__((address_space(3)))
constexpr int T16_N = 177, AL_T16 = 135168 + 4096;
constexpr int RING_BYTES = 135168, LDS_CTL_OFF = RING_BYTES, LDS_TOTAL = RING_BYTES + 4096 + 4 * T16_N * 16;
constexpr int LC_NCNT = 16, LC_TBASE = 48, LC_TILE_E = 96, LC_LCNT = 448, LC_GBASE = 480;

__device__ __forceinline__ unsigned pk2bf(float lo, float hi) { return (unsigned)f2bf(lo) | ((unsigned)f2bf(hi) << 16); }
__device__ __forceinline__ void tr_item(const float* __restrict__ W, int K, int ldw, int nsrc, const float* __restrict__ gk, bf16_t* dst, int k0, int n0, int lane) {
    const int n = n0 + lane; const bool ok = n < nsrc;
    const float* src = W + (size_t)k0 * ldw + (ok ? n : 0);
    float v[32];
#pragma unroll
    for (int i = 0; i < 32; ++i) v[i] = src[(size_t)i * ldw];
    if (gk) {
#pragma unroll
        for (int i = 0; i < 32; ++i) v[i] *= gk[k0 + i];
    }
    uint4* o = (uint4*)(dst + (size_t)lane * K + k0);
#pragma unroll
    for (int c = 0; c < 4; ++c) { uint4 w; w.x = pk2bf(v[8 * c], v[8 * c + 1]); w.y = pk2bf(v[8 * c + 2], v[8 * c + 3]); w.z = pk2bf(v[8 * c + 4], v[8 * c + 5]); w.w = pk2bf(v[8 * c + 6], v[8 * c + 7]);
        if (!ok) w = make_uint4(0u, 0u, 0u, 0u); o[c] = w; }
}
__device__ void f_expert_weights(const P& p, int bid, int nb) {
    const int tid = ltid(), wave = tid >> 6, lane = tid & 63;
    bf16_t* W13 = (bf16_t*)(p.ws + OFF_W13_T); bf16_t* WD = (bf16_t*)(p.ws + OFF_WD_T);
    constexpr int I_EXP = 32 * 128;
    for (int it = bid * 8 + wave; it < 3 * I_EXP; it += nb * 8) {
        int r = it;
        if (r < 2 * I_EXP) { const int up = r >= I_EXP; if (up) r -= I_EXP; const int e = r >> 7, q = r & 127, kb = q >> 2, nbk = q & 3, n0 = 64 * nbk;
            const float* src = (up ? p.w_up : p.w_gate) + (size_t)e * D_MODEL * EXP_FF;
            tr_item(src, D_MODEL, EXP_FF, EXP_FF, p.ln_ffn, W13 + ((size_t)e * 512 + 256 * (n0 >> 7) + 128 * up + (n0 & 127)) * D_MODEL, 32 * kb, n0, lane); }
        else { r -= 2 * I_EXP; const int e = r >> 7, q = r & 127, kb = q >> 4, nbk = q & 15, n0 = 64 * nbk;
            tr_item(p.w_down + (size_t)e * EXP_FF * D_MODEL, EXP_FF, D_MODEL, D_MODEL, nullptr, WD + ((size_t)e * D_MODEL + n0) * EXP_FF, 32 * kb, n0, lane); }
    }
}
constexpr int EW_ITEMS = 3 * 32 * 128;
__device__ __forceinline__ void ew_load(const P& p, int it, int lane, float (&v)[32]) {
    constexpr int I_EXP = 32 * 128;
    const float* src; int ldw;
    if (it < 2 * I_EXP) { const int up = it >= I_EXP; const int r = it - up * I_EXP; const int e = r >> 7, q = r & 127, kb = q >> 2, nbk = q & 3;
        src = (up ? p.w_up : p.w_gate) + (size_t)e * D_MODEL * EXP_FF + (size_t)(32 * kb) * EXP_FF + 64 * nbk + lane; ldw = EXP_FF; }
    else { const int r = it - 2 * I_EXP; const int e = r >> 7, q = r & 127, kb = q >> 4, nbk = q & 15;
        src = p.w_down + (size_t)e * EXP_FF * D_MODEL + (size_t)(32 * kb) * D_MODEL + 64 * nbk + lane; ldw = D_MODEL; }
#pragma unroll
    for (int i = 0; i < 32; ++i) v[i] = src[(size_t)i * ldw];
}
__device__ __forceinline__ void ew_store(const P& p, int it, int lane, float (&v)[32]) {
    constexpr int I_EXP = 32 * 128;
    bf16_t* W13 = (bf16_t*)(p.ws + OFF_W13_T); bf16_t* WD = (bf16_t*)(p.ws + OFF_WD_T);
    bf16_t* dst;
    if (it < 2 * I_EXP) { const int up = it >= I_EXP; const int r = it - up * I_EXP; const int e = r >> 7, q = r & 127, kb = q >> 2, nbk = q & 3, n0 = 64 * nbk;
        const float* gk = p.ln_ffn + 32 * kb;
#pragma unroll
        for (int i = 0; i < 32; ++i) v[i] *= gk[i];
        dst = W13 + ((size_t)e * 512 + 256 * (n0 >> 7) + 128 * up + (n0 & 127) + lane) * D_MODEL + 32 * kb; }
    else { const int r = it - 2 * I_EXP; const int e = r >> 7, q = r & 127, kb = q >> 4, nbk = q & 15;
        dst = WD + ((size_t)e * D_MODEL + 64 * nbk + lane) * EXP_FF + 32 * kb; }
    pg8::u32x4* o = (pg8::u32x4*)dst;
#pragma unroll
    for (int c = 0; c < 4; ++c) { pg8::u32x4 w; w.x = pg8::cvt_pk_bf16(v[8 * c], v[8 * c + 1]); w.y = pg8::cvt_pk_bf16(v[8 * c + 2], v[8 * c + 3]); w.z = pg8::cvt_pk_bf16(v[8 * c + 4], v[8 * c + 5]); w.w = pg8::cvt_pk_bf16(v[8 * c + 6], v[8 * c + 7]); o[c] = w; }
}
__device__ void f_prologue(const P& p, int bid, int nb, float* sm) {
    const int tid = ltid(), wave = tid >> 6, lane = tid & 63;
    const int gw = bid * 8 + wave, ngw = nb * 8;
    bf16_t* WIN_T = (bf16_t*)(p.ws + OFF_WIN_T); bf16_t* WOUT_T = (bf16_t*)(p.ws + OFF_WOUT_T);
    constexpr int I_IN = 32 * (LDU / 64), I_OUT = 32 * 16;
    for (int it = gw; it < I_IN + I_OUT; it += ngw) {
        if (it < I_IN) { const int kb = it / (LDU / 64), nbk = it % (LDU / 64); tr_item(p.w_in, D_MODEL, D_IN, D_IN, p.ln_mix, WIN_T + (size_t)(64 * nbk) * D_MODEL, 32 * kb, 64 * nbk, lane); }
        else { const int r = it - I_IN, kb = r >> 4, nbk = r & 15; tr_item(p.w_out, D_MODEL, D_MODEL, D_MODEL, nullptr, WOUT_T + (size_t)(64 * nbk) * D_MODEL, 32 * kb, 64 * nbk, lane); }
    }
    { bf16_t* W1T = (bf16_t*)(p.ws + OFF_W1T); bf16_t* W2T = (bf16_t*)(p.ws + OFF_W2T); float* B1 = (float*)(p.ws + OFF_B1);
      for (int it = gw; it < 2 * 128 + 2 * 4; it += ngw) {
          if (it < 256) { const int kv = it >> 7, q = it & 127, kb = q >> 1, nbk = q & 1; tr_item(kv ? p.cv1 : p.ck1, 2048, 128, 128, nullptr, W1T + ((size_t)kv * 128 + 64 * nbk) * 2048, 32 * kb, 64 * nbk, lane); }
          else { const int r = it - 256, kv = r >> 2, kb = r & 3; tr_item(kv ? p.cv2 : p.ck2, 128, 64, 64, nullptr, W2T + (size_t)kv * 64 * 128, 32 * kb, 0, lane); }
      }
      for (int o = gw; o < 256; o += ngw) { const int kv = o >> 7, n = o & 127; const float* w1 = kv ? p.cv1 : p.ck1; const float* pos = kv ? p.pos_v : p.pos_k;
          float a = 0.f; for (int k = lane; k < 2048; k += 64) a = fmaf(pos[k], w1[(size_t)k * 128 + n], a);
          a = wave_sum(a); if (lane == 0) B1[o] = a; } }
    { bf16_t* RH = (bf16_t*)(p.ws + OFF_RW_HI); bf16_t* RL = (bf16_t*)(p.ws + OFF_RW_LO);
      for (int i = bid * NT + tid; i < 48 * 1024; i += nb * NT) { const int c = i >> 10, k = i & 1023;
          const float w = (c < 4 ? p.wg[k * 4 + c] : (c < 36 ? p.we[k * 32 + (c - 4)] : 0.f)) * p.ln_ffn[k];
          const bf16_t hi = f2bf(w); RH[i] = hi; RL[i] = f2bf(w - bf2f(hi)); } }
    bf16_t* XN = (bf16_t*)(p.ws + OFF_XN);
    for (int row = gw; row < T_TOK; row += ngw) {
        const float4* xr = (const float4*)(p.x + (size_t)row * D_MODEL) + lane;
        float4 v[4]; float s = 0.f;
#pragma unroll
        for (int j = 0; j < 4; ++j) { v[j] = xr[64 * j]; s += (v[j].x * v[j].x + v[j].y * v[j].y) + (v[j].z * v[j].z + v[j].w * v[j].w); }
        const float rs = 1.0f / sqrtf(wave_sum(s) * (1.0f / D_MODEL) + EPS);
        uint2* o8 = (uint2*)(XN + (size_t)row * D_MODEL) + lane;
#pragma unroll
        for (int j = 0; j < 4; ++j) o8[64 * j] = make_uint2(pk2bf(v[j].x * rs, v[j].y * rs), pk2bf(v[j].z * rs, v[j].w * rs));
    }
    float* biasd = (float*)(p.ws + OFF_BIASD);
    for (int i = bid * NT + tid; i < 16 * 2048; i += nb * NT) { const int h = i >> 11, d = i & 2047; biasd[i] = p.rel_bias[t5_bucket(d) * 16 + h]; }
    bf16_t* kc = (bf16_t*)(p.ws + OFF_KCMP); bf16_t* vc = (bf16_t*)(p.ws + OFF_VCMP);
    for (int i = bid * NT + tid; i < 32 * 64; i += nb * NT) { const int bg = i >> 6, d = i & 63; kc[(bg * 128 + 127) * 64 + d] = 0; vc[(bg * 128 + 127) * 64 + d] = 0; }
}

typedef short bf16x8_t __attribute__((ext_vector_type(8)));
typedef float f32x4_t __attribute__((ext_vector_type(4)));
typedef float f32x2_t __attribute__((ext_vector_type(2)));
typedef float f32x16_t __attribute__((ext_vector_type(16)));
typedef short v4i16_t __attribute__((ext_vector_type(4)));
#define MFMA32(a, b, c) __builtin_amdgcn_mfma_f32_32x32x16_bf16(a, b, c, 0, 0, 0)
constexpr int SLOT_V = 8192, SLOT_BYTES = 16384, NSLOT = 3;
constexpr int AL_RING = 0, AL_TAB = NSLOT * SLOT_BYTES, AL_SEL = AL_TAB + 2048, AL_TAB4 = AL_SEL + 512, T4_N = 257, T4_OFF = 64, AL_IMP = AL_TAB4 + 4 * T4_N * 16;
constexpr float LOG2E = 1.4426950408889634f, NEG_BIG = -1.0e30f;
typedef unsigned u32x4_t __attribute__((ext_vector_type(4)));
__device__ __forceinline__ void dma_tile(const bf16_t* k0, const bf16_t* v0, int pitch, LASP unsigned char* slot, int wave, int lane) {
    const bf16_t* ks = k0 + (size_t)lane * pitch + wave * 8;
    const bf16_t* vs = v0 + (size_t)(16 * (wave & 3) + (lane >> 2)) * pitch + (wave >> 2) * 32 + (lane & 3) * 8;
    __builtin_amdgcn_global_load_lds((const unsigned*)ks, (LASP unsigned*)(slot + wave * 1024), 16, 0, 0);
    __builtin_amdgcn_global_load_lds((const unsigned*)vs, (LASP unsigned*)(slot + SLOT_V + wave * 1024), 16, 0, 0);
}
__device__ __forceinline__ void glds16(const void* gsrc, unsigned lds_dst) { unsigned keep;
    asm volatile("s_mov_b32 %0, m0\n\ts_mov_b32 m0, %2\n\ts_nop 0\n\tglobal_load_lds_dwordx4 %1, off\n\ts_mov_b32 m0, %0" : "=&s"(keep) : "v"(gsrc), "s"(lds_dst) : "memory"); }
__device__ __forceinline__ void dma_k(const bf16_t* k0, int pitch, unsigned slot, int wave, int lane) { glds16(k0 + (size_t)lane * pitch + wave * 8, (unsigned)__builtin_amdgcn_readfirstlane(slot + wave * 1024)); }
__device__ __forceinline__ void dma_v(const bf16_t* v0, int pitch, unsigned slot, int wave, int lane) { glds16(v0 + (size_t)(16 * (wave & 3) + (lane >> 2)) * pitch + (wave >> 2) * 32 + (lane & 3) * 8, (unsigned)__builtin_amdgcn_readfirstlane(slot + SLOT_V + wave * 1024)); }
#define DMA_WAIT_BAR(N) asm volatile("s_waitcnt vmcnt(" #N ") lgkmcnt(0)\n\ts_barrier" ::: "memory")
#define KRD(dst, ka, off) asm volatile("ds_read_b128 %0, %1 offset:%2" : "=&v"(dst) : "v"(ka), "i"(off) : "memory")
#define LGKM_WAIT2(n, a, b) asm volatile("s_waitcnt lgkmcnt(" #n ")" : "+v"(a), "+v"(b) :: "memory")
template <int NS, int S0>
__device__ __forceinline__ void qk_tile(f32x16_t& p0, f32x16_t& p1, float init, const LASP unsigned char* kt, const bf16x8_t* q, int r32, int h) {
    const unsigned ka = (unsigned)(uintptr_t)kt + (unsigned)(h * 1024 + r32 * 16 + S0 * 2048);
    bf16x8_t a0[NS], a1[NS];
    KRD(a0[0], ka, 0); KRD(a1[0], ka, 512); KRD(a0[1], ka, 2048); KRD(a1[1], ka, 2560);
    if constexpr (NS == 4) { KRD(a0[2], ka, 4096); KRD(a1[2], ka, 4608); KRD(a0[3], ka, 6144); KRD(a1[3], ka, 6656); }
    { const f32x16_t iv = {init, init, init, init, init, init, init, init, init, init, init, init, init, init, init, init}; p0 = iv; p1 = iv; }
    if constexpr (NS == 4) {
        LGKM_WAIT2(6, a0[0], a1[0]); p0 = MFMA32(a0[0], q[0], p0); p1 = MFMA32(a1[0], q[0], p1);
        LGKM_WAIT2(4, a0[1], a1[1]); p0 = MFMA32(a0[1], q[1], p0); p1 = MFMA32(a1[1], q[1], p1);
        LGKM_WAIT2(2, a0[2], a1[2]); p0 = MFMA32(a0[2], q[2], p0); p1 = MFMA32(a1[2], q[2], p1);
        LGKM_WAIT2(0, a0[3], a1[3]); p0 = MFMA32(a0[3], q[3], p0); p1 = MFMA32(a1[3], q[3], p1);
    } else {
        LGKM_WAIT2(2, a0[0], a1[0]); p0 = MFMA32(a0[0], q[0], p0); p1 = MFMA32(a1[0], q[0], p1);
        LGKM_WAIT2(0, a0[1], a1[1]); p0 = MFMA32(a0[1], q[1], p0); p1 = MFMA32(a1[1], q[1], p1);
    }
}
__device__ __forceinline__ void xf_gen(f32x16_t& p0, f32x16_t& p1, int dqh, unsigned wlim, const LASP float* tab) {
#pragma unroll
    for (int g4 = 0; g4 < 4; ++g4) {
        float b0[4], b1[4];
#pragma unroll
        for (int i = 0; i < 4; ++i) { const int kk = i + 8 * g4; const unsigned d0 = (unsigned)(dqh - kk), d1 = (unsigned)(dqh - kk - 32); b0[i] = tab[d0 < 127u ? d0 : 127u]; b1[i] = tab[d1 < 127u ? d1 : 127u]; }
#pragma unroll
        for (int i = 0; i < 4; ++i) { const int r = 4 * g4 + i, kk = i + 8 * g4; const unsigned d0 = (unsigned)(dqh - kk), d1 = (unsigned)(dqh - kk - 32);
            const float s0 = p0[r] + b0[i], s1 = p1[r] + b1[i]; p0[r] = d0 < wlim ? s0 : NEG_BIG; p1[r] = d1 < wlim ? s1 : NEG_BIG; }
        __builtin_amdgcn_sched_barrier(0);
    }
}
template <bool MASK>
__device__ __forceinline__ void xf4(f32x16_t& p0, f32x16_t& p1, int dqh, unsigned wlim, const LASP f32x4_t* tab4) {
    const LASP f32x4_t* tq = tab4 + ((dqh < -8 ? -8 : (dqh > 192 ? 192 : dqh)) + T4_OFF - 56);
#pragma unroll
    for (int G = 0; G < 4; ++G) {
        const int D0 = dqh - 8 * G, D1 = D0 - 32;
        const f32x4_t e0 = tq[56 - 8 * G], e1 = tq[24 - 8 * G];
        if (MASK) { _Pragma("unroll") for (int i = 0; i < 4; ++i) { const int r = 4 * G + i; const float s0 = p0[r] + e0[i], s1 = p1[r] + e1[i];
            p0[r] = (unsigned)(D0 - i) < wlim ? s0 : NEG_BIG; p1[r] = (unsigned)(D1 - i) < wlim ? s1 : NEG_BIG; } }
        else { const f32x4_t u0 = (f32x4_t){p0[4 * G], p0[4 * G + 1], p0[4 * G + 2], p0[4 * G + 3]} + e0, u1 = (f32x4_t){p1[4 * G], p1[4 * G + 1], p1[4 * G + 2], p1[4 * G + 3]} + e1;
            _Pragma("unroll") for (int i = 0; i < 4; ++i) { p0[4 * G + i] = u0[i]; p1[4 * G + i] = u1[i]; } }
        if (G & 1) __builtin_amdgcn_sched_barrier(0);
    }
}
__device__ __forceinline__ void xf4b(f32x16_t& p0, f32x16_t& p1, int dqh, const LASP f32x4_t* tab4) {
    const LASP f32x4_t* tq = tab4 + ((dqh < -8 ? -8 : (dqh > 192 ? 192 : dqh)) + T4_OFF - 56);
#pragma unroll
    for (int G = 0; G < 4; ++G) {
        const int D0 = dqh - 8 * G, D1 = D0 - 32;
        const f32x4_t e0 = tq[56 - 8 * G], e1 = tq[24 - 8 * G];
        const f32x4_t u0 = (f32x4_t){p0[4 * G], p0[4 * G + 1], p0[4 * G + 2], p0[4 * G + 3]} + e0, u1 = (f32x4_t){p1[4 * G], p1[4 * G + 1], p1[4 * G + 2], p1[4 * G + 3]} + e1;
#pragma unroll
        for (int i = 0; i < 4; ++i) { p0[4 * G + i] = u0[i]; p1[4 * G + i] = u1[i]; }
    }
}
template <bool MASK>
__device__ __forceinline__ void xf4_2(f32x16_t& a0, f32x16_t& a1, f32x16_t& b0, f32x16_t& b1, int dqh, const LASP f32x4_t* tab4) {
    const LASP f32x4_t* tq = tab4 + ((dqh < -8 ? -8 : (dqh > 192 ? 192 : dqh)) + T4_OFF - 56);
#pragma unroll
    for (int G = 0; G < 4; ++G) {
        const int D0 = dqh - 8 * G, D1 = D0 - 32;
        const f32x4_t e0 = tq[56 - 8 * G], e1 = tq[24 - 8 * G];
        if (MASK) { _Pragma("unroll") for (int i = 0; i < 4; ++i) { const int r = 4 * G + i; const bool v0 = (D0 - i) >= 0, v1 = (D1 - i) >= 0;
            const float sa0 = a0[r] + e0[i], sa1 = a1[r] + e1[i], sb0 = b0[r] + e0[i], sb1 = b1[r] + e1[i];
            a0[r] = v0 ? sa0 : NEG_BIG; a1[r] = v1 ? sa1 : NEG_BIG; b0[r] = v0 ? sb0 : NEG_BIG; b1[r] = v1 ? sb1 : NEG_BIG; } }
        else { const f32x4_t ua0 = (f32x4_t){a0[4 * G], a0[4 * G + 1], a0[4 * G + 2], a0[4 * G + 3]} + e0, ua1 = (f32x4_t){a1[4 * G], a1[4 * G + 1], a1[4 * G + 2], a1[4 * G + 3]} + e1;
            const f32x4_t ub0 = (f32x4_t){b0[4 * G], b0[4 * G + 1], b0[4 * G + 2], b0[4 * G + 3]} + e0, ub1 = (f32x4_t){b1[4 * G], b1[4 * G + 1], b1[4 * G + 2], b1[4 * G + 3]} + e1;
            _Pragma("unroll") for (int i = 0; i < 4; ++i) { a0[4 * G + i] = ua0[i]; a1[4 * G + i] = ua1[i]; b0[4 * G + i] = ub0[i]; b1[4 * G + i] = ub1[i]; } }
        if (G & 1) __builtin_amdgcn_sched_barrier(0);
    }
}
__device__ __forceinline__ void t16_fill(LASP f32x4_t* t16, const LASP float* tab, int idx) {
    const int D = idx - 1; f32x4_t e;
#pragma unroll
    for (int i = 0; i < 4; ++i) { const int d = D - 16 * i; e[i] = d < 0 ? NEG_BIG : tab[d > 127 ? 127 : d]; }
    t16[idx] = e;
}
__device__ __forceinline__ void t4_fill(LASP f32x4_t* t4, const LASP float* tab, int idx) {
    const int D = idx - T4_OFF; f32x4_t e;
#pragma unroll
    for (int i = 0; i < 4; ++i) { const int d = D - i; e[i] = d < 0 ? NEG_BIG : tab[d > 127 ? 127 : d]; }
    t4[idx] = e;
}
__device__ __forceinline__ float max16(const f32x16_t& a) {
    float m0 = fmaxf(fmaxf(a[0], a[1]), a[2]), m1 = fmaxf(fmaxf(a[3], a[4]), a[5]), m2 = fmaxf(fmaxf(a[6], a[7]), a[8]), m3 = fmaxf(fmaxf(a[9], a[10]), a[11]);
    m0 = fmaxf(fmaxf(m0, a[12]), a[13]); m1 = fmaxf(fmaxf(m1, a[14]), a[15]);
    return fmaxf(fmaxf(m0, m1), fmaxf(m2, m3));
}
__device__ __forceinline__ float sum16(const f32x16_t& a) { return ((a[0] + a[1]) + (a[2] + a[3])) + ((a[4] + a[5]) + (a[6] + a[7])) + (((a[8] + a[9]) + (a[10] + a[11])) + ((a[12] + a[13]) + (a[14] + a[15]))); }
__device__ __forceinline__ bf16x8_t pack8(const f32x16_t& a, int b) {
    u32x4_t w; w[0] = pg8::cvt_pk_bf16(a[b], a[b + 1]); w[1] = pg8::cvt_pk_bf16(a[b + 2], a[b + 3]); w[2] = pg8::cvt_pk_bf16(a[b + 4], a[b + 5]); w[3] = pg8::cvt_pk_bf16(a[b + 6], a[b + 7]);
    return __builtin_bit_cast(bf16x8_t, w);
}
constexpr float SM_THR = 8.0f;
struct AttnSt { float m, l; f32x16_t o[2]; };
__device__ __forceinline__ void st_init(AttnSt& s, float m0) { s.m = m0 + SM_THR; s.l = 0.f;     const f32x16_t z = {0.f, 0.f, 0.f, 0.f, 0.f, 0.f, 0.f, 0.f, 0.f, 0.f, 0.f, 0.f, 0.f, 0.f, 0.f, 0.f}; s.o[0] = z; s.o[1] = z; }
#define TRRD(dst, va, off) asm volatile("ds_read_b64_tr_b16 %0, %1 offset:%2" : "=&v"(dst) : "v"(va), "i"(off) : "memory")
#define LGKM_WAIT4(n, a, b, c, d, e, f, g, hh) asm volatile("s_waitcnt lgkmcnt(" #n ")" : "+v"(a), "+v"(b), "+v"(c), "+v"(d), "+v"(e), "+v"(f), "+v"(g), "+v"(hh) :: "memory")
#define VFRAG(l, hgh) ((bf16x8_t){l[0], l[1], l[2], l[3], hgh[0], hgh[1], hgh[2], hgh[3]})
__device__ __forceinline__ void pv_tile(f32x16_t (&o)[2], const LASP unsigned char* vb, const bf16x8_t (&pf)[4]) {
    const unsigned va = (unsigned)(uintptr_t)vb;
    v4i16_t l0[4], h0[4], l1[4], h1[4];
    TRRD(l0[0], va, 0); TRRD(h0[0], va, 512); TRRD(l1[0], va, 4096); TRRD(h1[0], va, 4608); TRRD(l0[1], va, 1024); TRRD(h0[1], va, 1536); TRRD(l1[1], va, 5120); TRRD(h1[1], va, 5632);
    TRRD(l0[2], va, 2048); TRRD(h0[2], va, 2560); TRRD(l1[2], va, 6144); TRRD(h1[2], va, 6656); TRRD(l0[3], va, 3072); TRRD(h0[3], va, 3584); TRRD(l1[3], va, 7168); TRRD(h1[3], va, 7680);
    LGKM_WAIT4(8, l0[0], h0[0], l1[0], h1[0], l0[1], h0[1], l1[1], h1[1]);
    o[0] = MFMA32(VFRAG(l0[0], h0[0]), pf[0], o[0]); o[1] = MFMA32(VFRAG(l1[0], h1[0]), pf[0], o[1]);
    o[0] = MFMA32(VFRAG(l0[1], h0[1]), pf[1], o[0]); o[1] = MFMA32(VFRAG(l1[1], h1[1]), pf[1], o[1]);
    LGKM_WAIT4(0, l0[2], h0[2], l1[2], h1[2], l0[3], h0[3], l1[3], h1[3]);
    o[0] = MFMA32(VFRAG(l0[2], h0[2]), pf[2], o[0]); o[1] = MFMA32(VFRAG(l1[2], h1[2]), pf[2], o[1]);
    o[0] = MFMA32(VFRAG(l0[3], h0[3]), pf[3], o[0]); o[1] = MFMA32(VFRAG(l1[3], h1[3]), pf[3], o[1]);
}
struct VFr1 { v4i16_t l0[4], h0[4], l1[4], h1[4]; };
__device__ __forceinline__ void pv_read1(VFr1& f, const LASP unsigned char* vb) {
    const unsigned va = (unsigned)(uintptr_t)vb;
    TRRD(f.l0[0], va, 0); TRRD(f.h0[0], va, 512); TRRD(f.l1[0], va, 4096); TRRD(f.h1[0], va, 4608); TRRD(f.l0[1], va, 1024); TRRD(f.h0[1], va, 1536); TRRD(f.l1[1], va, 5120); TRRD(f.h1[1], va, 5632);
    TRRD(f.l0[2], va, 2048); TRRD(f.h0[2], va, 2560); TRRD(f.l1[2], va, 6144); TRRD(f.h1[2], va, 6656); TRRD(f.l0[3], va, 3072); TRRD(f.h0[3], va, 3584); TRRD(f.l1[3], va, 7168); TRRD(f.h1[3], va, 7680);
}
__device__ __forceinline__ void pv_mma1(f32x16_t (&o)[2], VFr1& f, const bf16x8_t (&pf)[4]) {
    LGKM_WAIT4(8, f.l0[0], f.h0[0], f.l1[0], f.h1[0], f.l0[1], f.h0[1], f.l1[1], f.h1[1]);
    o[0] = MFMA32(VFRAG(f.l0[0], f.h0[0]), pf[0], o[0]); o[1] = MFMA32(VFRAG(f.l1[0], f.h1[0]), pf[0], o[1]);
    o[0] = MFMA32(VFRAG(f.l0[1], f.h0[1]), pf[1], o[0]); o[1] = MFMA32(VFRAG(f.l1[1], f.h1[1]), pf[1], o[1]);
    LGKM_WAIT4(0, f.l0[2], f.h0[2], f.l1[2], f.h1[2], f.l0[3], f.h0[3], f.l1[3], f.h1[3]);
    o[0] = MFMA32(VFRAG(f.l0[2], f.h0[2]), pf[2], o[0]); o[1] = MFMA32(VFRAG(f.l1[2], f.h1[2]), pf[2], o[1]);
    o[0] = MFMA32(VFRAG(f.l0[3], f.h0[3]), pf[3], o[0]); o[1] = MFMA32(VFRAG(f.l1[3], f.h1[3]), pf[3], o[1]);
}
__device__ __forceinline__ void pv_tile2(f32x16_t (&oa)[2], f32x16_t (&ob)[2], const LASP unsigned char* vb, const bf16x8_t (&pfa)[4], const bf16x8_t (&pfb)[4]) {
    const unsigned va = (unsigned)(uintptr_t)vb;
    v4i16_t l0[4], h0[4], l1[4], h1[4];
    TRRD(l0[0], va, 0); TRRD(h0[0], va, 512); TRRD(l0[1], va, 1024); TRRD(h0[1], va, 1536); TRRD(l0[2], va, 2048); TRRD(h0[2], va, 2560); TRRD(l0[3], va, 3072); TRRD(h0[3], va, 3584);
    TRRD(l1[0], va, 4096); TRRD(h1[0], va, 4608); TRRD(l1[1], va, 5120); TRRD(h1[1], va, 5632); TRRD(l1[2], va, 6144); TRRD(h1[2], va, 6656); TRRD(l1[3], va, 7168); TRRD(h1[3], va, 7680);
    LGKM_WAIT4(8, l0[0], h0[0], l0[1], h0[1], l0[2], h0[2], l0[3], h0[3]);
#pragma unroll
    for (int ks = 0; ks < 4; ++ks) { const bf16x8_t a = VFRAG(l0[ks], h0[ks]); oa[0] = MFMA32(a, pfa[ks], oa[0]); ob[0] = MFMA32(a, pfb[ks], ob[0]); }
    LGKM_WAIT4(0, l1[0], h1[0], l1[1], h1[1], l1[2], h1[2], l1[3], h1[3]);
#pragma unroll
    for (int ks = 0; ks < 4; ++ks) { const bf16x8_t a = VFRAG(l1[ks], h1[ks]); oa[1] = MFMA32(a, pfa[ks], oa[1]); ob[1] = MFMA32(a, pfb[ks], ob[1]); }
}
template <bool MASKQ>
__device__ __forceinline__ void sm_pv(AttnSt& st, f32x16_t& p0, f32x16_t& p1, const LASP unsigned char* vb, bool sel) {
    float mx = pl32_max(fmaxf(max16(p0), max16(p1)));
    if (MASKQ) mx = sel ? mx : NEG_BIG;
    if (__any(mx > SM_THR)) {
        const float d = mx > SM_THR ? mx : 0.f, f = __builtin_amdgcn_exp2f(-d);
        st.m += d; st.l *= f;
#pragma unroll
        for (int r = 0; r < 16; ++r) { st.o[0][r] *= f; st.o[1][r] *= f; p0[r] -= d; p1[r] -= d; }
    }
#pragma unroll
    for (int r = 0; r < 16; ++r) { p0[r] = __builtin_amdgcn_exp2f(p0[r]); p1[r] = __builtin_amdgcn_exp2f(p1[r]); }
    float rs = sum16(p0) + sum16(p1);
    if (MASKQ) rs = sel ? rs : 0.f;
    st.l += rs;
    bf16x8_t pf[4]; pf[0] = pack8(p0, 0); pf[1] = pack8(p0, 8); pf[2] = pack8(p1, 0); pf[3] = pack8(p1, 8);
    if (MASKQ) {
#pragma unroll
        for (int k = 0; k < 4; ++k) { u32x4_t w = __builtin_bit_cast(u32x4_t, pf[k]); w[0] = sel ? w[0] : 0u; w[1] = sel ? w[1] : 0u; w[2] = sel ? w[2] : 0u; w[3] = sel ? w[3] : 0u; pf[k] = __builtin_bit_cast(bf16x8_t, w); }
    }
    pv_tile(st.o, vb, pf);
}
__device__ __forceinline__ void sm_only(AttnSt& st, f32x16_t& p0, f32x16_t& p1, bf16x8_t (&pf)[4]) {
    const float mx = pl32_max(fmaxf(max16(p0), max16(p1)));
    if (__any(mx > SM_THR)) {
        const float d = mx > SM_THR ? mx : 0.f, f = __builtin_amdgcn_exp2f(-d);
        st.m += d; st.l *= f;
#pragma unroll
        for (int r = 0; r < 16; ++r) { st.o[0][r] *= f; st.o[1][r] *= f; p0[r] -= d; p1[r] -= d; }
    }
#pragma unroll
    for (int r = 0; r < 16; ++r) { p0[r] = __builtin_amdgcn_exp2f(p0[r]); p1[r] = __builtin_amdgcn_exp2f(p1[r]); }
    st.l += sum16(p0) + sum16(p1);
    pf[0] = pack8(p0, 0); pf[1] = pack8(p0, 8); pf[2] = pack8(p1, 0); pf[3] = pack8(p1, 8);
}
__device__ __forceinline__ bf16x8_t q_scaled(const bf16_t* qp, float c) {
    const u32x4_t v = *(const u32x4_t*)qp; u32x4_t w;
#pragma unroll
    for (int i = 0; i < 4; ++i) w[i] = pg8::cvt_pk_bf16(__uint_as_float(v[i] << 16) * c, __uint_as_float(v[i] & 0xffff0000u) * c);
    return __builtin_bit_cast(bf16x8_t, w);
}

template <int NS>
__device__ __forceinline__ float self_score(const bf16x8_t* q, const bf16_t* krow, int h) {
    float s = 0.f;
#pragma unroll
    for (int i = 0; i < NS; ++i) { const u32x4_t kv = *(const u32x4_t*)(krow + 16 * i + 8 * h); const u32x4_t qv = __builtin_bit_cast(u32x4_t, q[i]);
#pragma unroll
        for (int e = 0; e < 4; ++e) { s = fmaf(__uint_as_float(qv[e] << 16), __uint_as_float(kv[e] << 16), s); s = fmaf(__uint_as_float(qv[e] & 0xffff0000u), __uint_as_float(kv[e] & 0xffff0000u), s); } }
    return pl32_sum(s);
}

__device__ void f_cmp(const P& p, int bid, int nb, LASP unsigned char* lds) {
    const int tid = ltid(), wave = __builtin_amdgcn_readfirstlane(tid >> 6), lane = tid & 63, r32 = lane & 31, h = lane >> 5;
    const bf16_t* U = (const bf16_t*)(p.ws + OFF_U);
    constexpr int HSTR = 136;
    LASP float* red = (LASP float*)lds + (wave & 3) * 1024;
    LASP bf16_t* hid = (LASP bf16_t*)(lds + 16384);
    for (int unit = bid; unit < 256; unit += nb) {
        const int pr = unit >> 2, ct = unit & 3, kv = pr & 1, bg = pr >> 1, b = bg >> 1, g = bg & 1;
        const int col0 = (kv ? C_VC : C_KC) + g * 64;
        const bf16_t* W1T = (const bf16_t*)(p.ws + OFF_W1T) + (size_t)kv * 128 * 2048; const bf16_t* W2T = (const bf16_t*)(p.ws + OFF_W2T) + (size_t)kv * 64 * 128;
        const float* B1 = (const float*)(p.ws + OFF_B1) + kv * 128;
        const int nblk = wave & 3, khalf = wave >> 2;
        const int tokb = 16 * (ct * 32 + r32);
        const bf16_t* Ub = U + (size_t)b * SEQ * LDU + col0 + 8 * h;
        const bf16_t* wp = W1T + (size_t)(nblk * 32 + r32) * 2048 + 8 * h;
        f32x16_t acc = {0.f, 0.f, 0.f, 0.f, 0.f, 0.f, 0.f, 0.f, 0.f, 0.f, 0.f, 0.f, 0.f, 0.f, 0.f, 0.f};
#pragma unroll 8
        for (int s = khalf * 64; s < khalf * 64 + 64; ++s) {
            int tok = tokb + (s >> 2); tok = tok < SEQ ? tok : SEQ - 1;
            const bf16x8_t a = *(const bf16x8_t*)(Ub + (size_t)tok * LDU + (s & 3) * 16);
            const bf16x8_t bb = *(const bf16x8_t*)(wp + 16 * s);
            acc = MFMA32(a, bb, acc);
        }
        if (khalf == 1) {
#pragma unroll
            for (int r = 0; r < 16; ++r) red[r * 64 + lane] = acc[r];
        }
        __syncthreads();
        if (khalf == 0) { const int n = nblk * 32 + r32; const float b1 = B1[n];
#pragma unroll
            for (int r = 0; r < 16; ++r) { const float v = acc[r] + red[r * 64 + lane] + b1; const float u = 0.7978845608028654f * (v + 0.044715f * v * v * v);
                const float th = 1.0f - 2.0f / (__expf(2.0f * u) + 1.0f);
                hid[((r & 3) + 8 * (r >> 2) + 4 * h) * HSTR + n] = f2bf(0.5f * v * (1.0f + th)); } }
        __syncthreads();
        if (wave < 2) {
            f32x16_t a2 = {0.f, 0.f, 0.f, 0.f, 0.f, 0.f, 0.f, 0.f, 0.f, 0.f, 0.f, 0.f, 0.f, 0.f, 0.f, 0.f};
#pragma unroll
            for (int s = 0; s < 8; ++s) { const bf16x8_t a = *(const LASP bf16x8_t*)(hid + r32 * HSTR + 16 * s + 8 * h); const bf16x8_t bb = *(const bf16x8_t*)(W2T + (size_t)(wave * 32 + r32) * 128 + 16 * s + 8 * h);
                a2 = MFMA32(a, bb, a2); }
            bf16_t* dst = (bf16_t*)(p.ws + (kv ? OFF_VCMP : OFF_KCMP)) + (size_t)bg * 128 * 64 + wave * 32 + r32;
#pragma unroll
            for (int r = 0; r < 16; ++r) { const int row = ct * 32 + (r & 3) + 8 * (r >> 2) + 4 * h; dst[row * 64] = row < N_CMP ? f2bf(a2[r]) : (bf16_t)0; }
        }
        __syncthreads();
    }
}

template <int DRY> __device__ void nsa_unit(const P& p, int b, int g, int cur, LASP unsigned char* lds, int ew_it, bool fresh) {
    const int tid = ltid(), wave = __builtin_amdgcn_readfirstlane(tid >> 6), lane = tid & 63, r32 = lane & 31, h = lane >> 5;
    const int rh = wave >> 1, th = wave & 1, hq = g * 4 + rh, bg = b * 2 + g;
    const int t0 = cur * 64, tl = th * 32 + r32, t = t0 + tl;
    const bf16_t* U = (const bf16_t*)(p.ws + OFF_U);
    const bf16_t* Ub = U + (size_t)b * SEQ * LDU;
    LASP unsigned char* ring = lds + AL_RING;
    LASP float* tabw = (LASP float*)(lds + AL_TAB) + rh * 128;
    const LASP f32x4_t* tab4 = (const LASP f32x4_t*)(lds + AL_TAB4) + rh * T4_N;
    LASP unsigned* selm = (LASP unsigned*)(lds + AL_SEL);
    LASP float* impsh = (LASP float*)(lds + AL_IMP);
    const int vlane = SLOT_V + ((lane >> 4) & 1) * 32 + (lane & 3) * 8 + (4 * h + ((lane & 15) >> 2)) * 64;
    const float c = 0.125f * LOG2E;
    { if (fresh) { const float* biasd = (const float*)(p.ws + OFF_BIASD) + (g * 4 + (tid >> 7)) * 2048; ((LASP float*)(lds + AL_TAB))[tid] = (biasd[tid & 127] - biasd[127]) * LOG2E; } if (tid == 0) selm[64] = 0u; }
    bf16x8_t q[4];
    { const bf16_t* qp = Ub + (size_t)t * LDU + C_QA + hq * 64 + 8 * h;
#pragma unroll
      for (int s = 0; s < 4; ++s) q[s] = q_scaled(qp + 16 * s, c); }
    const float ref_s = self_score<4>(q, Ub + (size_t)t * LDU + C_KS + g * 64, h), ref_w = self_score<4>(q, Ub + (size_t)t * LDU + C_KW + g * 64, h);
#define NSA_GATE(i) (1.0f / (1.0f + __expf(-bf2f(Ub[(size_t)t * LDU + C_GATE + hq * 3 + (i)]))))
    f32x16_t oacc[2];
    {
        const bf16_t* kc = (const bf16_t*)(p.ws + OFF_KCMP) + (size_t)bg * 128 * 64; const bf16_t* vc = (const bf16_t*)(p.ws + OFF_VCMP) + (size_t)bg * 128 * 64;
        dma_tile(kc, vc, 64, ring, wave, lane); dma_tile(kc + 64 * 64, vc + 64 * 64, 64, ring + SLOT_BYTES, wave, lane);
        dma_tile(Ub + C_KS + g * 64, Ub + C_VS + g * 64, LDU, ring + 2 * SLOT_BYTES, wave, lane);
        DMA_WAIT_BAR(2);
        if (fresh) { for (int i_ = tid; i_ < 4 * T16_N; i_ += NT) t16_fill((LASP f32x4_t*)(lds + AL_T16) + (i_ / T16_N) * T16_N, (const LASP float*)(lds + AL_TAB) + (i_ / T16_N) * 128, i_ % T16_N);
            asm volatile("s_waitcnt lgkmcnt(0)\n\ts_barrier" ::: "memory"); }
        if (fresh) for (int i_ = tid; i_ < 4 * T4_N; i_ += NT) t4_fill((LASP f32x4_t*)(lds + AL_TAB4) + (i_ / T4_N) * T4_N, (const LASP float*)(lds + AL_TAB) + (i_ / T4_N) * 128, i_ % T4_N);
        f32x16_t x0, x1, x2, x3;
        qk_tile<4, 0>(x0, x1, 0.f, ring, q, r32, h); qk_tile<4, 0>(x2, x3, 0.f, ring + SLOT_BYTES, q, r32, h);
        const float* dummy = nullptr; (void)dummy;
        const int dq = t - 31 - 64 * h;
#define CMP_XF(X, OFF) do { _Pragma("unroll") for (int G = 0; G < 4; ++G) { int i_ = dq - (OFF) - 128 * G + 1; i_ = i_ < 0 ? 0 : (i_ > T16_N - 1 ? T16_N - 1 : i_); const f32x4_t e_ = t16[i_]; \
            const f32x4_t u_ = (f32x4_t){X[4 * G], X[4 * G + 1], X[4 * G + 2], X[4 * G + 3]} + e_; X[4 * G] = u_[0]; X[4 * G + 1] = u_[1]; X[4 * G + 2] = u_[2]; X[4 * G + 3] = u_[3]; } } while (0)
        const LASP f32x4_t* t16 = (const LASP f32x4_t*)(lds + AL_T16) + rh * T16_N;
        CMP_XF(x0, 0); CMP_XF(x1, 512); CMP_XF(x2, 1024); CMP_XF(x3, 1536);
#undef CMP_XF
        float mx = fmaxf(fmaxf(max16(x0), max16(x1)), fmaxf(max16(x2), max16(x3)));
        mx = pl32_max(mx);
#pragma unroll
        for (int r = 0; r < 16; ++r) { x0[r] = __builtin_amdgcn_exp2f(x0[r] - mx); x1[r] = __builtin_amdgcn_exp2f(x1[r] - mx); x2[r] = __builtin_amdgcn_exp2f(x2[r] - mx); x3[r] = __builtin_amdgcn_exp2f(x3[r] - mx); }
        float l = (sum16(x0) + sum16(x1)) + (sum16(x2) + sum16(x3));
        l = pl32_sum(l);
        const float inv = (t >= 31) ? 1.0f / l : 0.f;
#pragma unroll
        for (int r = 0; r < 16; ++r) { x0[r] *= inv; x1[r] *= inv; x2[r] *= inv; x3[r] *= inv; }
        {
            LASP float* dst = impsh + tl * 129 + rh * 32 + h;
            float carry = 0.f;
#define IMP_TILE(X, T) do { _Pragma("unroll") for (int G = 0; G < 4; ++G) { const float s4 = (X[4 * G] + X[4 * G + 1]) + (X[4 * G + 2] + X[4 * G + 3]); \
                const float lp = pl32_other(X[4 * G + 3]); dst[2 * (4 * T + G)] = s4 + (h ? lp : carry); carry = lp; } } while (0)
            IMP_TILE(x0, 0); IMP_TILE(x1, 1); IMP_TILE(x2, 2); IMP_TILE(x3, 3);
#undef IMP_TILE
        }
        { const f32x16_t z = {0.f, 0.f, 0.f, 0.f, 0.f, 0.f, 0.f, 0.f, 0.f, 0.f, 0.f, 0.f, 0.f, 0.f, 0.f, 0.f}; oacc[0] = z; oacc[1] = z; }
        { bf16x8_t pf[4]; pf[0] = pack8(x0, 0); pf[1] = pack8(x0, 8); pf[2] = pack8(x1, 0); pf[3] = pack8(x1, 8); pv_tile(oacc, ring + vlane, pf);
          pf[0] = pack8(x2, 0); pf[1] = pack8(x2, 8); pf[2] = pack8(x3, 0); pf[3] = pack8(x3, 8); pv_tile(oacc, ring + SLOT_BYTES + vlane, pf); }
#pragma unroll
        for (int r = 0; r < 16; ++r) { const float g0_ = NSA_GATE(0); oacc[0][r] *= g0_; oacc[1][r] *= g0_; }
        float ewv[32];
        const bool ew_on = (unsigned)ew_it < (unsigned)EW_ITEMS;
        if (ew_on) ew_load(p, ew_it, lane, ewv);
        __syncthreads();
        {
            const int tk = tid >> 3, i8 = tid & 7;
            const LASP float* row = impsh + tk * 129 + 4 * i8;
            float v[4];
#pragma unroll
            for (int k = 0; k < 4; ++k) v[k] = ((row[k] + row[32 + k]) + row[64 + k]) + row[96 + k];
            const unsigned F = 1u | (1u << cur) | (cur >= 1 ? (1u << (cur - 1)) : 0u);
            const unsigned allv = (cur >= 31) ? 0xffffffffu : ((1u << (cur + 1)) - 1u);
            unsigned cand = allv & ~F; const int nfree = SEL_TOPN - __popc(F);
            unsigned sel = F;
            if (__popc(cand) <= nfree) sel |= cand;
            else {
#pragma unroll 1
                for (int it = 0; it < nfree; ++it) {
                    float best = -1.0f; int bj = 64;
#pragma unroll
                    for (int k = 0; k < 4; ++k) { const int j = 4 * i8 + k; const bool ok = ((cand >> j) & 1u) && v[k] > best; best = ok ? v[k] : best; bj = ok ? j : bj; }
#pragma unroll
                    for (int st_ = 0; st_ < 3; ++st_) {
                        const int ctrl = st_ == 0 ? 0xB1 : (st_ == 1 ? 0x4E : 0x141);
                        float ob; int oj;
                        if (st_ == 0) { ob = DPP_F(best, 0xB1); oj = __builtin_amdgcn_update_dpp(0, bj, 0xB1, 0xf, 0xf, true); }
                        else if (st_ == 1) { ob = DPP_F(best, 0x4E); oj = __builtin_amdgcn_update_dpp(0, bj, 0x4E, 0xf, 0xf, true); }
                        else { ob = DPP_F(best, 0x141); oj = __builtin_amdgcn_update_dpp(0, bj, 0x141, 0xf, 0xf, true); }
                        (void)ctrl;
                        const bool take = (ob > best) || (ob == best && oj < bj);
                        best = take ? ob : best; bj = take ? oj : bj;
                    }
                    sel |= 1u << bj; cand &= ~(1u << bj);
                }
            }
            if (i8 == 0) { selm[tk] = sel; atomicOr((unsigned*)&selm[64], sel); }
        }
        if (ew_on) ew_store(p, ew_it, lane, ewv);
        __syncthreads();
    }
    if (DRY == 1) { asm volatile("" :: "v"(oacc[0][0]), "v"(oacc[1][0])); return; }
    const unsigned mysel = selm[tl];
    const unsigned anysel = selm[64] & ((cur >= 31) ? 0xffffffffu : ((1u << (cur + 1)) - 1u));
    {
        LASP float* oal = (LASP float*)(lds + AL_IMP) + wave * 2048 + lane;
#pragma unroll
        for (int r = 0; r < 16; ++r) { oal[r * 64] = oacc[0][r]; oal[(16 + r) * 64] = oacc[1][r]; }
        const float g1 = NSA_GATE(1), g2 = NSA_GATE(2);
        const int wlo = cur >= 8 ? cur - 8 : 0;
#define NSA_NEXT(code) (((code) < 64) ? ((anysel & ~((2u << (code)) - 1u)) ? (__ffs((int)(anysel & ~((2u << (code)) - 1u))) - 1) : 64 + wlo) : ((((code) & 63) < cur) ? (code) + 1 : 128))
#define NSA_KSRC(code) (Ub + (size_t)(DRY == 2 ? 0 : ((code) & 63)) * 64 * LDU + (((code) < 64) ? C_KS : C_KW) + g * 64)
        const unsigned ringa = (unsigned)(uintptr_t)ring;
        const LASP unsigned char* kfl = ring + h * 1024 + r32 * 16;
        const LASP unsigned char* vfl = ring + vlane;
#define SBAR() __builtin_amdgcn_sched_barrier(0)
#define PIN(x) asm volatile("" : "+v"(x))
#define KLD(i, kb) kf[i] = *(const LASP bf16x8_t*)((kb) + ((i) >> 1) * 2048 + ((i) & 1) * 512)
#define VRD(i, ks, db) do { vl[i] = __builtin_amdgcn_ds_read_tr16_b64_v4i16((LASP v4i16_t*)(vbp + (db) * 4096 + (ks) * 1024)); vh[i] = __builtin_amdgcn_ds_read_tr16_b64_v4i16((LASP v4i16_t*)(vbp + (db) * 4096 + (ks) * 1024 + 512)); } while (0)
#define VFR(i) ((bf16x8_t){vl[i][0], vl[i][1], vl[i][2], vl[i][3], vh[i][0], vh[i][1], vh[i][2], vh[i][3]})
#define PKW(P, b) pg8::cvt_pk_bf16(P[b], P[(b) + 1])
#define PWF(k) __builtin_bit_cast(bf16x8_t, pw##k)
#define EX(v) __builtin_amdgcn_exp2f(v)
#define MX3(a, b, c) __builtin_fmaxf(__builtin_fmaxf((a), (b)), (c))
#define END_WAIT() do { if (c3 < 128) { asm volatile("s_waitcnt vmcnt(2) lgkmcnt(0)\n\ts_barrier" ::: "memory"); } else if (c1 < 128) { asm volatile("s_waitcnt vmcnt(1) lgkmcnt(0)\n\ts_barrier" ::: "memory"); } \
            else { asm volatile("s_waitcnt vmcnt(0) lgkmcnt(0)\n\ts_barrier" ::: "memory"); } } while (0)
#define ROTATE() do { cm1 = c0; c0 = c1; c1 = c2; c2 = c3; c3 = (c3 < 128) ? NSA_NEXT(c3) : 128; sp = s0; s0 = s1; s1 = (s1 == 2) ? 0 : s1 + 1; } while (0)
#define ROWMAX(C0, C1, mx) do { float a_ = MX3(C0[0], C0[1], C1[0]), b_ = MX3(C0[2], C0[3], C1[1]); a_ = MX3(a_, C1[2], C1[3]); \
            _Pragma("unroll") for (int r = 4; r < 16; r += 4) { a_ = MX3(a_, C0[r], C0[r + 1]); b_ = MX3(b_, C0[r + 2], C0[r + 3]); a_ = MX3(a_, C1[r], C1[r + 1]); b_ = MX3(b_, C1[r + 2], C1[r + 3]); } \
            mx = pl32_max(__builtin_fmaxf(a_, b_)); } while (0)
        int cm1 = 0, c0 = 0, c1 = NSA_NEXT(0), c2 = (c1 < 128) ? NSA_NEXT(c1) : 128, c3 = (c2 < 128) ? NSA_NEXT(c2) : 128;
        int sp = 1, s0 = 2, s1 = 0;
        (void)cm1;
        if (c1 < 128) { dma_k(NSA_KSRC(c1), LDU, ringa, wave, lane); dma_v(NSA_KSRC(c1) + 128, LDU, ringa, wave, lane); }
        if (c2 < 128) dma_k(NSA_KSRC(c2), LDU, ringa + SLOT_BYTES, wave, lane);
        bf16x8_t kf[8]; v4i16_t vl[8], vh[8]; u32x4_t pw0, pw1, pw2, pw3;
        f32x16_t pA0, pA1, pB0, pB1, o[2];
        { const f32x16_t z = {0.f, 0.f, 0.f, 0.f, 0.f, 0.f, 0.f, 0.f, 0.f, 0.f, 0.f, 0.f, 0.f, 0.f, 0.f, 0.f}; o[0] = z; o[1] = z; }
        float m = ref_s + SM_THR, l = 0.f; bool inwin = false;
        { const LASP unsigned char* kb = kfl + 2 * SLOT_BYTES;
          KLD(0, kb); KLD(1, kb); KLD(2, kb); KLD(3, kb); KLD(4, kb); KLD(5, kb); KLD(6, kb); KLD(7, kb);
          const float ci = -m; const f32x16_t cin = {ci, ci, ci, ci, ci, ci, ci, ci, ci, ci, ci, ci, ci, ci, ci, ci};
          pA0 = MFMA32(kf[0], q[0], cin); pA1 = MFMA32(kf[1], q[0], cin); pA0 = MFMA32(kf[2], q[1], pA0); pA1 = MFMA32(kf[3], q[1], pA1);
          pA0 = MFMA32(kf[4], q[2], pA0); pA1 = MFMA32(kf[5], q[2], pA1); pA0 = MFMA32(kf[6], q[3], pA0); pA1 = MFMA32(kf[7], q[3], pA1);
          if (3 > cur) xf4<false>(pA0, pA1, t - 4 * h, 0x7fffffffu, tab4);
          float mx; ROWMAX(pA0, pA1, mx);
          if (__any(mx > SM_THR)) { const float d = mx > SM_THR ? mx : 0.f; m += d;
#pragma unroll
              for (int r = 0; r < 16; ++r) { pA0[r] -= d; pA1[r] -= d; } }
#pragma unroll
          for (int r = 0; r < 16; ++r) { pA0[r] = EX(pA0[r]); pA1[r] = EX(pA1[r]); } }
        asm volatile("s_waitcnt vmcnt(0) lgkmcnt(0)\n\ts_barrier" ::: "memory");
        if (c3 < 128) dma_k(NSA_KSRC(c3), LDU, ringa + 2 * SLOT_BYTES, wave, lane);
        if (c1 < 128) { const LASP unsigned char* kb = kfl; KLD(0, kb); KLD(1, kb); KLD(2, kb); KLD(3, kb); KLD(4, kb); KLD(5, kb); KLD(6, kb); KLD(7, kb); }
        asm volatile("s_waitcnt lgkmcnt(0)\n\ts_barrier" ::: "memory");
        ROTATE();
#define NSA_STEP(C0, C1, P0, P1, BIAS) do { \
            const int j_ = c0 & 63; \
            const bool sel_ = (c0 >= 64) || ((mysel >> j_) & 1u); \
            const float ci_ = sel_ ? -m : NEG_BIG; \
            if (c3 < 128) dma_k(NSA_KSRC(c3), LDU, ringa + s0 * SLOT_BYTES, wave, lane); \
            if (c1 < 128) dma_v(NSA_KSRC(c1) + 128, LDU, ringa + s1 * SLOT_BYTES, wave, lane); \
            const LASP unsigned char* vbp = vfl + sp * SLOT_BYTES; \
            __builtin_amdgcn_s_waitcnt(0xC07F);        \
            f32x2_t sacc = {P0[0], P0[1]}; \
            { const f32x16_t cin_ = {ci_, ci_, ci_, ci_, ci_, ci_, ci_, ci_, ci_, ci_, ci_, ci_, ci_, ci_, ci_, ci_}; C1 = cin_; }        \
            SBAR(); \
            VRD(0, 0, 0); SBAR(); C0 = MFMA32(kf[0], q[0], C1); sacc += (f32x2_t){P0[2], P0[3]}; sacc += (f32x2_t){P0[4], P0[5]}; PIN(sacc); pw0[0] = PKW(P0, 0); pw0[1] = PKW(P0, 2); PIN(pw0); SBAR(); \
            VRD(1, 0, 1); SBAR(); C1 = MFMA32(kf[1], q[0], C1); sacc += (f32x2_t){P0[6], P0[7]}; sacc += (f32x2_t){P0[8], P0[9]}; PIN(sacc); pw0[2] = PKW(P0, 4); pw0[3] = PKW(P0, 6); PIN(pw0); SBAR(); \
            VRD(2, 1, 0); SBAR(); C0 = MFMA32(kf[2], q[1], C0); sacc += (f32x2_t){P0[10], P0[11]}; sacc += (f32x2_t){P0[12], P0[13]}; PIN(sacc); pw1[0] = PKW(P0, 8); pw1[1] = PKW(P0, 10); PIN(pw1); SBAR(); \
            VRD(3, 1, 1); SBAR(); C1 = MFMA32(kf[3], q[1], C1); sacc += (f32x2_t){P0[14], P0[15]}; sacc += (f32x2_t){P1[0], P1[1]}; PIN(sacc); pw1[2] = PKW(P0, 12); pw1[3] = PKW(P0, 14); PIN(pw1); SBAR(); \
            VRD(4, 2, 0); SBAR(); C0 = MFMA32(kf[4], q[2], C0); sacc += (f32x2_t){P1[2], P1[3]}; sacc += (f32x2_t){P1[4], P1[5]}; PIN(sacc); pw2[0] = PKW(P1, 0); pw2[1] = PKW(P1, 2); PIN(pw2); SBAR(); \
            VRD(5, 2, 1); SBAR(); C1 = MFMA32(kf[5], q[2], C1); sacc += (f32x2_t){P1[6], P1[7]}; sacc += (f32x2_t){P1[8], P1[9]}; PIN(sacc); pw2[2] = PKW(P1, 4); pw2[3] = PKW(P1, 6); PIN(pw2); SBAR(); \
            VRD(6, 3, 0); SBAR(); C0 = MFMA32(kf[6], q[3], C0); sacc += (f32x2_t){P1[10], P1[11]}; sacc += (f32x2_t){P1[12], P1[13]}; PIN(sacc); pw3[0] = PKW(P1, 8); pw3[1] = PKW(P1, 10); PIN(pw3); SBAR(); \
            VRD(7, 3, 1); SBAR(); C1 = MFMA32(kf[7], q[3], C1); sacc += (f32x2_t){P1[14], P1[15]}; PIN(sacc); pw3[2] = PKW(P1, 12); pw3[3] = PKW(P1, 14); PIN(pw3); SBAR(); \
            l += sacc.x + sacc.y; \
            if (BIAS) xf4b(C0, C1, t - 64 * j_ - 4 * h, tab4);        \
            float mx_; ROWMAX(C0, C1, mx_); \
            bool resc_ = false; float f_ = 1.f; \
            if (__builtin_expect(__any(mx_ > SM_THR), 0)) { const float d_ = mx_ > SM_THR ? mx_ : 0.f; f_ = EX(-d_); m += d_; l *= f_; resc_ = true; \
                _Pragma("unroll") for (int r = 0; r < 16; ++r) { asm volatile("v_sub_f32 %0, %0, %1" : "+v"(C0[r]) : "v"(d_)); asm volatile("v_sub_f32 %0, %0, %1" : "+v"(C1[r]) : "v"(d_)); } } \
            __builtin_amdgcn_s_waitcnt(0xC07F);        \
            SBAR(); \
            o[0] = MFMA32(VFR(0), PWF(0), o[0]); C0[0] = EX(C0[0]); C0[1] = EX(C0[1]); C0[2] = EX(C0[2]); C0[3] = EX(C0[3]); PIN(C0); SBAR(); \
            o[1] = MFMA32(VFR(1), PWF(0), o[1]); C0[4] = EX(C0[4]); C0[5] = EX(C0[5]); C0[6] = EX(C0[6]); C0[7] = EX(C0[7]); PIN(C0); SBAR(); \
            { const LASP unsigned char* kb_ = kfl + s1 * SLOT_BYTES; KLD(0, kb_); KLD(1, kb_); SBAR(); }        \
            o[0] = MFMA32(VFR(2), PWF(1), o[0]); C0[8] = EX(C0[8]); C0[9] = EX(C0[9]); C0[10] = EX(C0[10]); C0[11] = EX(C0[11]); PIN(C0); SBAR(); \
            { const LASP unsigned char* kb_ = kfl + s1 * SLOT_BYTES; KLD(2, kb_); KLD(3, kb_); SBAR(); }        \
            o[1] = MFMA32(VFR(3), PWF(1), o[1]); C0[12] = EX(C0[12]); C0[13] = EX(C0[13]); C0[14] = EX(C0[14]); C0[15] = EX(C0[15]); PIN(C0); SBAR(); \
            { const LASP unsigned char* kb_ = kfl + s1 * SLOT_BYTES; KLD(4, kb_); KLD(5, kb_); SBAR(); }        \
            o[0] = MFMA32(VFR(4), PWF(2), o[0]); C1[0] = EX(C1[0]); C1[1] = EX(C1[1]); C1[2] = EX(C1[2]); C1[3] = EX(C1[3]); PIN(C1); SBAR(); \
            { const LASP unsigned char* kb_ = kfl + s1 * SLOT_BYTES; KLD(6, kb_); KLD(7, kb_); SBAR(); }        \
            o[1] = MFMA32(VFR(5), PWF(2), o[1]); C1[4] = EX(C1[4]); C1[5] = EX(C1[5]); C1[6] = EX(C1[6]); C1[7] = EX(C1[7]); PIN(C1); SBAR(); \
            o[0] = MFMA32(VFR(6), PWF(3), o[0]); C1[8] = EX(C1[8]); C1[9] = EX(C1[9]); C1[10] = EX(C1[10]); C1[11] = EX(C1[11]); PIN(C1); SBAR(); \
            o[1] = MFMA32(VFR(7), PWF(3), o[1]); C1[12] = EX(C1[12]); C1[13] = EX(C1[13]); C1[14] = EX(C1[14]); C1[15] = EX(C1[15]); PIN(C1); SBAR(); \
            if (resc_) { _Pragma("unroll") for (int r = 0; r < 16; ++r) { asm volatile("v_mul_f32 %0, %0, %1" : "+v"(o[0][r]) : "v"(f_)); asm volatile("v_mul_f32 %0, %0, %1" : "+v"(o[1][r]) : "v"(f_)); } } \
            END_WAIT(); \
            ROTATE(); } while (0)
#define NSA_STEP_GEN(C0, C1, P0, P1, KIND) do { \
            const int j_ = c0 & 63; const bool win_ = c0 >= 64, sw_ = win_ && !inwin; \
            const bool sel_ = win_ || ((mysel >> j_) & 1u); \
            const float mq_ = sw_ ? ref_w + SM_THR : m; \
            const float ci_ = sel_ ? -mq_ : NEG_BIG; \
            if (c3 < 128) dma_k(NSA_KSRC(c3), LDU, ringa + s0 * SLOT_BYTES, wave, lane); \
            if (c1 < 128) dma_v(NSA_KSRC(c1) + 128, LDU, ringa + s1 * SLOT_BYTES, wave, lane); \
            { VFr1 vf_; pv_read1(vf_, vfl + sp * SLOT_BYTES);        \
              float sacc = 0.f; _Pragma("unroll") for (int r = 0; r < 16; ++r) sacc += P0[r] + P1[r]; l += sacc; \
              bf16x8_t pf_[4]; pf_[0] = pack8(P0, 0); pf_[1] = pack8(P0, 8); pf_[2] = pack8(P1, 0); pf_[3] = pack8(P1, 8); \
              pv_mma1(o, vf_, pf_); } \
            if (sw_) { const float fs_ = g1 / pl32_sum(l); l = 0.f; m = mq_; \
                _Pragma("unroll") for (int r = 0; r < 16; ++r) { oal[r * 64] = fmaf(fs_, o[0][r], oal[r * 64]); oal[(16 + r) * 64] = fmaf(fs_, o[1][r], oal[(16 + r) * 64]); o[0][r] = 0.f; o[1][r] = 0.f; } \
                inwin = true; } \
            { const f32x16_t cin_ = {ci_, ci_, ci_, ci_, ci_, ci_, ci_, ci_, ci_, ci_, ci_, ci_, ci_, ci_, ci_, ci_}; C1 = cin_; } \
            C0 = MFMA32(kf[0], q[0], C1); C1 = MFMA32(kf[1], q[0], C1); C0 = MFMA32(kf[2], q[1], C0); C1 = MFMA32(kf[3], q[1], C1); \
            C0 = MFMA32(kf[4], q[2], C0); C1 = MFMA32(kf[5], q[2], C1); C0 = MFMA32(kf[6], q[3], C0); C1 = MFMA32(kf[7], q[3], C1); \
            if (c1 < 128) { const LASP unsigned char* kb_ = kfl + s1 * SLOT_BYTES; KLD(0, kb_); KLD(1, kb_); KLD(2, kb_); KLD(3, kb_); KLD(4, kb_); KLD(5, kb_); KLD(6, kb_); KLD(7, kb_); } \
            if (KIND) xf4<true>(C0, C1, t - 64 * j_ - 4 * h, win_ ? (unsigned)WINDOW : 0x7fffffffu, tab4);        \
            else xf4<false>(C0, C1, t - 64 * j_ - 4 * h, 0u, tab4);                                               \
            float mx_; ROWMAX(C0, C1, mx_); \
            if (__any(mx_ > SM_THR)) { const float d_ = mx_ > SM_THR ? mx_ : 0.f, f_ = EX(-d_); m += d_; l *= f_; \
                _Pragma("unroll") for (int r = 0; r < 16; ++r) { C0[r] -= d_; C1[r] -= d_; o[0][r] *= f_; o[1][r] *= f_; } } \
            _Pragma("unroll") for (int r = 0; r < 16; ++r) { C0[r] = EX(C0[r]); C1[r] = EX(C1[r]); } \
            END_WAIT(); \
            ROTATE(); } while (0)
#define NSA_DRAIN(P0, P1) do { VFr1 vf_; pv_read1(vf_, vfl + sp * SLOT_BYTES); float sacc = 0.f; _Pragma("unroll") for (int r = 0; r < 16; ++r) sacc += P0[r] + P1[r]; l += sacc; \
            bf16x8_t pf_[4]; pf_[0] = pack8(P0, 0); pf_[1] = pack8(P0, 8); pf_[2] = pack8(P1, 0); pf_[3] = pack8(P1, 8); \
            pv_mma1(o, vf_, pf_); } while (0)
#define NSA_ISGEN(code) (((code) >= 64) ? (!inwin || !(((code) & 63) + 3 <= cur && ((code) & 63) + 8 > cur)) : (((code) & 63) + 3 > cur))
#define NSA_NEAR(code) ((((code) & 63) + 3 > cur) ? 3 : 0)
#define NSA_KIND(code) (((code) < 64) ? NSA_NEAR(code) : ((((code) & 63) + 8 == cur) ? 2 : (inwin ? NSA_NEAR(code) : 1)))
#define NSA_ISSEQ(code) ((code) >= 64 && (!inwin || ((code) & 63) + 8 == cur))
#define NSA_ISMASK(code) ((code) >= 64 && ((code) & 63) + 8 == cur)
        bool lastA = true;
        for (;;) {
            if (c0 >= 128) break;
            { const int kind_ = NSA_KIND(c0); if (kind_ == 0 || kind_ == 3) { const bool near_ = kind_ == 3; NSA_STEP(pB0, pB1, pA0, pA1, near_); } else NSA_STEP_GEN(pB0, pB1, pA0, pA1, true); }
            lastA = false;
            if (c0 >= 128) break;
            { const int kind_ = NSA_KIND(c0); if (kind_ == 0 || kind_ == 3) { const bool near_ = kind_ == 3; NSA_STEP(pA0, pA1, pB0, pB1, near_); } else NSA_STEP_GEN(pA0, pA1, pB0, pB1, true); }
            lastA = true;
        }
        if (lastA) NSA_DRAIN(pA0, pA1); else NSA_DRAIN(pB0, pB1);
#undef NSA_STEP
#undef NSA_STEP_GEN
#undef NSA_ISSEQ
#undef NSA_ISGEN
#undef NSA_ISMASK
#undef NSA_DRAIN
#undef NSA_NEXT
#undef NSA_KSRC
#undef KLD
#undef VRD
#undef VFR
#undef PKW
#undef PWF
#undef ROWMAX
#undef END_WAIT
#undef ROTATE
        const float fw = g2 / pl32_sum(l);
        bf16_t* orow = (bf16_t*)(p.ws + OFF_ATT) + ((size_t)b * SEQ + t) * D_MODEL + hq * 64 + 4 * h;
#pragma unroll
        for (int db = 0; db < 2; ++db)
#pragma unroll
            for (int rg = 0; rg < 4; ++rg) { float v_[4];
#pragma unroll
                for (int e = 0; e < 4; ++e) v_[e] = fmaf(fw, o[db][4 * rg + e], oal[(16 * db + 4 * rg + e) * 64]);
                uint2 w; w.x = pg8::cvt_pk_bf16(v_[0], v_[1]); w.y = pg8::cvt_pk_bf16(v_[2], v_[3]); if (DRY == 0) *(uint2*)(orow + 32 * db + 8 * rg) = w; else asm volatile("" :: "v"(w.x), "v"(w.y)); }
        asm volatile("s_waitcnt lgkmcnt(0)" ::: "memory");
    }
}

#undef NSA_GATE
__device__ void diff_unit(const P& p, int b, int hd, int qb, LASP unsigned char* lds, int ew_it, bool fresh) {
    const int tid = ltid(), wave = __builtin_amdgcn_readfirstlane(tid >> 6), lane = tid & 63, r32 = lane & 31, h = lane >> 5;
    const int q0w = qb * 256 + wave * 32, t = q0w + r32;
    const bf16_t* Ub = (const bf16_t*)(p.ws + OFF_U) + (size_t)b * SEQ * LDU;
    LASP unsigned char* ring = lds + AL_RING;
    LASP float* tabw = (LASP float*)(lds + AL_TAB);
    LASP f32x4_t* tab4 = (LASP f32x4_t*)(lds + AL_TAB4);
    const int vlane = SLOT_V + ((lane >> 4) & 1) * 32 + (lane & 3) * 8 + (4 * h + ((lane & 15) >> 2)) * 64;
    const float c = 0.17677669529663687f * LOG2E;
    float ewv[32];
    const bool ew_on = (unsigned)ew_it < (unsigned)EW_ITEMS;
    if (ew_on) ew_load(p, ew_it, lane, ewv);
    if (fresh && tid < 128) { const float* biasd = (const float*)(p.ws + OFF_BIASD) + (8 + hd) * 2048; tabw[tid] = (biasd[tid] - biasd[127]) * LOG2E; }
    bf16x8_t q[4];
    { const bf16_t* qp = Ub + (size_t)t * LDU + C_QB + hd * 64 + 8 * h;
#pragma unroll
      for (int s = 0; s < 4; ++s) q[s] = q_scaled(qp + 16 * s, c); }
    AttnSt sa, sb; st_init(sa, self_score<2>(q, Ub + (size_t)t * LDU + C_KB + hd * 64, h)); st_init(sb, self_score<2>(q + 2, Ub + (size_t)t * LDU + C_KB + hd * 64 + 32, h));
    const bf16_t* ksrc = Ub + C_KB + hd * 64; const bf16_t* vsrc = Ub + C_VB + hd * 64;
    const int ntile = 4 * qb + 4;
    dma_tile(ksrc, vsrc, LDU, ring, wave, lane);
    dma_tile(ksrc + (size_t)64 * LDU, vsrc + (size_t)64 * LDU, LDU, ring + SLOT_BYTES, wave, lane);
    DMA_WAIT_BAR(2);
    if (fresh && tid < T4_N) t4_fill(tab4, tabw, tid);
    if (ew_on) ew_store(p, ew_it, lane, ewv);
    asm volatile("s_waitcnt lgkmcnt(0)\n\ts_barrier" ::: "memory");
    int sl = 0;
#pragma nounroll
    for (int j = 0; j < ntile; ++j) {
        const int sl1 = sl == 2 ? 0 : sl + 1, sl2 = sl1 == 2 ? 0 : sl1 + 1;
        if (j + 2 < ntile) dma_tile(ksrc + (size_t)(j + 2) * 64 * LDU, vsrc + (size_t)(j + 2) * 64 * LDU, LDU, ring + sl2 * SLOT_BYTES, wave, lane);
        if (64 * j <= q0w + 31) {
            const LASP unsigned char* kt = ring + sl * SLOT_BYTES; const LASP unsigned char* vt = kt + vlane;
            const bool far = (64 * j + 63 + 113 <= q0w);
            f32x16_t pa0, pa1, pb0, pb1; bf16x8_t pfa[4], pfb[4];
            qk_tile<2, 0>(pa0, pa1, -sa.m, kt, q, r32, h); qk_tile<2, 2>(pb0, pb1, -sb.m, kt, q + 2, r32, h);
            if (!far) xf4_2<false>(pa0, pa1, pb0, pb1, t - 64 * j - 4 * h, tab4);
            sm_only(sa, pa0, pa1, pfa); sm_only(sb, pb0, pb1, pfb);
            pv_tile2(sa.o, sb.o, vt, pfa, pfb);
        }
        if (j + 2 < ntile) DMA_WAIT_BAR(2); else DMA_WAIT_BAR(0);
        sl = sl1;
    }
    float la = sa.l; la = pl32_sum(la);
    float lb = sb.l; lb = pl32_sum(lb);
    float lam;
    { const float a_ = lane < 32 ? p.lq1[lane] * p.lk1[lane] : 0.f, c2_ = lane < 32 ? p.lq2[lane] * p.lk2[lane] : 0.f; lam = expf(wave_sum(a_)) - expf(wave_sum(c2_)) + 0.2f; }
    const float fa = 1.0f / la, fb = lam / lb;
    float ss = 0.f;
#pragma unroll
    for (int r = 0; r < 16; ++r) { sa.o[0][r] = sa.o[0][r] * fa - sb.o[0][r] * fb; sa.o[1][r] = sa.o[1][r] * fa - sb.o[1][r] * fb; ss += sa.o[0][r] * sa.o[0][r] + sa.o[1][r] * sa.o[1][r]; }
    ss = pl32_sum(ss);
    const float rn = 0.8f / sqrtf(ss * (1.0f / 64.0f) + EPS);
    bf16_t* orow = (bf16_t*)(p.ws + OFF_ATT) + ((size_t)b * SEQ + t) * D_MODEL + 512 + hd * 64 + 4 * h;
#pragma unroll
    for (int db = 0; db < 2; ++db)
#pragma unroll
        for (int rg = 0; rg < 4; ++rg) { const float4 gsl = *(const float4*)(p.subln + 32 * db + 8 * rg + 4 * h);
            uint2 w; w.x = pg8::cvt_pk_bf16(sa.o[db][4 * rg] * rn * gsl.x, sa.o[db][4 * rg + 1] * rn * gsl.y); w.y = pg8::cvt_pk_bf16(sa.o[db][4 * rg + 2] * rn * gsl.z, sa.o[db][4 * rg + 3] * rn * gsl.w);
            *(uint2*)(orow + 32 * db + 8 * rg) = w; }
}

__device__ void f_attn(const P& p, int bid, int nb, LASP unsigned char* lds) {
#ifndef DRY_MODE
#define DRY_MODE 0
#endif
    if (DRY_MODE) for (int u = bid; u < 1024; u += nb) { const int vb0_ = u & 255, vb = ((vb0_ & 7) << 5) | (vb0_ >> 3), i = u >> 8; const int pair = vb >> 3, s = vb & 7;
        const unsigned ctab = (s == 0) ? 0x1f1a0800u : (s == 1) ? 0x1e180901u : (s == 2) ? 0x1d160a02u : (s == 3) ? 0x1c140b03u : (s == 4) ? 0x1b130c04u : (s == 5) ? 0x19120d05u : (s == 6) ? 0x17110e06u : 0x15100f07u;
        const int cur = (int)((ctab >> (8 * (3 - i))) & 0xffu);
        nsa_unit<DRY_MODE>(p, pair >> 1, pair & 1, cur, lds, -1, true); __syncthreads(); }
    int tabkey = -1;
    for (int u = bid; u < 2048; u += nb) {
        const int ew_it = u * 8 + __builtin_amdgcn_readfirstlane(ltid() >> 6);
        const int vb0_ = u & 255, vb = ((vb0_ & 7) << 5) | (vb0_ >> 3), i = u >> 8;
        if (i < 4) { const int pair = vb >> 3, s = vb & 7;
            const unsigned ctab = (s == 0) ? 0x1f1a0800u : (s == 1) ? 0x1e180901u : (s == 2) ? 0x1d160a02u : (s == 3) ? 0x1c140b03u : (s == 4) ? 0x1b130c04u : (s == 5) ? 0x19120d05u : (s == 6) ? 0x17110e06u : 0x15100f07u;
            const int cur = (int)((ctab >> (8 * (3 - i))) & 0xffu);
            const int key = pair & 1; nsa_unit<0>(p, pair >> 1, pair & 1, cur, lds, ew_it, key != tabkey); tabkey = key; }
        else { const int pair = vb >> 1, s = vb & 1, k = i - 4; const int qb = s ? ((k == 0) ? 6 : (k == 1) ? 5 : (k == 2) ? 2 : 1) : ((k == 0) ? 7 : (k == 1) ? 4 : (k == 2) ? 3 : 0);
            const int key = 8 + (pair & 7); diff_unit(p, pair >> 3, pair & 7, qb, lds, ew_it, key != tabkey); tabkey = key; }
        __syncthreads();
    }
}

template <bool DUMMY> __device__ void f_route(const P& p, int bid, int nb, float* sm, int* lctl) {
    const int tid = ltid(), wave = tid >> 6, lane = tid & 63, fr = lane & 15, fq = lane >> 4;
    const bf16_t* RH = (const bf16_t*)(p.ws + OFF_RW_HI); const bf16_t* RL = (const bf16_t*)(p.ws + OFF_RW_LO);
    const bf16_t* HBr = (const bf16_t*)(p.ws + OFF_HB);
    unsigned* cnt = (unsigned*)(p.ws + OFF_CTL) + CTL_CNT + (DUMMY ? 64 : 0);
    int* list = (int*)(p.ws + (DUMMY ? OFF_ATT + 32 * MiB : OFF_LIST)); float* slr = (float*)(p.ws + (DUMMY ? OFF_ATT + 36 * MiB : OFF_SLR));
    unsigned* tok_ep = (unsigned*)(p.ws + (DUMMY ? OFF_ATT + 40 * MiB : OFF_TOK_EP)); float* tok_w = (float*)(p.ws + (DUMMY ? OFF_ATT + 41 * MiB : OFF_TOK_W));
    float* lgs = sm + 24576 + wave * 800;
    int* lcnt = lctl + LC_LCNT; int* gbase = lctl + LC_GBASE;
    for (int t0 = bid * 128; t0 < T_TOK; t0 += nb * 128) {
        if (tid < 32) lcnt[tid] = 0;
        const int tok0 = t0 + wave * 16;
        f32x4_t acc[3]; acc[0] = (f32x4_t){0.f, 0.f, 0.f, 0.f}; acc[1] = acc[0]; acc[2] = acc[0];
        float ss = 0.f;
        const bf16_t* hrow = HBr + (size_t)(tok0 + fr) * D_MODEL + 8 * fq;
        LASP unsigned char* rb = (LASP unsigned char*)sm;
#define RT_DMA(c, boff) do { _Pragma("unroll") for (int q_ = 0; q_ < 6; ++q_) { const int idx_ = wave + 8 * q_, hl_ = idx_ / 24, rem_ = idx_ % 24, ks_ = rem_ / 3, nt_ = rem_ % 3; \
            const bf16_t* src_ = (hl_ ? RL : RH) + (size_t)(nt_ * 16 + (lane >> 2)) * D_MODEL + (c) * 256 + 32 * ks_ + 8 * (lane & 3); \
            __builtin_amdgcn_global_load_lds((const unsigned*)src_, (LASP unsigned*)(rb + (boff) + idx_ * 1024), 16, 0, 0); } } while (0)
#define RT_LDA(S, c) do { _Pragma("unroll") for (int k_ = 0; k_ < 8; ++k_) S[k_] = *(const u32x4_t*)(hrow + (c) * 256 + k_ * 32); } while (0)
#define RT_COMP(S, boff) do { _Pragma("unroll") for (int k_ = 0; k_ < 8; ++k_) { const u32x4_t wh = S[k_]; \
            _Pragma("unroll") for (int j = 0; j < 4; ++j) { const float v0 = __uint_as_float(wh[j] << 16), v1 = __uint_as_float(wh[j] & 0xffff0000u); ss = fmaf(v0, v0, ss); ss = fmaf(v1, v1, ss); } \
            const bf16x8_t ahi = __builtin_bit_cast(bf16x8_t, wh); \
            _Pragma("unroll") for (int n = 0; n < 3; ++n) { const bf16x8_t bh_ = *(const LASP bf16x8_t*)(rb + (boff) + (k_ * 3 + n) * 1024 + (fr * 4 + fq) * 16), bl_ = *(const LASP bf16x8_t*)(rb + (boff) + 24576 + (k_ * 3 + n) * 1024 + (fr * 4 + fq) * 16); \
                acc[n] = __builtin_amdgcn_mfma_f32_16x16x32_bf16(ahi, bh_, acc[n], 0, 0, 0); acc[n] = __builtin_amdgcn_mfma_f32_16x16x32_bf16(ahi, bl_, acc[n], 0, 0, 0); } } } while (0)
#define RT_BAR(N) asm volatile("s_waitcnt vmcnt(" #N ") lgkmcnt(0)\n\ts_barrier" ::: "memory")
        u32x4_t A0[8], A1[8];
        RT_DMA(0, 0); RT_LDA(A0, 0);
        RT_DMA(1, 49152); RT_LDA(A1, 1);
        RT_BAR(14);
        RT_COMP(A0, 0);
        RT_BAR(0);
        RT_DMA(2, 0); RT_LDA(A0, 2);
        RT_COMP(A1, 49152);
        RT_BAR(0);
        RT_DMA(3, 49152); RT_LDA(A1, 3);
        RT_COMP(A0, 0);
        RT_BAR(0);
        RT_COMP(A1, 49152);
        RT_BAR(0);
#undef RT_DMA
#undef RT_LDA
#undef RT_COMP
#undef RT_BAR
        ss = pl32_sum(pl16_sum(ss));
        const float rs = 1.0f / sqrtf(ss * (1.0f / D_MODEL) + EPS);
#pragma unroll
        for (int n = 0; n < 3; ++n)
#pragma unroll
            for (int i = 0; i < 4; ++i) lgs[(4 * fq + i) * 48 + n * 16 + fr] = acc[n][i];
        if (fq == 0) lgs[768 + fr] = rs;
        __syncthreads();
        int e_[2] = {0, 0}; int rk[2] = {0, 0}; float w_[2] = {0.f, 0.f}; float myrs = 0.f;
        if (lane < 16) {
            const float* l = lgs + lane * 48; myrs = lgs[768 + lane];
            float g[4]; int gi = 0;
#pragma unroll
            for (int i = 0; i < 4; ++i) g[i] = l[i] * myrs + p.bg[i];
            float mx = g[0];
#pragma unroll
            for (int i = 1; i < 4; ++i) if (g[i] > mx) { mx = g[i]; gi = i; }
            float den = 0.f;
#pragma unroll
            for (int i = 0; i < 4; ++i) den += expf(g[i] - mx);
            const float gprob = 1.0f / den;
            float el[8];
#pragma unroll
            for (int i = 0; i < 8; ++i) el[i] = l[4 + gi * 8 + i] * myrs + p.be[gi * 8 + i];
            float emx = el[0]; int e0 = 0;
#pragma unroll
            for (int i = 1; i < 8; ++i) if (el[i] > emx) { emx = el[i]; e0 = i; }
            float e2 = -INFINITY; int e1 = 0;
#pragma unroll
            for (int i = 0; i < 8; ++i) if (i != e0 && el[i] > e2) { e2 = el[i]; e1 = i; }
            float eden = 0.f;
#pragma unroll
            for (int i = 0; i < 8; ++i) eden += expf(el[i] - emx);
            const float pa = 1.0f / eden, pb = expf(e2 - emx) / eden;
            e_[0] = gi * 8 + e0; e_[1] = gi * 8 + e1; w_[0] = gprob * pa / (pa + pb); w_[1] = gprob * pb / (pa + pb);
            rk[0] = atomicAdd(&lcnt[e_[0]], 1); rk[1] = atomicAdd(&lcnt[e_[1]], 1);
        }
        __syncthreads();
        if (tid < 32) gbase[tid] = lcnt[tid] ? (int)atomicAdd(&cnt[tid], (unsigned)lcnt[tid]) : 0;
        __syncthreads();
        if (lane < 16) { const int tok = tok0 + lane;
#pragma unroll
            for (int k = 0; k < 2; ++k) { const int pos = gbase[e_[k]] + rk[k]; list[(size_t)e_[k] * T_TOK + pos] = tok; slr[(size_t)e_[k] * T_TOK + pos] = myrs;
                tok_ep[tok * 2 + k] = ((unsigned)e_[k] << 16) | (unsigned)pos; tok_w[tok * 2 + k] = w_[k]; } }
        __syncthreads();
    }
}
__device__ void f_moe_tables(const P& p, int* lctl) {
    const int tid = ltid();
    const unsigned* cnt = (const unsigned*)(p.ws + OFF_CTL) + CTL_CNT;
    if (tid < 32) lctl[LC_NCNT + tid] = (int)cnt[tid];
    __syncthreads();
    if (tid == 0) { int acc = 0; for (int e = 0; e < 32; ++e) { lctl[LC_TBASE + e] = acc; const int nt_ = (lctl[LC_NCNT + e] + 255) >> 8; for (int i = 0; i < nt_; ++i) lctl[LC_TILE_E + acc + i] = e; acc += nt_; } lctl[LC_TBASE + 32] = acc; }
    __syncthreads();
}
__device__ void f_final(const P& p, int bid, int nb, const int* lctl) {
    const int tid = ltid(), wave = tid >> 6, lane = tid & 63;
    const bf16_t* HBp = (const bf16_t*)(p.ws + OFF_HB); const bf16_t* YC = (const bf16_t*)(p.ws + OFF_YC);
    const unsigned* tok_ep = (const unsigned*)(p.ws + OFF_TOK_EP); const float* tok_w = (const float*)(p.ws + OFF_TOK_W);
    float4 gf[4];
#pragma unroll
    for (int j = 0; j < 4; ++j) gf[j] = *((const float4*)p.ln_final + lane + 64 * j);
    for (int tok = bid * 8 + wave; tok < T_TOK; tok += nb * 8) {
        const unsigned ep0 = tok_ep[tok * 2], ep1 = tok_ep[tok * 2 + 1]; const float w0 = tok_w[tok * 2], w1 = tok_w[tok * 2 + 1];
        const size_t s0 = (size_t)lctl[LC_TBASE + (ep0 >> 16)] * 256 + (ep0 & 0xffffu), s1 = (size_t)lctl[LC_TBASE + (ep1 >> 16)] * 256 + (ep1 & 0xffffu);
        const uint2* hr = (const uint2*)(HBp + (size_t)tok * D_MODEL) + lane; const uint2* y0 = (const uint2*)(YC + s0 * D_MODEL) + lane; const uint2* y1 = (const uint2*)(YC + s1 * D_MODEL) + lane;
        float4 z[4]; float ss = 0.f;
#pragma unroll
        for (int j = 0; j < 4; ++j) { const uint2 hh = hr[64 * j]; const uint2 a = y0[64 * j], b = y1[64 * j];
            z[j].x = __uint_as_float(hh.x << 16) + w0 * __uint_as_float(a.x << 16) + w1 * __uint_as_float(b.x << 16);
            z[j].y = __uint_as_float(hh.x & 0xffff0000u) + w0 * __uint_as_float(a.x & 0xffff0000u) + w1 * __uint_as_float(b.x & 0xffff0000u);
            z[j].z = __uint_as_float(hh.y << 16) + w0 * __uint_as_float(a.y << 16) + w1 * __uint_as_float(b.y << 16);
            z[j].w = __uint_as_float(hh.y & 0xffff0000u) + w0 * __uint_as_float(a.y & 0xffff0000u) + w1 * __uint_as_float(b.y & 0xffff0000u);
            ss += (z[j].x * z[j].x + z[j].y * z[j].y) + (z[j].z * z[j].z + z[j].w * z[j].w); }
        const float rs = 1.0f / sqrtf(wave_sum(ss) * (1.0f / D_MODEL) + EPS);
        float4* o = (float4*)(p.out + (size_t)tok * D_MODEL) + lane;
#pragma unroll
        for (int j = 0; j < 4; ++j) o[64 * j] = make_float4(z[j].x * rs * gf[j].x, z[j].y * rs * gf[j].y, z[j].z * rs * gf[j].z, z[j].w * rs * gf[j].w);
    }
}

#define XB_TMO      128
#define XB_XCNT(j)  (256  + 64 * (j))
#define XB_XSUB(j)  (1280 + 64 * (j))
#define XB_XGEN(j)  (2304 + 64 * (j))
#define XB_TOP      3328
#define XB_TOPGEN   3392
#define XCD_BAR_WORDS 3456
#define XB_SPIN_CAP (1u << 26)
#define LAS __attribute__((address_space(3)))

__device__ __forceinline__ unsigned xb_ld(unsigned* p)              { return __hip_atomic_load(p, __ATOMIC_RELAXED, __HIP_MEMORY_SCOPE_AGENT); }
__device__ __forceinline__ unsigned xb_add(unsigned* p, unsigned v) { return __hip_atomic_fetch_add(p, v, __ATOMIC_RELAXED, __HIP_MEMORY_SCOPE_AGENT); }
__device__ __forceinline__ unsigned xb_xcc_id() { return (unsigned)__builtin_amdgcn_s_getreg((3 << 11) | 20) & 0xFu; }
#define XB_SPIN(cond, bar) do { unsigned _sp = 0; while (cond) { __builtin_amdgcn_s_sleep(1); \
    if ((++_sp & 255u) == 0u) { if (xb_ld(&(bar)[XB_TMO])) break; if (_sp > XB_SPIN_CAP) { atomicAdd(&(bar)[XB_TMO], 1u); break; } } } } while (0)

struct XcdBarrier {
    unsigned* bar; unsigned x;
    volatile LAS unsigned* st;
};

__device__ __forceinline__ XcdBarrier xcd_barrier_post(unsigned* bar, volatile LAS unsigned* st) {
    XcdBarrier b; b.bar = bar; b.x = xb_xcc_id(); b.st = st;
    if (threadIdx.x == 0) (void)xb_add(&bar[XB_XCNT(b.x)], 1u);
    return b;
}
__device__ __forceinline__ void xcd_barrier_complete(unsigned* bar, unsigned x, unsigned& nloc, unsigned& nx) {
    const unsigned G = gridDim.x * gridDim.y * gridDim.z;
    unsigned sum, cnt, mine, sp = 0u;
    for (;;) {
        sum = 0u; cnt = 0u; mine = 0u;
#pragma unroll
        for (unsigned j = 0; j < 16; ++j) { const unsigned c = xb_ld(&bar[XB_XCNT(j)]); sum += c; cnt += (c > 0u) ? 1u : 0u; mine = (j == x) ? c : mine; }
        if (sum == G) break;
        __builtin_amdgcn_s_sleep(1);
        if ((++sp & 255u) == 0u) { if (xb_ld(&bar[XB_TMO])) break; if (sp > XB_SPIN_CAP) { atomicAdd(&bar[XB_TMO], 1u); break; } }
    }
    nloc = mine > 0u ? mine : 1u; nx = cnt > 0u ? cnt : 1u;
}

__device__ __forceinline__ void xcd_barrier(const XcdBarrier& b) {
    asm volatile("s_waitcnt vmcnt(0)" ::: "memory");
    __syncthreads();
    if (threadIdx.x == 0) {
        unsigned* bar = b.bar;
        __builtin_amdgcn_s_waitcnt(0);
        unsigned nloc = b.st[0], nx = b.st[1];
        if (nloc == 0u) { xcd_barrier_complete(bar, b.x, nloc, nx); b.st[0] = nloc; b.st[1] = nx; }
        const unsigned old = xb_add(&bar[XB_XSUB(b.x)], 1u);
        const unsigned gen = old / nloc;
        if (old + 1u == (gen + 1u) * nloc) {
            __builtin_amdgcn_fence(__ATOMIC_RELEASE, "agent");
            asm volatile("s_waitcnt vmcnt(0)" ::: "memory");
            const unsigned og = xb_add(&bar[XB_TOP], 1u);
            const unsigned tg = og / nx;
            if (og + 1u == (tg + 1u) * nx) xb_add(&bar[XB_TOPGEN], 1u);
            else XB_SPIN(xb_ld(&bar[XB_TOPGEN]) == tg, bar);
            __builtin_amdgcn_fence(__ATOMIC_ACQUIRE, "agent");
            xb_add(&bar[XB_XGEN(b.x)], 1u);
            asm volatile("s_waitcnt vmcnt(0)" ::: "memory");
        } else {
            XB_SPIN(xb_ld(&bar[XB_XGEN(b.x)]) == gen, bar);
            __builtin_amdgcn_fence(__ATOMIC_ACQUIRE, "agent");
            asm volatile("s_waitcnt vmcnt(0)" ::: "memory");
        }
    }
    __syncthreads();
}


extern __shared__ __attribute__((aligned(16))) unsigned char dyn_smem[];
__global__ void __launch_bounds__(NT, 2) k_mega(P p) {
    float* sm = (float*)dyn_smem;
    LASP unsigned char* ring = (LASP unsigned char*)dyn_smem;
    const int bid = blockIdx.x, nb = gridDim.x;
    int* lctl = (int*)(dyn_smem + LDS_CTL_OFF);
    for (int i = threadIdx.x; i < 1024; i += NT) lctl[i] = 0;
    __syncthreads();
    XcdBarrier bar = xcd_barrier_post((unsigned*)(p.ws + OFF_CTL), (volatile LAS unsigned*)(dyn_smem + LDS_CTL_OFF));
    f_prologue(p, bid, nb, sm);
    xcd_barrier(bar);
    { pg8::Gemm g{(const bf16_t*)(p.ws + OFF_XN), (const bf16_t*)(p.ws + OFF_WIN_T), T_TOK, LDU, D_MODEL}; pg8::StaticOrder S; S.init(T_TOK, LDU, nb, bid);
      pg8::EpiBf16Lean E{(bf16_t*)(p.ws + OFF_U), LDU, 0xffff};
      pg8::gemm_phase<pg8::EpiBf16Lean, pg8::StaticOrder, true, true>(ring, g, S, E); }
    xcd_barrier(bar);
    f_cmp(p, bid, nb, ring);
    xcd_barrier(bar);
    f_attn(p, bid, nb, ring);
    xcd_barrier(bar);
    { pg8::Gemm g{(const bf16_t*)(p.ws + OFF_ATT), (const bf16_t*)(p.ws + OFF_WOUT_T), T_TOK, D_MODEL, D_MODEL}; pg8::StaticOrder S; S.init(T_TOK, D_MODEL, nb, bid);
      pg8::EpiResF32 E{p.x, (bf16_t*)(p.ws + OFF_HB), D_MODEL};
      pg8::gemm_phase<pg8::EpiResF32, pg8::StaticOrder, true, true>(ring, g, S, E); }
    xcd_barrier(bar);
    f_route<false>(p, bid, nb, sm, lctl);
    xcd_barrier(bar);
    f_moe_tables(p, lctl);
    const int vcu = (nb % 8 == 0) ? (bid % 8) * (nb / 8) + bid / 8 : bid;
    const pg8::MoeTab tb{(const LASP int*)lctl + LC_NCNT, (const LASP int*)lctl + LC_TBASE, (const LASP int*)lctl + LC_TILE_E};
    { pg8::Gemm g{(const bf16_t*)(p.ws + OFF_HB), (const bf16_t*)(p.ws + OFF_W13_T), 0, 512, D_MODEL};
      pg8::MoeOrderP S{{tb, 1, lctl[LC_TBASE + 32], nb, vcu, (const int*)(p.ws + OFF_LIST), (unsigned)(D_MODEL * 2)}, (unsigned*)(p.ws + OFF_CTL + CTL_PANEL)};
      pg8::EpiSwiglu E{(bf16_t*)(p.ws + OFF_HG), (const float*)(p.ws + OFF_SLR), tb};
      pg8::gemm_phase_g<pg8::EpiSwiglu, pg8::MoeOrderP, true, true>(ring, g, S, E); }
    __syncthreads();
    { pg8::Gemm g{(const bf16_t*)(p.ws + OFF_HG), (const bf16_t*)(p.ws + OFF_WD_T), 0, D_MODEL, EXP_FF};
      const int ntot = lctl[LC_TBASE + 32];
      pg8::MoeOrderC S{{tb, 2, ntot, nb, vcu, nullptr, 0u}, (const unsigned*)(p.ws + OFF_CTL + CTL_PANEL), 16u, (2 * ntot) % nb, 3};
      pg8::EpiBf16Lean E{(bf16_t*)(p.ws + OFF_YC), D_MODEL, 3};
      pg8::gemm_phase<pg8::EpiBf16Lean, pg8::MoeOrderC, true, true>(ring, g, S, E); }
    xcd_barrier(bar);
    f_final(p, bid, nb, lctl);
}

extern "C" void kernel_launch(void* const* d_in, const int* in_sizes, int n_in, void* d_out, int out_size, void* d_ws, size_t ws_size, hipStream_t stream) {
    if (ws_size < WS_NEED) { fprintf(stderr, "kernel_launch: workspace too small (%zu < %zu)\n", ws_size, WS_NEED); return; }
    P p{};
    const float** f = (const float**)&p;
    for (int i = 0; i < 25; ++i) f[i] = (const float*)d_in[i];
    p.out = (float*)d_out; p.ws = (unsigned char*)d_ws;
    static int grid = 0;
    if (!grid) {
        int dev = 0, cus = 0, per_cu = 0;
        (void)hipGetDevice(&dev);
        (void)hipDeviceGetAttribute(&cus, hipDeviceAttributeMultiprocessorCount, dev);
        if (hipFuncSetAttribute((const void*)k_mega, hipFuncAttributeMaxDynamicSharedMemorySize, LDS_TOTAL) != hipSuccess) { fprintf(stderr, "kernel_launch: hipFuncSetAttribute failed\n"); grid = -1; return; }
        (void)hipOccupancyMaxActiveBlocksPerMultiprocessor(&per_cu, (const void*)k_mega, NT, LDS_TOTAL);
        if (per_cu < 1) fprintf(stderr, "kernel_launch: occupancy query reports %d blocks per CU\n", per_cu);
        grid = cus;
    }
    if (grid < 0) return;
    (void)hipMemsetAsync(p.ws + OFF_CTL, 0, 64 * 1024 + 320 * 256, stream);
    hipLaunchKernelGGL(k_mega, dim3(grid), dim3(NT), LDS_TOTAL, stream, p);
}
```

```cpp
#include <hip/hip_runtime.h>
#include <cstdio>
#include <cstdint>
#include <cmath>


typedef unsigned short bf16_t;
__device__ __forceinline__ int ltid() { int t = threadIdx.x; asm volatile("" : "+v"(t)); return t; }

constexpr int D_MODEL = 1024, BATCH = 16, SEQ = 2048, T_TOK = BATCH * SEQ;
constexpr int NSA_HEADS = 8, NSA_G = 2, NSA_HD = 64, CMP_LEN = 32, CMP_STRIDE = 16, CMP_HID = 128, N_CMP = 127;
constexpr int SEL_BLOCK = 64, SEL_TOPN = 8, WINDOW = 512, N_SEL = SEQ / SEL_BLOCK;
constexpr int DIFF_HEADS = 8, DIFF_HD = 32;
constexpr int D_IN = 2840, LDU = 3072;
constexpr int C_QA = 0, C_KC = 512, C_VC = 640, C_KS = 768, C_VS = 896, C_KW = 1024, C_VW = 1152, C_GATE = 1280, C_QB = 1304, C_KB = 1816, C_VB = 2328;
constexpr int N_EXP = 32, EPG = 8, N_GRP = 4, EXP_FF = 256;
constexpr float EPS = 1e-6f;
constexpr int NT = 512;

constexpr size_t MiB = 1024 * 1024;
constexpr size_t OFF_CTL = 0;
constexpr size_t OFF_RSTD = 64 * 1024;
constexpr size_t OFF_BIASD = 192 * 1024;
constexpr size_t OFF_HID = 1 * MiB;
constexpr size_t OFF_KCMP = 5 * MiB;
constexpr size_t OFF_VCMP = 5 * MiB + 512 * 1024;
constexpr size_t OFF_U = 8 * MiB;
constexpr size_t OFF_ATT = 200 * MiB;
constexpr size_t OFF_H = 264 * MiB;
constexpr size_t OFF_XN = OFF_ATT;
constexpr size_t OFF_WIN_T = 392 * MiB;
constexpr size_t OFF_WOUT_T = 398 * MiB;
constexpr size_t OFF_RW_HI = 6 * MiB;
constexpr size_t OFF_RW_LO = 6 * MiB + 128 * 1024;
constexpr size_t OFF_TOK_EP = 6 * MiB + 512 * 1024;
constexpr size_t OFF_TOK_W = 6 * MiB + 768 * 1024;
constexpr size_t OFF_LIST = 400 * MiB;
constexpr size_t OFF_SLR = 404 * MiB;
constexpr size_t OFF_W13_T = 408 * MiB;
constexpr size_t OFF_WD_T = 440 * MiB;
constexpr size_t OFF_HB = OFF_U;
constexpr size_t OFF_YC = OFF_U + 64 * MiB;
constexpr size_t OFF_HG = OFF_ATT + 16 * MiB;
constexpr size_t OFF_W1T = 7 * MiB;
constexpr size_t OFF_W2T = 1 * MiB;
constexpr size_t OFF_B1 = 1 * MiB + 64 * 1024;
constexpr size_t CTL_PANEL = 65536;
constexpr int CTL_CNT = 8192;
constexpr size_t WS_NEED = 456 * MiB;

struct P {
    const float *x, *rel_bias, *ln_mix, *w_in, *pos_k, *pos_v, *ck1, *ck2, *cv1, *cv2, *lq1, *lk1, *lq2, *lk2, *subln, *w_out, *ln_ffn, *wg, *bg, *we, *be,
        *w_gate, *w_up, *w_down, *ln_final;
    float* out;
    unsigned char* ws;
};

__device__ __forceinline__ float bf2f(bf16_t v) { return __uint_as_float((unsigned)v << 16); }
__device__ __forceinline__ bf16_t f2bf(float f) { unsigned u = __float_as_uint(f); u += 0x7fffu + ((u >> 16) & 1u); return (bf16_t)(u >> 16); }
#define DPP_F(v, ctrl) __uint_as_float((unsigned)__builtin_amdgcn_update_dpp(0, (int)__float_as_uint(v), ctrl, 0xf, 0xf, true))
__device__ __forceinline__ float pl16_sum(float v) { const auto rr = __builtin_amdgcn_permlane16_swap(__float_as_uint(v), __float_as_uint(v), false, false); return __uint_as_float(rr[0]) + __uint_as_float(rr[1]); }
__device__ __forceinline__ float pl16_max(float v) { const auto rr = __builtin_amdgcn_permlane16_swap(__float_as_uint(v), __float_as_uint(v), false, false); return fmaxf(__uint_as_float(rr[0]), __uint_as_float(rr[1])); }
__device__ __forceinline__ float pl32_sum(float v) { const auto rr = __builtin_amdgcn_permlane32_swap(__float_as_uint(v), __float_as_uint(v), false, false); return __uint_as_float(rr[0]) + __uint_as_float(rr[1]); }
__device__ __forceinline__ float pl32_max(float v) { const auto rr = __builtin_amdgcn_permlane32_swap(__float_as_uint(v), __float_as_uint(v), false, false); return fmaxf(__uint_as_float(rr[0]), __uint_as_float(rr[1])); }
__device__ __forceinline__ float pl32_other(float v) { const unsigned u = __float_as_uint(v); const auto rr = __builtin_amdgcn_permlane32_swap(u, u, false, false); return __uint_as_float(rr[0] != u ? rr[0] : rr[1]); }
__device__ __forceinline__ float wave_sum(float v) {
    v += DPP_F(v, 0xB1); v += DPP_F(v, 0x4E); v += DPP_F(v, 0x141); v += DPP_F(v, 0x140);
    return pl32_sum(pl16_sum(v));
}
__device__ __forceinline__ float wave_max(float v) {
    v = fmaxf(v, DPP_F(v, 0xB1)); v = fmaxf(v, DPP_F(v, 0x4E)); v = fmaxf(v, DPP_F(v, 0x141)); v = fmaxf(v, DPP_F(v, 0x140));
    return pl32_max(pl16_max(v));
}
__device__ __forceinline__ int t5_bucket(int n) {
    if (n < 16) return n;
    const float nf = (float)n;
    int large = 16 + (int)(logf(nf / 16.0f) / 2.0794415416798357f * 16.0f);
    return large < 31 ? large : 31;
}
__device__ __forceinline__ float gelu_tanh(float x) { return 0.5f * x * (1.0f + tanhf(0.7978845608028654f * (x + 0.044715f * x * x * x))); }
__device__ __forceinline__ float sigmoidf_(float x) { return 1.0f / (1.0f + expf(-x)); }

namespace pg8 {
#define PG8_LAS __attribute__((address_space(3)))
typedef unsigned short bf16_t;
typedef short bf16x8 __attribute__((ext_vector_type(8)));
typedef float f32x4 __attribute__((ext_vector_type(4)));
typedef unsigned u32x4 __attribute__((ext_vector_type(4)));
constexpr int BM = 256, BK = 64, HALF = 128, HTB = HALF * BK * 2  , STAGE_BYTES = 8 * HTB, NXCD = 8, WGM = 8;

__host__ __device__ __forceinline__ int lds_byte(int r, int c) { const int st = (r >> 4) * 2 + (c >> 5), rr = r & 15, cc = c & 31, ob = rr * 64 + cc * 2; return st * 1024 + (ob ^ (((ob >> 9) & 1) << 5)); }
__host__ __device__ __forceinline__ void stage_rc(int b, int& R, int& C) { const int st = b / 1024, sb = b % 1024, swz = sb ^ (((sb >> 9) & 1) << 5); R = (st >> 1) * 16 + swz / 64; C = (st & 1) * 32 + (swz % 64) / 2; }
__host__ __device__ __forceinline__ int perm32(int rho) { const int n = rho >> 4, i = rho & 15; return 8 * (i >> 2) + 4 * n + (i & 3); }

struct Unit { int pm, pn; };
struct Gemm { const bf16_t* A; const bf16_t* Bt; int M, N, K; };

struct StaticOrder {
    int nM, nN, nwg, G, c;
    __host__ __device__ void init(int M, int N, int G_, int c_) { nM = M / BM; nN = N / BM; nwg = nM * nN; G = G_; c = c_; }
    __host__ __device__ bool next(int i, Unit& u) const {
        const long L = (long)i * G + c; if (L >= nwg) return false;
        int wgid = (int)L; { const int q = nwg / NXCD, r = nwg % NXCD, xcd = wgid % NXCD, off = wgid / NXCD; wgid = (xcd < r ? xcd * (q + 1) : r * (q + 1) + (xcd - r) * q) + off; }
        const int nig = WGM * nN, gid = wgid / nig, fm = gid * WGM, gsz = (nM - fm) < WGM ? (nM - fm) : WGM;
        u.pm = fm + ((wgid % nig) % gsz); u.pn = (wgid % nig) / gsz; return true;
    }
    __device__ __forceinline__ void a_ready(const Unit&) const {}
    __device__ __forceinline__ unsigned peek(const Unit&) const { return 0u; }
    __device__ __forceinline__ void a_ready(const Unit&, unsigned) const {}
    __device__ __forceinline__ void done(const Unit&) const {}
};

__device__ __forceinline__ unsigned cvt_pk_bf16(float lo, float hi) { unsigned r; asm volatile("v_cvt_pk_bf16_f32 %0, %1, %2" : "=v"(r) : "v"(lo), "v"(hi)); return r; }
typedef float f32x2 __attribute__((ext_vector_type(2)));
__device__ __forceinline__ f32x2 gelu_pk(f32x2 v) {
    const f32x2 av = __builtin_elementwise_abs(v), d = av * 0.2316418882f + 1.0f;
    f32x2 t; t.x = __builtin_amdgcn_rcpf(d.x); t.y = __builtin_amdgcn_rcpf(d.y);
    f32x2 q = t * 0.5307027145f + (-0.7265760135f); q = q * t + 0.7107068705f; q = q * t + (-0.142248368f); q = q * t + 0.127414796f; q = q * t;
    const f32x2 s = (v * v) * (-0.72134752044f);
    f32x2 e; e.x = __builtin_amdgcn_exp2f(s.x); e.y = __builtin_amdgcn_exp2f(s.y);
    const f32x2 m = v * (q * e), r = v - m;
    f32x2 o; o.x = v.x < 0.f ? m.x : r.x; o.y = v.y < 0.f ? m.y : r.y; return o;
}

template <int ACT  > struct EpiBf16 {
    static constexpr bool PERM = true, AFTER_DRAIN = false; static_assert(ACT == 0 || ACT == 1, "EpiBf16: ACT is 0 (none) or 1 (gelu_pk)");
    bf16_t* O; int ldc; const float* bias; int split_cols; size_t split_stride; float scale0;
    __device__ __forceinline__ void operator()(const f32x4 (&acc)[2][2][4][2], const Unit& u, int wr, int wc, int fr, int fq) const {
        const int row0 = u.pm * BM + wr * 64 + fr; int colt = u.pn * BM; bf16_t* base = O;
        float sc = 1.f; if (split_cols) { const int t = colt / split_cols; base += (size_t)t * split_stride; colt -= t * split_cols; if (t == 0) sc = scale0; }
        const int col0 = colt + wc * 32 + 8 * fq, bcol0 = u.pn * BM + wc * 32 + 8 * fq;
        f32x4 bv[2][2];
#pragma unroll
        for (int bj = 0; bj < 2; ++bj)
#pragma unroll
            for (int n = 0; n < 2; ++n) bv[bj][n] = bias ? *(const f32x4*)(bias + bcol0 + bj * HALF + 4 * n) : (f32x4){0.f, 0.f, 0.f, 0.f};
#pragma unroll
        for (int ai = 0; ai < 2; ++ai)
#pragma unroll
            for (int m = 0; m < 4; ++m) { bf16_t* rowp = base + (size_t)(row0 + ai * HALF + m * 16) * ldc + col0;
#pragma unroll
                for (int bj = 0; bj < 2; ++bj) { f32x4 v0 = acc[ai][bj][m][0] + bv[bj][0], v1 = acc[ai][bj][m][1] + bv[bj][1];
                    if (ACT == 1) { f32x2 a = gelu_pk((f32x2){v0[0], v0[1]}), b = gelu_pk((f32x2){v0[2], v0[3]}), c = gelu_pk((f32x2){v1[0], v1[1]}), d = gelu_pk((f32x2){v1[2], v1[3]});
                        v0 = (f32x4){a.x, a.y, b.x, b.y}; v1 = (f32x4){c.x, c.y, d.x, d.y}; }
                    v0 = v0 * sc; v1 = v1 * sc; u32x4 w; w.x = cvt_pk_bf16(v0[0], v0[1]); w.y = cvt_pk_bf16(v0[2], v0[3]); w.z = cvt_pk_bf16(v1[0], v1[1]); w.w = cvt_pk_bf16(v1[2], v1[3]);
                    *(u32x4*)(rowp + bj * HALF) = w; } }
    }
};
template <class Epi, class Sched, bool ALIGN_EPI = false, bool SP2 = false>
__device__ __forceinline__ void gemm_phase(PG8_LAS unsigned char* lds, const Gemm g, const Sched& S, const Epi& E) {
    const int tid = ltid(), wid = __builtin_amdgcn_readfirstlane(tid >> 6), lane = tid & 63, wr = wid >> 2, wc = wid & 3, fr = lane & 15, fq = lane >> 4;
    const int K = g.K, nt = K / BK;
    unsigned voffA[2], voffB[2];
#pragma unroll
    for (int i = 0; i < 2; ++i) { int R, C; stage_rc(tid * 16 + i * 8192, R, C); const int Rb = Epi::PERM ? ((R & ~31) + perm32(R & 31)) : R;
        voffA[i] = (unsigned)(R * K + C) * 2u; voffB[i] = (unsigned)(Rb * K + C) * 2u; }
    const size_t kstep = (size_t)(BK * 2);
    const size_t hstep = (size_t)HALF * K * 2;
    const size_t tstep = 2 * hstep;
    const unsigned ldsw = (unsigned)wid * 1024u;
    const int aoff = lds_byte(wr * 64 + fr, fq * 8), boff = lds_byte(wc * 32 + fr, fq * 8);
#define PG8_SA(b, h) (((b) * 2 + (h)) * HTB)
#define PG8_SB(b, h) ((4 + (b) * 2 + (h)) * HTB)
#define PG8_STAGE(bufoff, gbase, voff) do { _Pragma("unroll") for (int _i = 0; _i < 2; ++_i) \
        __builtin_amdgcn_global_load_lds((const unsigned*)((const char*)(gbase) + (voff)[_i]), (PG8_LAS unsigned*)(lds + (bufoff) + ldsw + _i * 8192), 16, 0, 0); } while (0)
#define PG8_LDA(dst, b, h) do { _Pragma("unroll") for (int m = 0; m < 4; ++m) _Pragma("unroll") for (int k = 0; k < 2; ++k) dst[m][k] = *(const PG8_LAS bf16x8*)(lds + PG8_SA(b, h) + aoff + m * 2048 + k * 1024); } while (0)
#define PG8_LDB(dst, b, h) do { _Pragma("unroll") for (int n = 0; n < 2; ++n) _Pragma("unroll") for (int k = 0; k < 2; ++k) dst[n][k] = *(const PG8_LAS bf16x8*)(lds + PG8_SB(b, h) + boff + n * 2048 + k * 1024); } while (0)
#define PG8_MMA(ai, bj, At, Bt) do { __builtin_amdgcn_s_setprio(1); _Pragma("unroll") for (int m = 0; m < 4; ++m) _Pragma("unroll") for (int n = 0; n < 2; ++n) _Pragma("unroll") for (int k = 0; k < 2; ++k) \
        acc[ai][bj][m][n] = __builtin_amdgcn_mfma_f32_16x16x32_bf16(Bt[n][k], At[m][k], acc[ai][bj][m][n], 0, 0, 0); __builtin_amdgcn_s_setprio(0); } while (0)
#define PG8_WAIT_V(n) asm volatile("s_waitcnt vmcnt(" #n ")" ::: "memory")
#define PG8_WAIT_L(n) asm volatile("s_waitcnt lgkmcnt(" #n ")" ::: "memory")
#define PG8_BAR __builtin_amdgcn_s_barrier()
#define PG8_SCHED __builtin_amdgcn_sched_barrier(0)
    Unit cur, nxt; int ui = 0;
    if (!S.next(0, cur)) return;
    f32x4 acc[2][2][4][2];
#pragma unroll
    for (int a = 0; a < 2; ++a)
#pragma unroll
        for (int b = 0; b < 2; ++b)
#pragma unroll
            for (int m = 0; m < 4; ++m)
#pragma unroll
                for (int n = 0; n < 2; ++n) acc[a][b][m][n] = (f32x4){0.f, 0.f, 0.f, 0.f};
    bf16x8 At[4][2], B0[2][2], B1[2][2];
    const char* cA = (const char*)g.A + (size_t)cur.pm * tstep; const char* cB = (const char*)g.Bt + (size_t)cur.pn * tstep;
    S.a_ready(cur);
    if constexpr (SP2) {
        PG8_STAGE(PG8_SB(0, 0), cB, voffB); PG8_STAGE(PG8_SB(0, 1), cB + hstep, voffB); PG8_STAGE(PG8_SA(0, 0), cA, voffA); PG8_STAGE(PG8_SA(0, 1), cA + hstep, voffA);
        if (wr == 1) PG8_BAR;
        PG8_WAIT_V(2); PG8_BAR;
        PG8_STAGE(PG8_SB(1, 0), cB + kstep, voffB); PG8_STAGE(PG8_SA(1, 0), cA + kstep, voffA); PG8_STAGE(PG8_SB(1, 1), cB + hstep + kstep, voffB);
        PG8_WAIT_V(6); PG8_BAR;
    } else {
        PG8_STAGE(PG8_SB(0, 0), cB, voffB); PG8_STAGE(PG8_SA(0, 0), cA, voffA); PG8_STAGE(PG8_SB(0, 1), cB + hstep, voffB); PG8_STAGE(PG8_SA(0, 1), cA + hstep, voffA);
        if (wr == 1) PG8_BAR;
        PG8_WAIT_V(4); PG8_BAR;
        PG8_STAGE(PG8_SB(1, 0), cB + kstep, voffB); PG8_STAGE(PG8_SA(1, 0), cA + kstep, voffA); PG8_STAGE(PG8_SB(1, 1), cB + hstep + kstep, voffB);
        PG8_WAIT_V(6); PG8_BAR;
    }
    for (;;) {
        const bool has_next = S.next(ui + 1, nxt);
        const unsigned pk_ = has_next ? S.peek(nxt) : 0u;
        const char* nA = has_next ? (const char*)g.A + (size_t)nxt.pm * tstep : cA; const char* nB = has_next ? (const char*)g.Bt + (size_t)nxt.pn * tstep : cB;
#pragma nounroll
        for (int t = 0; t < nt; t += 2) {
            const bool last = (t == nt - 2);
            const char* a1 = cA + (size_t)(t + 1) * kstep;
            const char* a2 = last ? nA : cA + (size_t)(t + 2) * kstep; const char* b2 = last ? nB : cB + (size_t)(t + 2) * kstep;
            const char* a3 = a2 + kstep; const char* b3 = b2 + kstep;
            if (last && has_next) S.a_ready(nxt, pk_);
            if constexpr (SP2) {
            PG8_LDB(B0, 0, 0); PG8_LDB(B1, 0, 1); PG8_SCHED; PG8_LDA(At, 0, 0); PG8_STAGE(PG8_SA(1, 1), a1 + hstep, voffA);
            PG8_WAIT_V(8); PG8_WAIT_L(0); PG8_BAR; PG8_MMA(0, 0, At, B0); PG8_MMA(0, 1, At, B1); PG8_BAR; PG8_SCHED;
            PG8_LDA(At, 0, 1); PG8_STAGE(PG8_SB(0, 0), b2, voffB); PG8_STAGE(PG8_SB(0, 1), b2 + hstep, voffB); PG8_STAGE(PG8_SA(0, 0), a2, voffA);
            PG8_WAIT_V(8); PG8_WAIT_L(0); PG8_BAR; PG8_MMA(1, 0, At, B0); PG8_MMA(1, 1, At, B1); PG8_BAR; PG8_SCHED;
            PG8_LDB(B0, 1, 0); PG8_LDB(B1, 1, 1); PG8_SCHED; PG8_LDA(At, 1, 0); PG8_STAGE(PG8_SA(0, 1), a2 + hstep, voffA);
            PG8_WAIT_V(8); PG8_WAIT_L(0); PG8_BAR; PG8_MMA(0, 0, At, B0); PG8_MMA(0, 1, At, B1); PG8_BAR; PG8_SCHED;
            PG8_LDA(At, 1, 1); PG8_STAGE(PG8_SB(1, 0), b3, voffB); PG8_STAGE(PG8_SB(1, 1), b3 + hstep, voffB); PG8_STAGE(PG8_SA(1, 0), a3, voffA);
            PG8_WAIT_V(8); PG8_WAIT_L(0); PG8_BAR; PG8_MMA(1, 0, At, B0); PG8_MMA(1, 1, At, B1); PG8_BAR; PG8_SCHED;
            } else {
            PG8_LDB(B0, 0, 0); PG8_SCHED; PG8_LDA(At, 0, 0); PG8_STAGE(PG8_SA(1, 1), a1 + hstep, voffA);
            PG8_WAIT_L(8); PG8_BAR; PG8_WAIT_L(0); PG8_MMA(0, 0, At, B0); PG8_BAR; PG8_SCHED;
            PG8_LDB(B1, 0, 1); PG8_STAGE(PG8_SB(0, 0), b2, voffB);
            PG8_BAR; PG8_WAIT_L(0); PG8_MMA(0, 1, At, B1); PG8_BAR;
            PG8_LDA(At, 0, 1); PG8_STAGE(PG8_SA(0, 0), a2, voffA);
            PG8_BAR; PG8_WAIT_L(0); PG8_MMA(1, 0, At, B0); PG8_BAR; PG8_SCHED;
            PG8_STAGE(PG8_SB(0, 1), b2 + hstep, voffB);
            PG8_WAIT_V(6); PG8_BAR; PG8_MMA(1, 1, At, B1); PG8_BAR;
            PG8_LDB(B0, 1, 0); PG8_SCHED; PG8_LDA(At, 1, 0); PG8_STAGE(PG8_SA(0, 1), a2 + hstep, voffA);
            PG8_WAIT_L(8); PG8_BAR; PG8_WAIT_L(0); PG8_MMA(0, 0, At, B0); PG8_BAR; PG8_SCHED;
            PG8_LDB(B1, 1, 1); PG8_STAGE(PG8_SB(1, 0), b3, voffB);
            PG8_BAR; PG8_WAIT_L(0); PG8_MMA(0, 1, At, B1); PG8_BAR;
            PG8_LDA(At, 1, 1); PG8_STAGE(PG8_SA(1, 0), a3, voffA);
            PG8_BAR; PG8_WAIT_L(0); PG8_MMA(1, 0, At, B0); PG8_BAR; PG8_SCHED;
            PG8_STAGE(PG8_SB(1, 1), b3 + hstep, voffB);
            PG8_WAIT_V(6); PG8_BAR; PG8_MMA(1, 1, At, B1); PG8_BAR;
            }
        }
        if constexpr (ALIGN_EPI) { if (wr == 0) PG8_BAR; }
        if constexpr (!Epi::AFTER_DRAIN) { int fr2 = fr, fq2 = fq; asm volatile("" : "+v"(fr2), "+v"(fq2)); E(acc, cur, wr, wc, fr2, fq2); S.done(cur); }
        if (!has_next) break;
#pragma unroll
        for (int a = 0; a < 2; ++a)
#pragma unroll
            for (int b = 0; b < 2; ++b)
#pragma unroll
                for (int m = 0; m < 4; ++m)
#pragma unroll
                    for (int n = 0; n < 2; ++n) acc[a][b][m][n] = (f32x4){0.f, 0.f, 0.f, 0.f};
        cur = nxt; cA = nA; cB = nB; ++ui;
        if constexpr (ALIGN_EPI) { if (wr == 1) PG8_BAR; }
    }
    PG8_WAIT_V(0);
    if constexpr (!ALIGN_EPI) { if (wr == 0) PG8_BAR; }
    PG8_BAR;
    if constexpr (Epi::AFTER_DRAIN) { E.fused(acc, cur, wr, wc, fr, fq, lds, wid, lane); S.done(cur); }
#undef PG8_SA
#undef PG8_SB
#undef PG8_STAGE
#undef PG8_LDA
#undef PG8_LDB
#undef PG8_MMA
#undef PG8_WAIT_V
#undef PG8_WAIT_L
#undef PG8_BAR
#undef PG8_SCHED
}
}

namespace pg8 {
struct EpiResF32 {
    static constexpr bool PERM = true, AFTER_DRAIN = false;
    const float* base; bf16_t* hb; int ldc;
    __device__ __forceinline__ void operator()(const f32x4 (&acc)[2][2][4][2], const Unit& u, int wr, int wc, int fr, int fq) const {
        const int row0 = u.pm * BM + wr * 64 + fr, col0 = u.pn * BM + wc * 32 + 8 * fq;
#pragma unroll
        for (int ai = 0; ai < 2; ++ai)
#pragma unroll
            for (int m = 0; m < 4; ++m) { const size_t off = (size_t)(row0 + ai * HALF + m * 16) * ldc + col0;
#pragma unroll
                for (int bj = 0; bj < 2; ++bj) { const f32x4 h0 = *(const f32x4*)(base + off + bj * HALF) + acc[ai][bj][m][0], h1 = *(const f32x4*)(base + off + bj * HALF + 4) + acc[ai][bj][m][1];
                    u32x4 w; w.x = cvt_pk_bf16(h0[0], h0[1]); w.y = cvt_pk_bf16(h0[2], h0[3]); w.z = cvt_pk_bf16(h1[0], h1[1]); w.w = cvt_pk_bf16(h1[2], h1[3]);
                    *(u32x4*)(hb + off + bj * HALF) = w; } }
    }
};

struct EpiBf16Lean {
    static constexpr bool PERM = true, AFTER_DRAIN = false;
    bf16_t* O; int ldc; int pnmask;
    __device__ __forceinline__ void operator()(const f32x4 (&acc)[2][2][4][2], const Unit& u, int wr, int wc, int fr, int fq) const {
        bf16_t* base = O + (size_t)(u.pm * BM + wr * 64 + fr) * ldc + (u.pn & pnmask) * BM + wc * 32 + 8 * fq;
#pragma unroll
        for (int ai = 0; ai < 2; ++ai)
#pragma unroll
            for (int m = 0; m < 4; ++m) { bf16_t* rowp = base + (size_t)(ai * HALF + m * 16) * ldc;
#pragma unroll
                for (int bj = 0; bj < 2; ++bj) { const f32x4 v0 = acc[ai][bj][m][0], v1 = acc[ai][bj][m][1];
                    u32x4 w; w.x = cvt_pk_bf16(v0[0], v0[1]); w.y = cvt_pk_bf16(v0[2], v0[3]); w.z = cvt_pk_bf16(v1[0], v1[1]); w.w = cvt_pk_bf16(v1[2], v1[3]);
                    *(u32x4*)(rowp + bj * HALF) = w; } }
    }
};

template <class Epi, class Sched, bool ALIGN_EPI, bool GATHER>
__device__ __forceinline__ void gemm_phase_g(PG8_LAS unsigned char* lds, const Gemm g, const Sched& S, const Epi& E) {
    const int tid = ltid(), wid = __builtin_amdgcn_readfirstlane(tid >> 6), lane = tid & 63, wr = wid >> 2, wc = wid & 3, fr = lane & 15, fq = lane >> 4;
    const int K = g.K, nt = K / BK;
    unsigned voffB[2];
#pragma unroll
    for (int i = 0; i < 2; ++i) { int R, C; stage_rc(tid * 16 + i * 8192, R, C); const int Rb = Epi::PERM ? ((R & ~31) + perm32(R & 31)) : R; voffB[i] = (unsigned)(Rb * K + C) * 2u; }
    const size_t kstep = (size_t)(BK * 2), hstep = (size_t)HALF * K * 2, tstep = 2 * hstep;
    const unsigned ldsw = (unsigned)wid * 1024u;
    const int aoff = lds_byte(wr * 64 + fr, fq * 8), boff = lds_byte(wc * 32 + fr, fq * 8);
#define PG8_SA(b, h) (((b) * 2 + (h)) * HTB)
#define PG8_SB(b, h) ((4 + (b) * 2 + (h)) * HTB)
#define PG8_STAGE(bufoff, gbase, voff) do { _Pragma("unroll") for (int _i = 0; _i < 2; ++_i) \
        __builtin_amdgcn_global_load_lds((const unsigned*)((const char*)(gbase) + (voff)[_i]), (PG8_LAS unsigned*)(lds + (bufoff) + ldsw + _i * 8192), 16, 0, 0); } while (0)
#define PG8_LDA(dst, b, h) do { _Pragma("unroll") for (int m = 0; m < 4; ++m) _Pragma("unroll") for (int k = 0; k < 2; ++k) dst[m][k] = *(const PG8_LAS bf16x8*)(lds + PG8_SA(b, h) + aoff + m * 2048 + k * 1024); } while (0)
#define PG8_LDB(dst, b, h) do { _Pragma("unroll") for (int n = 0; n < 2; ++n) _Pragma("unroll") for (int k = 0; k < 2; ++k) dst[n][k] = *(const PG8_LAS bf16x8*)(lds + PG8_SB(b, h) + boff + n * 2048 + k * 1024); } while (0)
#define PG8_MMA(ai, bj, At, Bt) do { __builtin_amdgcn_s_setprio(1); _Pragma("unroll") for (int m = 0; m < 4; ++m) _Pragma("unroll") for (int n = 0; n < 2; ++n) _Pragma("unroll") for (int k = 0; k < 2; ++k) \
        acc[ai][bj][m][n] = __builtin_amdgcn_mfma_f32_16x16x32_bf16(Bt[n][k], At[m][k], acc[ai][bj][m][n], 0, 0, 0); __builtin_amdgcn_s_setprio(0); } while (0)
#define PG8_WAIT_V(n) asm volatile("s_waitcnt vmcnt(" #n ")" ::: "memory")
#define PG8_WAIT_L(n) asm volatile("s_waitcnt lgkmcnt(" #n ")" ::: "memory")
#define PG8_BAR __builtin_amdgcn_s_barrier()
#define PG8_SCHED __builtin_amdgcn_sched_barrier(0)
#define PG8_OFFS(u, o) do { _Pragma("unroll") for (int _h = 0; _h < 2; ++_h) _Pragma("unroll") for (int _i = 0; _i < 2; ++_i) { int R_, C_; stage_rc(tid * 16 + _i * 8192, R_, C_); \
        if constexpr (GATHER) o[_h][_i] = S.rowoff(u, _h * HALF + R_) + (unsigned)C_ * 2u; else o[_h][_i] = (unsigned)((_h * HALF + R_) * K + C_) * 2u; } } while (0)
    Unit cur, nxt; int ui = 0;
    if (!S.next(0, cur)) return;
    f32x4 acc[2][2][4][2];
#pragma unroll
    for (int a = 0; a < 2; ++a)
#pragma unroll
        for (int b = 0; b < 2; ++b)
#pragma unroll
            for (int m = 0; m < 4; ++m)
#pragma unroll
                for (int n = 0; n < 2; ++n) acc[a][b][m][n] = (f32x4){0.f, 0.f, 0.f, 0.f};
    bf16x8 At[4][2], B0[2][2], B1[2][2];
    unsigned vo[2][2], nvo[2][2];
    const char* cA = GATHER ? (const char*)g.A : (const char*)g.A + (size_t)cur.pm * tstep; const char* cB = (const char*)g.Bt + (size_t)cur.pn * tstep;
    PG8_OFFS(cur, vo);
    PG8_STAGE(PG8_SB(0, 0), cB, voffB); PG8_STAGE(PG8_SB(0, 1), cB + hstep, voffB); PG8_STAGE(PG8_SA(0, 0), cA, vo[0]); PG8_STAGE(PG8_SA(0, 1), cA, vo[1]);
    if (wr == 1) PG8_BAR;
    PG8_WAIT_V(2); PG8_BAR;
    PG8_STAGE(PG8_SB(1, 0), cB + kstep, voffB); PG8_STAGE(PG8_SA(1, 0), cA + kstep, vo[0]); PG8_STAGE(PG8_SB(1, 1), cB + hstep + kstep, voffB);
    PG8_WAIT_V(6); PG8_BAR;
    for (;;) {
        const bool has_next = S.next(ui + 1, nxt);
        const char* nA = has_next ? (GATHER ? (const char*)g.A : (const char*)g.A + (size_t)nxt.pm * tstep) : cA; const char* nB = has_next ? (const char*)g.Bt + (size_t)nxt.pn * tstep : cB;
        if constexpr (GATHER) { if (has_next) { PG8_OFFS(nxt, nvo); } else { nvo[0][0] = vo[0][0]; nvo[0][1] = vo[0][1]; nvo[1][0] = vo[1][0]; nvo[1][1] = vo[1][1]; } }
#pragma nounroll
        for (int t = 0; t < nt; t += 2) {
            const bool last = (t == nt - 2);
            const char* a1 = cA + (size_t)(t + 1) * kstep;
            const char* a2 = last ? nA : cA + (size_t)(t + 2) * kstep; const char* b2 = last ? nB : cB + (size_t)(t + 2) * kstep;
            const char* a3 = a2 + kstep; const char* b3 = b2 + kstep;
            PG8_LDB(B0, 0, 0); PG8_LDB(B1, 0, 1); PG8_SCHED; PG8_LDA(At, 0, 0); PG8_STAGE(PG8_SA(1, 1), a1, vo[1]);
            if constexpr (GATHER) { if (last) { vo[0][0] = nvo[0][0]; vo[0][1] = nvo[0][1]; vo[1][0] = nvo[1][0]; vo[1][1] = nvo[1][1]; } }
            PG8_WAIT_V(8); PG8_WAIT_L(0); PG8_BAR; PG8_MMA(0, 0, At, B0); PG8_MMA(0, 1, At, B1); PG8_BAR; PG8_SCHED;
            PG8_LDA(At, 0, 1); PG8_STAGE(PG8_SB(0, 0), b2, voffB); PG8_STAGE(PG8_SB(0, 1), b2 + hstep, voffB); PG8_STAGE(PG8_SA(0, 0), a2, vo[0]);
            PG8_WAIT_V(8); PG8_WAIT_L(0); PG8_BAR; PG8_MMA(1, 0, At, B0); PG8_MMA(1, 1, At, B1); PG8_BAR; PG8_SCHED;
            PG8_LDB(B0, 1, 0); PG8_LDB(B1, 1, 1); PG8_SCHED; PG8_LDA(At, 1, 0); PG8_STAGE(PG8_SA(0, 1), a2, vo[1]);
            PG8_WAIT_V(8); PG8_WAIT_L(0); PG8_BAR; PG8_MMA(0, 0, At, B0); PG8_MMA(0, 1, At, B1); PG8_BAR; PG8_SCHED;
            PG8_LDA(At, 1, 1); PG8_STAGE(PG8_SB(1, 0), b3, voffB); PG8_STAGE(PG8_SB(1, 1), b3 + hstep, voffB); PG8_STAGE(PG8_SA(1, 0), a3, vo[0]);
            PG8_WAIT_V(8); PG8_WAIT_L(0); PG8_BAR; PG8_MMA(1, 0, At, B0); PG8_MMA(1, 1, At, B1); PG8_BAR; PG8_SCHED;
        }
        if constexpr (ALIGN_EPI) { if (wr == 0) PG8_BAR; }
        { int fr2 = fr, fq2 = fq; asm volatile("" : "+v"(fr2), "+v"(fq2)); E(acc, cur, wr, wc, fr2, fq2); S.done(cur); }
        if (!has_next) break;
#pragma unroll
        for (int a = 0; a < 2; ++a)
#pragma unroll
            for (int b = 0; b < 2; ++b)
#pragma unroll
                for (int m = 0; m < 4; ++m)
#pragma unroll
                    for (int n = 0; n < 2; ++n) acc[a][b][m][n] = (f32x4){0.f, 0.f, 0.f, 0.f};
        cur = nxt; cA = nA; cB = nB; ++ui;
        if constexpr (ALIGN_EPI) { if (wr == 1) PG8_BAR; }
    }
    PG8_WAIT_V(0);
    if constexpr (!ALIGN_EPI) { if (wr == 0) PG8_BAR; }
    PG8_BAR;
#undef PG8_SA
#undef PG8_SB
#undef PG8_STAGE
#undef PG8_LDA
#undef PG8_LDB
#undef PG8_MMA
#undef PG8_WAIT_V
#undef PG8_WAIT_L
#undef PG8_BAR
#undef PG8_SCHED
#undef PG8_OFFS
}

struct MoeTab { const PG8_LAS int* ncnt; const PG8_LAS int* tbase; const PG8_LAS int* tile_e; };
struct MoeOrder {
    MoeTab tb; int sh  , ntot, G, c; const int* list; unsigned rowbytes;
    __device__ __forceinline__ bool next(int i, Unit& u) const {
        const int L = i * G + c; if (L >= (ntot << sh)) return false;
        const int pm = L >> sh, pl = L & ((1 << sh) - 1); u.pm = pm; u.pn = (tb.tile_e[pm] << sh) + pl; return true;
    }
    __device__ __forceinline__ unsigned rowoff(const Unit& u, int r) const {
        const int e = tb.tile_e[u.pm]; int pos = (u.pm - tb.tbase[e]) * BM + r; const int n = tb.ncnt[e]; pos = pos < n ? pos : n - 1;
        return (unsigned)list[(size_t)e * 32768 + pos] * rowbytes;
    }
    __device__ __forceinline__ void a_ready(const Unit&) const {}
    __device__ __forceinline__ unsigned peek(const Unit&) const { return 0u; }
    __device__ __forceinline__ void a_ready(const Unit&, unsigned) const {}
    __device__ __forceinline__ void done(const Unit&) const {}
};
struct MoeOrderP : MoeOrder {
    unsigned* ready;
    __device__ __forceinline__ void done(const Unit& u) const {
        asm volatile("s_waitcnt vmcnt(0)" ::: "memory");
        if ((threadIdx.x & 63) == 0) __hip_atomic_fetch_add(ready + 64 * u.pm, 1u, __ATOMIC_RELAXED, __HIP_MEMORY_SCOPE_AGENT);
    }
};
struct MoeOrderC : MoeOrder {
    const unsigned* ready; unsigned need; int nh, sk;
    __device__ __forceinline__ bool next(int i, Unit& u) const {
        const int nl = G - nh, heavy = c < nh, ra = heavy ? nl + c : c - nh;
        int L;
        if (heavy) L = sk * nl + i * G + ra; else L = (i < sk) ? i * nl + ra : sk * nl + (i - sk) * G + ra;
        if (L >= (ntot << sh)) return false;
        const int pm = L >> sh, pl = L & ((1 << sh) - 1); u.pm = pm; u.pn = (tb.tile_e[pm] << sh) + pl; return true;
    }
    __device__ __forceinline__ unsigned peek(const Unit& u) const {
        unsigned v = 0u; if (threadIdx.x < 64) v = __hip_atomic_load(ready + 64 * u.pm, __ATOMIC_RELAXED, __HIP_MEMORY_SCOPE_AGENT); return v;
    }
    __device__ __forceinline__ void a_ready(const Unit& u, unsigned peeked) const {
        if (threadIdx.x < 64) {
            unsigned polls = 0, pa = peeked;
            while ((unsigned)__builtin_amdgcn_readfirstlane(pa) < need) {
                if (++polls > (1u << 22)) break;
                __builtin_amdgcn_s_sleep(2); pa = __hip_atomic_load(ready + 64 * u.pm, __ATOMIC_RELAXED, __HIP_MEMORY_SCOPE_AGENT); }
            __builtin_amdgcn_fence(__ATOMIC_ACQUIRE, "agent");
            asm volatile("s_waitcnt vmcnt(0)" ::: "memory");
        }
        asm volatile("" ::: "memory"); __builtin_amdgcn_s_barrier(); asm volatile("" ::: "memory");
    }
    __device__ __forceinline__ void a_ready(const Unit& u) const { a_ready(u, 0u); }
};
struct EpiSwiglu {
    static constexpr bool PERM = false, AFTER_DRAIN = false;
    bf16_t* HG; const float* slr; MoeTab tb;
    __device__ __forceinline__ void operator()(const f32x4 (&acc)[2][2][4][2], const Unit& u, int wr, int wc, int fr, int fq) const {
        const int e = tb.tile_e[u.pm], pl = u.pn & 1, ne = tb.ncnt[e], pos0 = (u.pm - tb.tbase[e]) * BM;
#pragma unroll
        for (int ai = 0; ai < 2; ++ai)
#pragma unroll
            for (int m = 0; m < 4; ++m) {
                const int r = ai * HALF + wr * 64 + m * 16 + fr; int pos = pos0 + r; pos = pos < ne ? pos : ne - 1;
                const float rs = slr[(size_t)e * 32768 + pos];
                bf16_t* dst = HG + (size_t)(u.pm * BM + r) * 256 + pl * 128 + wc * 32 + 4 * fq;
#pragma unroll
                for (int n = 0; n < 2; ++n) { const f32x4 gt = acc[ai][0][m][n] * rs, up = acc[ai][1][m][n] * rs; float hv[4];
#pragma unroll
                    for (int j = 0; j < 4; ++j) hv[j] = gt[j] / (1.0f + __expf(-gt[j])) * up[j];
                    const unsigned long long w = (unsigned long long)cvt_pk_bf16(hv[0], hv[1]) | ((unsigned long long)cvt_pk_bf16(hv[2], hv[3]) << 32);
                    __hip_atomic_store((__attribute__((address_space(1))) unsigned long long*)(dst + n * 16), w, __ATOMIC_RELAXED, __HIP_MEMORY_SCOPE_AGENT); }
            }
    }
};
}
#define LASP __attribute__((address_space(3)))
constexpr int T16_N = 177, AL_T16 = 135168 + 4096;
constexpr int RING_BYTES = 135168, LDS_CTL_OFF = RING_BYTES, LDS_TOTAL = RING_BYTES + 4096 + 4 * T16_N * 16;
constexpr int LC_NCNT = 16, LC_TBASE = 48, LC_TILE_E = 96, LC_LCNT = 448, LC_GBASE = 480;

__device__ __forceinline__ unsigned pk2bf(float lo, float hi) { return (unsigned)f2bf(lo) | ((unsigned)f2bf(hi) << 16); }
__device__ __forceinline__ void tr_item(const float* __restrict__ W, int K, int ldw, int nsrc, const float* __restrict__ gk, bf16_t* dst, int k0, int n0, int lane) {
    const int n = n0 + lane; const bool ok = n < nsrc;
    const float* src = W + (size_t)k0 * ldw + (ok ? n : 0);
    float v[32];
#pragma unroll
    for (int i = 0; i < 32; ++i) v[i] = src[(size_t)i * ldw];
    if (gk) {
#pragma unroll
        for (int i = 0; i < 32; ++i) v[i] *= gk[k0 + i];
    }
    uint4* o = (uint4*)(dst + (size_t)lane * K + k0);
#pragma unroll
    for (int c = 0; c < 4; ++c) { uint4 w; w.x = pk2bf(v[8 * c], v[8 * c + 1]); w.y = pk2bf(v[8 * c + 2], v[8 * c + 3]); w.z = pk2bf(v[8 * c + 4], v[8 * c + 5]); w.w = pk2bf(v[8 * c + 6], v[8 * c + 7]);
        if (!ok) w = make_uint4(0u, 0u, 0u, 0u); o[c] = w; }
}
__device__ void f_expert_weights(const P& p, int bid, int nb) {
    const int tid = ltid(), wave = tid >> 6, lane = tid & 63;
    bf16_t* W13 = (bf16_t*)(p.ws + OFF_W13_T); bf16_t* WD = (bf16_t*)(p.ws + OFF_WD_T);
    constexpr int I_EXP = 32 * 128;
    for (int it = bid * 8 + wave; it < 3 * I_EXP; it += nb * 8) {
        int r = it;
        if (r < 2 * I_EXP) { const int up = r >= I_EXP; if (up) r -= I_EXP; const int e = r >> 7, q = r & 127, kb = q >> 2, nbk = q & 3, n0 = 64 * nbk;
            const float* src = (up ? p.w_up : p.w_gate) + (size_t)e * D_MODEL * EXP_FF;
            tr_item(src, D_MODEL, EXP_FF, EXP_FF, p.ln_ffn, W13 + ((size_t)e * 512 + 256 * (n0 >> 7) + 128 * up + (n0 & 127)) * D_MODEL, 32 * kb, n0, lane); }
        else { r -= 2 * I_EXP; const int e = r >> 7, q = r & 127, kb = q >> 4, nbk = q & 15, n0 = 64 * nbk;
            tr_item(p.w_down + (size_t)e * EXP_FF * D_MODEL, EXP_FF, D_MODEL, D_MODEL, nullptr, WD + ((size_t)e * D_MODEL + n0) * EXP_FF, 32 * kb, n0, lane); }
    }
}
constexpr int EW_ITEMS = 3 * 32 * 128;
__device__ __forceinline__ void ew_load(const P& p, int it, int lane, float (&v)[32]) {
    constexpr int I_EXP = 32 * 128;
    const float* src; int ldw;
    if (it < 2 * I_EXP) { const int up = it >= I_EXP; const int r = it - up * I_EXP; const int e = r >> 7, q = r & 127, kb = q >> 2, nbk = q & 3;
        src = (up ? p.w_up : p.w_gate) + (size_t)e * D_MODEL * EXP_FF + (size_t)(32 * kb) * EXP_FF + 64 * nbk + lane; ldw = EXP_FF; }
    else { const int r = it - 2 * I_EXP; const int e = r >> 7, q = r & 127, kb = q >> 4, nbk = q & 15;
        src = p.w_down + (size_t)e * EXP_FF * D_MODEL + (size_t)(32 * kb) * D_MODEL + 64 * nbk + lane; ldw = D_MODEL; }
#pragma unroll
    for (int i = 0; i < 32; ++i) v[i] = src[(size_t)i * ldw];
}
__device__ __forceinline__ void ew_store(const P& p, int it, int lane, float (&v)[32]) {
    constexpr int I_EXP = 32 * 128;
    bf16_t* W13 = (bf16_t*)(p.ws + OFF_W13_T); bf16_t* WD = (bf16_t*)(p.ws + OFF_WD_T);
    bf16_t* dst;
    if (it < 2 * I_EXP) { const int up = it >= I_EXP; const int r = it - up * I_EXP; const int e = r >> 7, q = r & 127, kb = q >> 2, nbk = q & 3, n0 = 64 * nbk;
        const float* gk = p.ln_ffn + 32 * kb;
#pragma unroll
        for (int i = 0; i < 32; ++i) v[i] *= gk[i];
        dst = W13 + ((size_t)e * 512 + 256 * (n0 >> 7) + 128 * up + (n0 & 127) + lane) * D_MODEL + 32 * kb; }
    else { const int r = it - 2 * I_EXP; const int e = r >> 7, q = r & 127, kb = q >> 4, nbk = q & 15;
        dst = WD + ((size_t)e * D_MODEL + 64 * nbk + lane) * EXP_FF + 32 * kb; }
    pg8::u32x4* o = (pg8::u32x4*)dst;
#pragma unroll
    for (int c = 0; c < 4; ++c) { pg8::u32x4 w; w.x = pg8::cvt_pk_bf16(v[8 * c], v[8 * c + 1]); w.y = pg8::cvt_pk_bf16(v[8 * c + 2], v[8 * c + 3]); w.z = pg8::cvt_pk_bf16(v[8 * c + 4], v[8 * c + 5]); w.w = pg8::cvt_pk_bf16(v[8 * c + 6], v[8 * c + 7]); o[c] = w; }
}
__device__ void f_prologue(const P& p, int bid, int nb, float* sm) {
    const int tid = ltid(), wave = tid >> 6, lane = tid & 63;
    const int gw = bid * 8 + wave, ngw = nb * 8;
    bf16_t* WIN_T = (bf16_t*)(p.ws + OFF_WIN_T); bf16_t* WOUT_T = (bf16_t*)(p.ws + OFF_WOUT_T);
    constexpr int I_IN = 32 * (LDU / 64), I_OUT = 32 * 16;
    for (int it = gw; it < I_IN + I_OUT; it += ngw) {
        if (it < I_IN) { const int kb = it / (LDU / 64), nbk = it % (LDU / 64); tr_item(p.w_in, D_MODEL, D_IN, D_IN, p.ln_mix, WIN_T + (size_t)(64 * nbk) * D_MODEL, 32 * kb, 64 * nbk, lane); }
        else { const int r = it - I_IN, kb = r >> 4, nbk = r & 15; tr_item(p.w_out, D_MODEL, D_MODEL, D_MODEL, nullptr, WOUT_T + (size_t)(64 * nbk) * D_MODEL, 32 * kb, 64 * nbk, lane); }
    }
    { bf16_t* W1T = (bf16_t*)(p.ws + OFF_W1T); bf16_t* W2T = (bf16_t*)(p.ws + OFF_W2T); float* B1 = (float*)(p.ws + OFF_B1);
      for (int it = gw; it < 2 * 128 + 2 * 4; it += ngw) {
          if (it < 256) { const int kv = it >> 7, q = it & 127, kb = q >> 1, nbk = q & 1; tr_item(kv ? p.cv1 : p.ck1, 2048, 128, 128, nullptr, W1T + ((size_t)kv * 128 + 64 * nbk) * 2048, 32 * kb, 64 * nbk, lane); }
          else { const int r = it - 256, kv = r >> 2, kb = r & 3; tr_item(kv ? p.cv2 : p.ck2, 128, 64, 64, nullptr, W2T + (size_t)kv * 64 * 128, 32 * kb, 0, lane); }
      }
      for (int o = gw; o < 256; o += ngw) { const int kv = o >> 7, n = o & 127; const float* w1 = kv ? p.cv1 : p.ck1; const float* pos = kv ? p.pos_v : p.pos_k;
          float a = 0.f; for (int k = lane; k < 2048; k += 64) a = fmaf(pos[k], w1[(size_t)k * 128 + n], a);
          a = wave_sum(a); if (lane == 0) B1[o] = a; } }
    { bf16_t* RH = (bf16_t*)(p.ws + OFF_RW_HI); bf16_t* RL = (bf16_t*)(p.ws + OFF_RW_LO);
      for (int i = bid * NT + tid; i < 48 * 1024; i += nb * NT) { const int c = i >> 10, k = i & 1023;
          const float w = (c < 4 ? p.wg[k * 4 + c] : (c < 36 ? p.we[k * 32 + (c - 4)] : 0.f)) * p.ln_ffn[k];
          const bf16_t hi = f2bf(w); RH[i] = hi; RL[i] = f2bf(w - bf2f(hi)); } }
    bf16_t* XN = (bf16_t*)(p.ws + OFF_XN);
    for (int row = gw; row < T_TOK; row += ngw) {
        const float4* xr = (const float4*)(p.x + (size_t)row * D_MODEL) + lane;
        float4 v[4]; float s = 0.f;
#pragma unroll
        for (int j = 0; j < 4; ++j) { v[j] = xr[64 * j]; s += (v[j].x * v[j].x + v[j].y * v[j].y) + (v[j].z * v[j].z + v[j].w * v[j].w); }
        const float rs = 1.0f / sqrtf(wave_sum(s) * (1.0f / D_MODEL) + EPS);
        uint2* o8 = (uint2*)(XN + (size_t)row * D_MODEL) + lane;
#pragma unroll
        for (int j = 0; j < 4; ++j) o8[64 * j] = make_uint2(pk2bf(v[j].x * rs, v[j].y * rs), pk2bf(v[j].z * rs, v[j].w * rs));
    }
    float* biasd = (float*)(p.ws + OFF_BIASD);
    for (int i = bid * NT + tid; i < 16 * 2048; i += nb * NT) { const int h = i >> 11, d = i & 2047; biasd[i] = p.rel_bias[t5_bucket(d) * 16 + h]; }
    bf16_t* kc = (bf16_t*)(p.ws + OFF_KCMP); bf16_t* vc = (bf16_t*)(p.ws + OFF_VCMP);
    for (int i = bid * NT + tid; i < 32 * 64; i += nb * NT) { const int bg = i >> 6, d = i & 63; kc[(bg * 128 + 127) * 64 + d] = 0; vc[(bg * 128 + 127) * 64 + d] = 0; }
}

typedef short bf16x8_t __attribute__((ext_vector_type(8)));
typedef float f32x4_t __attribute__((ext_vector_type(4)));
typedef float f32x2_t __attribute__((ext_vector_type(2)));
typedef float f32x16_t __attribute__((ext_vector_type(16)));
typedef short v4i16_t __attribute__((ext_vector_type(4)));
#define MFMA32(a, b, c) __builtin_amdgcn_mfma_f32_32x32x16_bf16(a, b, c, 0, 0, 0)
constexpr int SLOT_V = 8192, SLOT_BYTES = 16384, NSLOT = 3;
constexpr int AL_RING = 0, AL_TAB = NSLOT * SLOT_BYTES, AL_SEL = AL_TAB + 2048, AL_TAB4 = AL_SEL + 512, T4_N = 257, T4_OFF = 64, AL_IMP = AL_TAB4 + 4 * T4_N * 16;
constexpr float LOG2E = 1.4426950408889634f, NEG_BIG = -1.0e30f;
typedef unsigned u32x4_t __attribute__((ext_vector_type(4)));
__device__ __forceinline__ void dma_tile(const bf16_t* k0, const bf16_t* v0, int pitch, LASP unsigned char* slot, int wave, int lane) {
    const bf16_t* ks = k0 + (size_t)lane * pitch + wave * 8;
    const bf16_t* vs = v0 + (size_t)(16 * (wave & 3) + (lane >> 2)) * pitch + (wave >> 2) * 32 + (lane & 3) * 8;
    __builtin_amdgcn_global_load_lds((const unsigned*)ks, (LASP unsigned*)(slot + wave * 1024), 16, 0, 0);
    __builtin_amdgcn_global_load_lds((const unsigned*)vs, (LASP unsigned*)(slot + SLOT_V + wave * 1024), 16, 0, 0);
}
__device__ __forceinline__ void glds16(const void* gsrc, unsigned lds_dst) { unsigned keep;
    asm volatile("s_mov_b32 %0, m0\n\ts_mov_b32 m0, %2\n\ts_nop 0\n\tglobal_load_lds_dwordx4 %1, off\n\ts_mov_b32 m0, %0" : "=&s"(keep) : "v"(gsrc), "s"(lds_dst) : "memory"); }
__device__ __forceinline__ void dma_k(const bf16_t* k0, int pitch, unsigned slot, int wave, int lane) { glds16(k0 + (size_t)lane * pitch + wave * 8, (unsigned)__builtin_amdgcn_readfirstlane(slot + wave * 1024)); }
__device__ __forceinline__ void dma_v(const bf16_t* v0, int pitch, unsigned slot, int wave, int lane) { glds16(v0 + (size_t)(16 * (wave & 3) + (lane >> 2)) * pitch + (wave >> 2) * 32 + (lane & 3) * 8, (unsigned)__builtin_amdgcn_readfirstlane(slot + SLOT_V + wave * 1024)); }
#define DMA_WAIT_BAR(N) asm volatile("s_waitcnt vmcnt(" #N ") lgkmcnt(0)\n\ts_barrier" ::: "memory")
#define KRD(dst, ka, off) asm volatile("ds_read_b128 %0, %1 offset:%2" : "=&v"(dst) : "v"(ka), "i"(off) : "memory")
#define LGKM_WAIT2(n, a, b) asm volatile("s_waitcnt lgkmcnt(" #n ")" : "+v"(a), "+v"(b) :: "memory")
template <int NS, int S0>
__device__ __forceinline__ void qk_tile(f32x16_t& p0, f32x16_t& p1, float init, const LASP unsigned char* kt, const bf16x8_t* q, int r32, int h) {
    const unsigned ka = (unsigned)(uintptr_t)kt + (unsigned)(h * 1024 + r32 * 16 + S0 * 2048);
    bf16x8_t a0[NS], a1[NS];
    KRD(a0[0], ka, 0); KRD(a1[0], ka, 512); KRD(a0[1], ka, 2048); KRD(a1[1], ka, 2560);
    if constexpr (NS == 4) { KRD(a0[2], ka, 4096); KRD(a1[2], ka, 4608); KRD(a0[3], ka, 6144); KRD(a1[3], ka, 6656); }
    { const f32x16_t iv = {init, init, init, init, init, init, init, init, init, init, init, init, init, init, init, init}; p0 = iv; p1 = iv; }
    if constexpr (NS == 4) {
        LGKM_WAIT2(6, a0[0], a1[0]); p0 = MFMA32(a0[0], q[0], p0); p1 = MFMA32(a1[0], q[0], p1);
        LGKM_WAIT2(4, a0[1], a1[1]); p0 = MFMA32(a0[1], q[1], p0); p1 = MFMA32(a1[1], q[1], p1);
        LGKM_WAIT2(2, a0[2], a1[2]); p0 = MFMA32(a0[2], q[2], p0); p1 = MFMA32(a1[2], q[2], p1);
        LGKM_WAIT2(0, a0[3], a1[3]); p0 = MFMA32(a0[3], q[3], p0); p1 = MFMA32(a1[3], q[3], p1);
    } else {
        LGKM_WAIT2(2, a0[0], a1[0]); p0 = MFMA32(a0[0], q[0], p0); p1 = MFMA32(a1[0], q[0], p1);
        LGKM_WAIT2(0, a0[1], a1[1]); p0 = MFMA32(a0[1], q[1], p0); p1 = MFMA32(a1[1], q[1], p1);
    }
}
__device__ __forceinline__ void xf_gen(f32x16_t& p0, f32x16_t& p1, int dqh, unsigned wlim, const LASP float* tab) {
#pragma unroll
    for (int g4 = 0; g4 < 4; ++g4) {
        float b0[4], b1[4];
#pragma unroll
        for (int i = 0; i < 4; ++i) { const int kk = i + 8 * g4; const unsigned d0 = (unsigned)(dqh - kk), d1 = (unsigned)(dqh - kk - 32); b0[i] = tab[d0 < 127u ? d0 : 127u]; b1[i] = tab[d1 < 127u ? d1 : 127u]; }
#pragma unroll
        for (int i = 0; i < 4; ++i) { const int r = 4 * g4 + i, kk = i + 8 * g4; const unsigned d0 = (unsigned)(dqh - kk), d1 = (unsigned)(dqh - kk - 32);
            const float s0 = p0[r] + b0[i], s1 = p1[r] + b1[i]; p0[r] = d0 < wlim ? s0 : NEG_BIG; p1[r] = d1 < wlim ? s1 : NEG_BIG; }
        __builtin_amdgcn_sched_barrier(0);
    }
}
template <bool MASK>
__device__ __forceinline__ void xf4(f32x16_t& p0, f32x16_t& p1, int dqh, unsigned wlim, const LASP f32x4_t* tab4) {
    const LASP f32x4_t* tq = tab4 + ((dqh < -8 ? -8 : (dqh > 192 ? 192 : dqh)) + T4_OFF - 56);
#pragma unroll
    for (int G = 0; G < 4; ++G) {
        const int D0 = dqh - 8 * G, D1 = D0 - 32;
        const f32x4_t e0 = tq[56 - 8 * G], e1 = tq[24 - 8 * G];
        if (MASK) { _Pragma("unroll") for (int i = 0; i < 4; ++i) { const int r = 4 * G + i; const float s0 = p0[r] + e0[i], s1 = p1[r] + e1[i];
            p0[r] = (unsigned)(D0 - i) < wlim ? s0 : NEG_BIG; p1[r] = (unsigned)(D1 - i) < wlim ? s1 : NEG_BIG; } }
        else { const f32x4_t u0 = (f32x4_t){p0[4 * G], p0[4 * G + 1], p0[4 * G + 2], p0[4 * G + 3]} + e0, u1 = (f32x4_t){p1[4 * G], p1[4 * G + 1], p1[4 * G + 2], p1[4 * G + 3]} + e1;
            _Pragma("unroll") for (int i = 0; i < 4; ++i) { p0[4 * G + i] = u0[i]; p1[4 * G + i] = u1[i]; } }
        if (G & 1) __builtin_amdgcn_sched_barrier(0);
    }
}
__device__ __forceinline__ void xf4b(f32x16_t& p0, f32x16_t& p1, int dqh, const LASP f32x4_t* tab4) {
    const LASP f32x4_t* tq = tab4 + ((dqh < -8 ? -8 : (dqh > 192 ? 192 : dqh)) + T4_OFF - 56);
#pragma unroll
    for (int G = 0; G < 4; ++G) {
        const int D0 = dqh - 8 * G, D1 = D0 - 32;
        const f32x4_t e0 = tq[56 - 8 * G], e1 = tq[24 - 8 * G];
        const f32x4_t u0 = (f32x4_t){p0[4 * G], p0[4 * G + 1], p0[4 * G + 2], p0[4 * G + 3]} + e0, u1 = (f32x4_t){p1[4 * G], p1[4 * G + 1], p1[4 * G + 2], p1[4 * G + 3]} + e1;
#pragma unroll
        for (int i = 0; i < 4; ++i) { p0[4 * G + i] = u0[i]; p1[4 * G + i] = u1[i]; }
    }
}
template <bool MASK>
__device__ __forceinline__ void xf4_2(f32x16_t& a0, f32x16_t& a1, f32x16_t& b0, f32x16_t& b1, int dqh, const LASP f32x4_t* tab4) {
    const LASP f32x4_t* tq = tab4 + ((dqh < -8 ? -8 : (dqh > 192 ? 192 : dqh)) + T4_OFF - 56);
#pragma unroll
    for (int G = 0; G < 4; ++G) {
        const int D0 = dqh - 8 * G, D1 = D0 - 32;
        const f32x4_t e0 = tq[56 - 8 * G], e1 = tq[24 - 8 * G];
        if (MASK) { _Pragma("unroll") for (int i = 0; i < 4; ++i) { const int r = 4 * G + i; const bool v0 = (D0 - i) >= 0, v1 = (D1 - i) >= 0;
            const float sa0 = a0[r] + e0[i], sa1 = a1[r] + e1[i], sb0 = b0[r] + e0[i], sb1 = b1[r] + e1[i];
            a0[r] = v0 ? sa0 : NEG_BIG; a1[r] = v1 ? sa1 : NEG_BIG; b0[r] = v0 ? sb0 : NEG_BIG; b1[r] = v1 ? sb1 : NEG_BIG; } }
        else { const f32x4_t ua0 = (f32x4_t){a0[4 * G], a0[4 * G + 1], a0[4 * G + 2], a0[4 * G + 3]} + e0, ua1 = (f32x4_t){a1[4 * G], a1[4 * G + 1], a1[4 * G + 2], a1[4 * G + 3]} + e1;
            const f32x4_t ub0 = (f32x4_t){b0[4 * G], b0[4 * G + 1], b0[4 * G + 2], b0[4 * G + 3]} + e0, ub1 = (f32x4_t){b1[4 * G], b1[4 * G + 1], b1[4 * G + 2], b1[4 * G + 3]} + e1;
            _Pragma("unroll") for (int i = 0; i < 4; ++i) { a0[4 * G + i] = ua0[i]; a1[4 * G + i] = ua1[i]; b0[4 * G + i] = ub0[i]; b1[4 * G + i] = ub1[i]; } }
        if (G & 1) __builtin_amdgcn_sched_barrier(0);
    }
}
__device__ __forceinline__ void t16_fill(LASP f32x4_t* t16, const LASP float* tab, int idx) {
    const int D = idx - 1; f32x4_t e;
#pragma unroll
    for (int i = 0; i < 4; ++i) { const int d = D - 16 * i; e[i] = d < 0 ? NEG_BIG : tab[d > 127 ? 127 : d]; }
    t16[idx] = e;
}
__device__ __forceinline__ void t4_fill(LASP f32x4_t* t4, const LASP float* tab, int idx) {
    const int D = idx - T4_OFF; f32x4_t e;
#pragma unroll
    for (int i = 0; i < 4; ++i) { const int d = D - i; e[i] = d < 0 ? NEG_BIG : tab[d > 127 ? 127 : d]; }
    t4[idx] = e;
}
__device__ __forceinline__ float max16(const f32x16_t& a) {
    float m0 = fmaxf(fmaxf(a[0], a[1]), a[2]), m1 = fmaxf(fmaxf(a[3], a[4]), a[5]), m2 = fmaxf(fmaxf(a[6], a[7]), a[8]), m3 = fmaxf(fmaxf(a[9], a[10]), a[11]);
    m0 = fmaxf(fmaxf(m0, a[12]), a[13]); m1 = fmaxf(fmaxf(m1, a[14]), a[15]);
    return fmaxf(fmaxf(m0, m1), fmaxf(m2, m3));
}
__device__ __forceinline__ float sum16(const f32x16_t& a) { return ((a[0] + a[1]) + (a[2] + a[3])) + ((a[4] + a[5]) + (a[6] + a[7])) + (((a[8] + a[9]) + (a[10] + a[11])) + ((a[12] + a[13]) + (a[14] + a[15]))); }
__device__ __forceinline__ bf16x8_t pack8(const f32x16_t& a, int b) {
    u32x4_t w; w[0] = pg8::cvt_pk_bf16(a[b], a[b + 1]); w[1] = pg8::cvt_pk_bf16(a[b + 2], a[b + 3]); w[2] = pg8::cvt_pk_bf16(a[b + 4], a[b + 5]); w[3] = pg8::cvt_pk_bf16(a[b + 6], a[b + 7]);
    return __builtin_bit_cast(bf16x8_t, w);
}
constexpr float SM_THR = 8.0f;
struct AttnSt { float m, l; f32x16_t o[2]; };
__device__ __forceinline__ void st_init(AttnSt& s, float m0) { s.m = m0 + SM_THR; s.l = 0.f;     const f32x16_t z = {0.f, 0.f, 0.f, 0.f, 0.f, 0.f, 0.f, 0.f, 0.f, 0.f, 0.f, 0.f, 0.f, 0.f, 0.f, 0.f}; s.o[0] = z; s.o[1] = z; }
#define TRRD(dst, va, off) asm volatile("ds_read_b64_tr_b16 %0, %1 offset:%2" : "=&v"(dst) : "v"(va), "i"(off) : "memory")
#define LGKM_WAIT4(n, a, b, c, d, e, f, g, hh) asm volatile("s_waitcnt lgkmcnt(" #n ")" : "+v"(a), "+v"(b), "+v"(c), "+v"(d), "+v"(e), "+v"(f), "+v"(g), "+v"(hh) :: "memory")
#define VFRAG(l, hgh) ((bf16x8_t){l[0], l[1], l[2], l[3], hgh[0], hgh[1], hgh[2], hgh[3]})
__device__ __forceinline__ void pv_tile(f32x16_t (&o)[2], const LASP unsigned char* vb, const bf16x8_t (&pf)[4]) {
    const unsigned va = (unsigned)(uintptr_t)vb;
    v4i16_t l0[4], h0[4], l1[4], h1[4];
    TRRD(l0[0], va, 0); TRRD(h0[0], va, 512); TRRD(l1[0], va, 4096); TRRD(h1[0], va, 4608); TRRD(l0[1], va, 1024); TRRD(h0[1], va, 1536); TRRD(l1[1], va, 5120); TRRD(h1[1], va, 5632);
    TRRD(l0[2], va, 2048); TRRD(h0[2], va, 2560); TRRD(l1[2], va, 6144); TRRD(h1[2], va, 6656); TRRD(l0[3], va, 3072); TRRD(h0[3], va, 3584); TRRD(l1[3], va, 7168); TRRD(h1[3], va, 7680);
    LGKM_WAIT4(8, l0[0], h0[0], l1[0], h1[0], l0[1], h0[1], l1[1], h1[1]);
    o[0] = MFMA32(VFRAG(l0[0], h0[0]), pf[0], o[0]); o[1] = MFMA32(VFRAG(l1[0], h1[0]), pf[0], o[1]);
    o[0] = MFMA32(VFRAG(l0[1], h0[1]), pf[1], o[0]); o[1] = MFMA32(VFRAG(l1[1], h1[1]), pf[1], o[1]);
    LGKM_WAIT4(0, l0[2], h0[2], l1[2], h1[2], l0[3], h0[3], l1[3], h1[3]);
    o[0] = MFMA32(VFRAG(l0[2], h0[2]), pf[2], o[0]); o[1] = MFMA32(VFRAG(l1[2], h1[2]), pf[2], o[1]);
    o[0] = MFMA32(VFRAG(l0[3], h0[3]), pf[3], o[0]); o[1] = MFMA32(VFRAG(l1[3], h1[3]), pf[3], o[1]);
}
struct VFr1 { v4i16_t l0[4], h0[4], l1[4], h1[4]; };
__device__ __forceinline__ void pv_read1(VFr1& f, const LASP unsigned char* vb) {
    const unsigned va = (unsigned)(uintptr_t)vb;
    TRRD(f.l0[0], va, 0); TRRD(f.h0[0], va, 512); TRRD(f.l1[0], va, 4096); TRRD(f.h1[0], va, 4608); TRRD(f.l0[1], va, 1024); TRRD(f.h0[1], va, 1536); TRRD(f.l1[1], va, 5120); TRRD(f.h1[1], va, 5632);
    TRRD(f.l0[2], va, 2048); TRRD(f.h0[2], va, 2560); TRRD(f.l1[2], va, 6144); TRRD(f.h1[2], va, 6656); TRRD(f.l0[3], va, 3072); TRRD(f.h0[3], va, 3584); TRRD(f.l1[3], va, 7168); TRRD(f.h1[3], va, 7680);
}
__device__ __forceinline__ void pv_mma1(f32x16_t (&o)[2], VFr1& f, const bf16x8_t (&pf)[4]) {
    LGKM_WAIT4(8, f.l0[0], f.h0[0], f.l1[0], f.h1[0], f.l0[1], f.h0[1], f.l1[1], f.h1[1]);
    o[0] = MFMA32(VFRAG(f.l0[0], f.h0[0]), pf[0], o[0]); o[1] = MFMA32(VFRAG(f.l1[0], f.h1[0]), pf[0], o[1]);
    o[0] = MFMA32(VFRAG(f.l0[1], f.h0[1]), pf[1], o[0]); o[1] = MFMA32(VFRAG(f.l1[1], f.h1[1]), pf[1], o[1]);
    LGKM_WAIT4(0, f.l0[2], f.h0[2], f.l1[2], f.h1[2], f.l0[3], f.h0[3], f.l1[3], f.h1[3]);
    o[0] = MFMA32(VFRAG(f.l0[2], f.h0[2]), pf[2], o[0]); o[1] = MFMA32(VFRAG(f.l1[2], f.h1[2]), pf[2], o[1]);
    o[0] = MFMA32(VFRAG(f.l0[3], f.h0[3]), pf[3], o[0]); o[1] = MFMA32(VFRAG(f.l1[3], f.h1[3]), pf[3], o[1]);
}
__device__ __forceinline__ void pv_tile2(f32x16_t (&oa)[2], f32x16_t (&ob)[2], const LASP unsigned char* vb, const bf16x8_t (&pfa)[4], const bf16x8_t (&pfb)[4]) {
    const unsigned va = (unsigned)(uintptr_t)vb;
    v4i16_t l0[4], h0[4], l1[4], h1[4];
    TRRD(l0[0], va, 0); TRRD(h0[0], va, 512); TRRD(l0[1], va, 1024); TRRD(h0[1], va, 1536); TRRD(l0[2], va, 2048); TRRD(h0[2], va, 2560); TRRD(l0[3], va, 3072); TRRD(h0[3], va, 3584);
    TRRD(l1[0], va, 4096); TRRD(h1[0], va, 4608); TRRD(l1[1], va, 5120); TRRD(h1[1], va, 5632); TRRD(l1[2], va, 6144); TRRD(h1[2], va, 6656); TRRD(l1[3], va, 7168); TRRD(h1[3], va, 7680);
    LGKM_WAIT4(8, l0[0], h0[0], l0[1], h0[1], l0[2], h0[2], l0[3], h0[3]);
#pragma unroll
    for (int ks = 0; ks < 4; ++ks) { const bf16x8_t a = VFRAG(l0[ks], h0[ks]); oa[0] = MFMA32(a, pfa[ks], oa[0]); ob[0] = MFMA32(a, pfb[ks], ob[0]); }
    LGKM_WAIT4(0, l1[0], h1[0], l1[1], h1[1], l1[2], h1[2], l1[3], h1[3]);
#pragma unroll
    for (int ks = 0; ks < 4; ++ks) { const bf16x8_t a = VFRAG(l1[ks], h1[ks]); oa[1] = MFMA32(a, pfa[ks], oa[1]); ob[1] = MFMA32(a, pfb[ks], ob[1]); }
}
template <bool MASKQ>
__device__ __forceinline__ void sm_pv(AttnSt& st, f32x16_t& p0, f32x16_t& p1, const LASP unsigned char* vb, bool sel) {
    float mx = pl32_max(fmaxf(max16(p0), max16(p1)));
    if (MASKQ) mx = sel ? mx : NEG_BIG;
    if (__any(mx > SM_THR)) {
        const float d = mx > SM_THR ? mx : 0.f, f = __builtin_amdgcn_exp2f(-d);
        st.m += d; st.l *= f;
#pragma unroll
        for (int r = 0; r < 16; ++r) { st.o[0][r] *= f; st.o[1][r] *= f; p0[r] -= d; p1[r] -= d; }
    }
#pragma unroll
    for (int r = 0; r < 16; ++r) { p0[r] = __builtin_amdgcn_exp2f(p0[r]); p1[r] = __builtin_amdgcn_exp2f(p1[r]); }
    float rs = sum16(p0) + sum16(p1);
    if (MASKQ) rs = sel ? rs : 0.f;
    st.l += rs;
    bf16x8_t pf[4]; pf[0] = pack8(p0, 0); pf[1] = pack8(p0, 8); pf[2] = pack8(p1, 0); pf[3] = pack8(p1, 8);
    if (MASKQ) {
#pragma unroll
        for (int k = 0; k < 4; ++k) { u32x4_t w = __builtin_bit_cast(u32x4_t, pf[k]); w[0] = sel ? w[0] : 0u; w[1] = sel ? w[1] : 0u; w[2] = sel ? w[2] : 0u; w[3] = sel ? w[3] : 0u; pf[k] = __builtin_bit_cast(bf16x8_t, w); }
    }
    pv_tile(st.o, vb, pf);
}
__device__ __forceinline__ void sm_only(AttnSt& st, f32x16_t& p0, f32x16_t& p1, bf16x8_t (&pf)[4]) {
    const float mx = pl32_max(fmaxf(max16(p0), max16(p1)));
    if (__any(mx > SM_THR)) {
        const float d = mx > SM_THR ? mx : 0.f, f = __builtin_amdgcn_exp2f(-d);
        st.m += d; st.l *= f;
#pragma unroll
        for (int r = 0; r < 16; ++r) { st.o[0][r] *= f; st.o[1][r] *= f; p0[r] -= d; p1[r] -= d; }
    }
#pragma unroll
    for (int r = 0; r < 16; ++r) { p0[r] = __builtin_amdgcn_exp2f(p0[r]); p1[r] = __builtin_amdgcn_exp2f(p1[r]); }
    st.l += sum16(p0) + sum16(p1);
    pf[0] = pack8(p0, 0); pf[1] = pack8(p0, 8); pf[2] = pack8(p1, 0); pf[3] = pack8(p1, 8);
}
__device__ __forceinline__ bf16x8_t q_scaled(const bf16_t* qp, float c) {
    const u32x4_t v = *(const u32x4_t*)qp; u32x4_t w;
#pragma unroll
    for (int i = 0; i < 4; ++i) w[i] = pg8::cvt_pk_bf16(__uint_as_float(v[i] << 16) * c, __uint_as_float(v[i] & 0xffff0000u) * c);
    return __builtin_bit_cast(bf16x8_t, w);
}

template <int NS>
__device__ __forceinline__ float self_score(const bf16x8_t* q, const bf16_t* krow, int h) {
    float s = 0.f;
#pragma unroll
    for (int i = 0; i < NS; ++i) { const u32x4_t kv = *(const u32x4_t*)(krow + 16 * i + 8 * h); const u32x4_t qv = __builtin_bit_cast(u32x4_t, q[i]);
#pragma unroll
        for (int e = 0; e < 4; ++e) { s = fmaf(__uint_as_float(qv[e] << 16), __uint_as_float(kv[e] << 16), s); s = fmaf(__uint_as_float(qv[e] & 0xffff0000u), __uint_as_float(kv[e] & 0xffff0000u), s); } }
    return pl32_sum(s);
}

__device__ void f_cmp(const P& p, int bid, int nb, LASP unsigned char* lds) {
    const int tid = ltid(), wave = __builtin_amdgcn_readfirstlane(tid >> 6), lane = tid & 63, r32 = lane & 31, h = lane >> 5;
    const bf16_t* U = (const bf16_t*)(p.ws + OFF_U);
    constexpr int HSTR = 136;
    LASP float* red = (LASP float*)lds + (wave & 3) * 1024;
    LASP bf16_t* hid = (LASP bf16_t*)(lds + 16384);
    for (int unit = bid; unit < 256; unit += nb) {
        const int pr = unit >> 2, ct = unit & 3, kv = pr & 1, bg = pr >> 1, b = bg >> 1, g = bg & 1;
        const int col0 = (kv ? C_VC : C_KC) + g * 64;
        const bf16_t* W1T = (const bf16_t*)(p.ws + OFF_W1T) + (size_t)kv * 128 * 2048; const bf16_t* W2T = (const bf16_t*)(p.ws + OFF_W2T) + (size_t)kv * 64 * 128;
        const float* B1 = (const float*)(p.ws + OFF_B1) + kv * 128;
        const int nblk = wave & 3, khalf = wave >> 2;
        const int tokb = 16 * (ct * 32 + r32);
        const bf16_t* Ub = U + (size_t)b * SEQ * LDU + col0 + 8 * h;
        const bf16_t* wp = W1T + (size_t)(nblk * 32 + r32) * 2048 + 8 * h;
        f32x16_t acc = {0.f, 0.f, 0.f, 0.f, 0.f, 0.f, 0.f, 0.f, 0.f, 0.f, 0.f, 0.f, 0.f, 0.f, 0.f, 0.f};
#pragma unroll 8
        for (int s = khalf * 64; s < khalf * 64 + 64; ++s) {
            int tok = tokb + (s >> 2); tok = tok < SEQ ? tok : SEQ - 1;
            const bf16x8_t a = *(const bf16x8_t*)(Ub + (size_t)tok * LDU + (s & 3) * 16);
            const bf16x8_t bb = *(const bf16x8_t*)(wp + 16 * s);
            acc = MFMA32(a, bb, acc);
        }
        if (khalf == 1) {
#pragma unroll
            for (int r = 0; r < 16; ++r) red[r * 64 + lane] = acc[r];
        }
        __syncthreads();
        if (khalf == 0) { const int n = nblk * 32 + r32; const float b1 = B1[n];
#pragma unroll
            for (int r = 0; r < 16; ++r) { const float v = acc[r] + red[r * 64 + lane] + b1; const float u = 0.7978845608028654f * (v + 0.044715f * v * v * v);
                const float th = 1.0f - 2.0f / (__expf(2.0f * u) + 1.0f);
                hid[((r & 3) + 8 * (r >> 2) + 4 * h) * HSTR + n] = f2bf(0.5f * v * (1.0f + th)); } }
        __syncthreads();
        if (wave < 2) {
            f32x16_t a2 = {0.f, 0.f, 0.f, 0.f, 0.f, 0.f, 0.f, 0.f, 0.f, 0.f, 0.f, 0.f, 0.f, 0.f, 0.f, 0.f};
#pragma unroll
            for (int s = 0; s < 8; ++s) { const bf16x8_t a = *(const LASP bf16x8_t*)(hid + r32 * HSTR + 16 * s + 8 * h); const bf16x8_t bb = *(const bf16x8_t*)(W2T + (size_t)(wave * 32 + r32) * 128 + 16 * s + 8 * h);
                a2 = MFMA32(a, bb, a2); }
            bf16_t* dst = (bf16_t*)(p.ws + (kv ? OFF_VCMP : OFF_KCMP)) + (size_t)bg * 128 * 64 + wave * 32 + r32;
#pragma unroll
            for (int r = 0; r < 16; ++r) { const int row = ct * 32 + (r & 3) + 8 * (r >> 2) + 4 * h; dst[row * 64] = row < N_CMP ? f2bf(a2[r]) : (bf16_t)0; }
        }
        __syncthreads();
    }
}

template <int DRY> __device__ void nsa_unit(const P& p, int b, int g, int cur, LASP unsigned char* lds, int ew_it, bool fresh) {
    const int tid = ltid(), wave = __builtin_amdgcn_readfirstlane(tid >> 6), lane = tid & 63, r32 = lane & 31, h = lane >> 5;
    const int rh = wave >> 1, th = wave & 1, hq = g * 4 + rh, bg = b * 2 + g;
    const int t0 = cur * 64, tl = th * 32 + r32, t = t0 + tl;
    const bf16_t* U = (const bf16_t*)(p.ws + OFF_U);
    const bf16_t* Ub = U + (size_t)b * SEQ * LDU;
    LASP unsigned char* ring = lds + AL_RING;
    LASP float* tabw = (LASP float*)(lds + AL_TAB) + rh * 128;
    const LASP f32x4_t* tab4 = (const LASP f32x4_t*)(lds + AL_TAB4) + rh * T4_N;
    LASP unsigned* selm = (LASP unsigned*)(lds + AL_SEL);
    LASP float* impsh = (LASP float*)(lds + AL_IMP);
    const int vlane = SLOT_V + ((lane >> 4) & 1) * 32 + (lane & 3) * 8 + (4 * h + ((lane & 15) >> 2)) * 64;
    const float c = 0.125f * LOG2E;
    { if (fresh) { const float* biasd = (const float*)(p.ws + OFF_BIASD) + (g * 4 + (tid >> 7)) * 2048; ((LASP float*)(lds + AL_TAB))[tid] = (biasd[tid & 127] - biasd[127]) * LOG2E; } if (tid == 0) selm[64] = 0u; }
    bf16x8_t q[4];
    { const bf16_t* qp = Ub + (size_t)t * LDU + C_QA + hq * 64 + 8 * h;
#pragma unroll
      for (int s = 0; s < 4; ++s) q[s] = q_scaled(qp + 16 * s, c); }
    const float ref_s = self_score<4>(q, Ub + (size_t)t * LDU + C_KS + g * 64, h), ref_w = self_score<4>(q, Ub + (size_t)t * LDU + C_KW + g * 64, h);
#define NSA_GATE(i) (1.0f / (1.0f + __expf(-bf2f(Ub[(size_t)t * LDU + C_GATE + hq * 3 + (i)]))))
    f32x16_t oacc[2];
    {
        const bf16_t* kc = (const bf16_t*)(p.ws + OFF_KCMP) + (size_t)bg * 128 * 64; const bf16_t* vc = (const bf16_t*)(p.ws + OFF_VCMP) + (size_t)bg * 128 * 64;
        dma_tile(kc, vc, 64, ring, wave, lane); dma_tile(kc + 64 * 64, vc + 64 * 64, 64, ring + SLOT_BYTES, wave, lane);
        dma_tile(Ub + C_KS + g * 64, Ub + C_VS + g * 64, LDU, ring + 2 * SLOT_BYTES, wave, lane);
        DMA_WAIT_BAR(2);
        if (fresh) { for (int i_ = tid; i_ < 4 * T16_N; i_ += NT) t16_fill((LASP f32x4_t*)(lds + AL_T16) + (i_ / T16_N) * T16_N, (const LASP float*)(lds + AL_TAB) + (i_ / T16_N) * 128, i_ % T16_N);
            asm volatile("s_waitcnt lgkmcnt(0)\n\ts_barrier" ::: "memory"); }
        if (fresh) for (int i_ = tid; i_ < 4 * T4_N; i_ += NT) t4_fill((LASP f32x4_t*)(lds + AL_TAB4) + (i_ / T4_N) * T4_N, (const LASP float*)(lds + AL_TAB) + (i_ / T4_N) * 128, i_ % T4_N);
        f32x16_t x0, x1, x2, x3;
        qk_tile<4, 0>(x0, x1, 0.f, ring, q, r32, h); qk_tile<4, 0>(x2, x3, 0.f, ring + SLOT_BYTES, q, r32, h);
        const float* dummy = nullptr; (void)dummy;
        const int dq = t - 31 - 64 * h;
#define CMP_XF(X, OFF) do { _Pragma("unroll") for (int G = 0; G < 4; ++G) { int i_ = dq - (OFF) - 128 * G + 1; i_ = i_ < 0 ? 0 : (i_ > T16_N - 1 ? T16_N - 1 : i_); const f32x4_t e_ = t16[i_]; \
            const f32x4_t u_ = (f32x4_t){X[4 * G], X[4 * G + 1], X[4 * G + 2], X[4 * G + 3]} + e_; X[4 * G] = u_[0]; X[4 * G + 1] = u_[1]; X[4 * G + 2] = u_[2]; X[4 * G + 3] = u_[3]; } } while (0)
        const LASP f32x4_t* t16 = (const LASP f32x4_t*)(lds + AL_T16) + rh * T16_N;
        CMP_XF(x0, 0); CMP_XF(x1, 512); CMP_XF(x2, 1024); CMP_XF(x3, 1536);
#undef CMP_XF
        float mx = fmaxf(fmaxf(max16(x0), max16(x1)), fmaxf(max16(x2), max16(x3)));
        mx = pl32_max(mx);
#pragma unroll
        for (int r = 0; r < 16; ++r) { x0[r] = __builtin_amdgcn_exp2f(x0[r] - mx); x1[r] = __builtin_amdgcn_exp2f(x1[r] - mx); x2[r] = __builtin_amdgcn_exp2f(x2[r] - mx); x3[r] = __builtin_amdgcn_exp2f(x3[r] - mx); }
        float l = (sum16(x0) + sum16(x1)) + (sum16(x2) + sum16(x3));
        l = pl32_sum(l);
        const float inv = (t >= 31) ? 1.0f / l : 0.f;
#pragma unroll
        for (int r = 0; r < 16; ++r) { x0[r] *= inv; x1[r] *= inv; x2[r] *= inv; x3[r] *= inv; }
        {
            LASP float* dst = impsh + tl * 129 + rh * 32 + h;
            float carry = 0.f;
#define IMP_TILE(X, T) do { _Pragma("unroll") for (int G = 0; G < 4; ++G) { const float s4 = (X[4 * G] + X[4 * G + 1]) + (X[4 * G + 2] + X[4 * G + 3]); \
                const float lp = pl32_other(X[4 * G + 3]); dst[2 * (4 * T + G)] = s4 + (h ? lp : carry); carry = lp; } } while (0)
            IMP_TILE(x0, 0); IMP_TILE(x1, 1); IMP_TILE(x2, 2); IMP_TILE(x3, 3);
#undef IMP_TILE
        }
        { const f32x16_t z = {0.f, 0.f, 0.f, 0.f, 0.f, 0.f, 0.f, 0.f, 0.f, 0.f, 0.f, 0.f, 0.f, 0.f, 0.f, 0.f}; oacc[0] = z; oacc[1] = z; }
        { bf16x8_t pf[4]; pf[0] = pack8(x0, 0); pf[1] = pack8(x0, 8); pf[2] = pack8(x1, 0); pf[3] = pack8(x1, 8); pv_tile(oacc, ring + vlane, pf);
          pf[0] = pack8(x2, 0); pf[1] = pack8(x2, 8); pf[2] = pack8(x3, 0); pf[3] = pack8(x3, 8); pv_tile(oacc, ring + SLOT_BYTES + vlane, pf); }
#pragma unroll
        for (int r = 0; r < 16; ++r) { const float g0_ = NSA_GATE(0); oacc[0][r] *= g0_; oacc[1][r] *= g0_; }
        float ewv[32];
        const bool ew_on = (unsigned)ew_it < (unsigned)EW_ITEMS;
        if (ew_on) ew_load(p, ew_it, lane, ewv);
        __syncthreads();
        {
            const int tk = tid >> 3, i8 = tid & 7;
            const LASP float* row = impsh + tk * 129 + 4 * i8;
            float v[4];
#pragma unroll
            for (int k = 0; k < 4; ++k) v[k] = ((row[k] + row[32 + k]) + row[64 + k]) + row[96 + k];
            const unsigned F = 1u | (1u << cur) | (cur >= 1 ? (1u << (cur - 1)) : 0u);
            const unsigned allv = (cur >= 31) ? 0xffffffffu : ((1u << (cur + 1)) - 1u);
            unsigned cand = allv & ~F; const int nfree = SEL_TOPN - __popc(F);
            unsigned sel = F;
            if (__popc(cand) <= nfree) sel |= cand;
            else {
#pragma unroll 1
                for (int it = 0; it < nfree; ++it) {
                    float best = -1.0f; int bj = 64;
#pragma unroll
                    for (int k = 0; k < 4; ++k) { const int j = 4 * i8 + k; const bool ok = ((cand >> j) & 1u) && v[k] > best; best = ok ? v[k] : best; bj = ok ? j : bj; }
#pragma unroll
                    for (int st_ = 0; st_ < 3; ++st_) {
                        const int ctrl = st_ == 0 ? 0xB1 : (st_ == 1 ? 0x4E : 0x141);
                        float ob; int oj;
                        if (st_ == 0) { ob = DPP_F(best, 0xB1); oj = __builtin_amdgcn_update_dpp(0, bj, 0xB1, 0xf, 0xf, true); }
                        else if (st_ == 1) { ob = DPP_F(best, 0x4E); oj = __builtin_amdgcn_update_dpp(0, bj, 0x4E, 0xf, 0xf, true); }
                        else { ob = DPP_F(best, 0x141); oj = __builtin_amdgcn_update_dpp(0, bj, 0x141, 0xf, 0xf, true); }
                        (void)ctrl;
                        const bool take = (ob > best) || (ob == best && oj < bj);
                        best = take ? ob : best; bj = take ? oj : bj;
                    }
                    sel |= 1u << bj; cand &= ~(1u << bj);
                }
            }
            if (i8 == 0) { selm[tk] = sel; atomicOr((unsigned*)&selm[64], sel); }
        }
        if (ew_on) ew_store(p, ew_it, lane, ewv);
        __syncthreads();
    }
    if (DRY == 1) { asm volatile("" :: "v"(oacc[0][0]), "v"(oacc[1][0])); return; }
    const unsigned mysel = selm[tl];
    const unsigned anysel = selm[64] & ((cur >= 31) ? 0xffffffffu : ((1u << (cur + 1)) - 1u));
    {
        LASP float* oal = (LASP float*)(lds + AL_IMP) + wave * 2048 + lane;
#pragma unroll
        for (int r = 0; r < 16; ++r) { oal[r * 64] = oacc[0][r]; oal[(16 + r) * 64] = oacc[1][r]; }
        const int wlo = cur >= 8 ? cur - 8 : 0;
#define NSA_NEXT(code) (((code) < 64) ? ((anysel & ~((2u << (code)) - 1u)) ? (__ffs((int)(anysel & ~((2u << (code)) - 1u))) - 1) : 64 + wlo) : ((((code) & 63) < cur) ? (code) + 1 : 128))
#define NSA_KSRC(code) (Ub + (size_t)(DRY == 2 ? 0 : ((code) & 63)) * 64 * LDU + (((code) < 64) ? C_KS : C_KW) + g * 64)
        const unsigned ringa = (unsigned)(uintptr_t)ring;
        const LASP unsigned char* kfl = ring + h * 1024 + r32 * 16;
        const LASP unsigned char* vfl = ring + vlane;
#define SBAR() __builtin_amdgcn_sched_barrier(0)
#define PIN(x) asm volatile("" : "+v"(x))
#define KLD(i, kb) kf[i] = *(const LASP bf16x8_t*)((kb) + ((i) >> 1) * 2048 + ((i) & 1) * 512)
#define VRD(i, ks, db) do { vl[i] = __builtin_amdgcn_ds_read_tr16_b64_v4i16((LASP v4i16_t*)(vbp + (db) * 4096 + (ks) * 1024)); vh[i] = __builtin_amdgcn_ds_read_tr16_b64_v4i16((LASP v4i16_t*)(vbp + (db) * 4096 + (ks) * 1024 + 512)); } while (0)
#define VFR(i) ((bf16x8_t){vl[i][0], vl[i][1], vl[i][2], vl[i][3], vh[i][0], vh[i][1], vh[i][2], vh[i][3]})
#define PKW(P, b) pg8::cvt_pk_bf16(P[b], P[(b) + 1])
#define PWF(k) __builtin_bit_cast(bf16x8_t, pw##k)
#define EX(v) __builtin_amdgcn_exp2f(v)
#define MX3(a, b, c) __builtin_fmaxf(__builtin_fmaxf((a), (b)), (c))
#define END_WAIT3() do { if (c3 < 128) { asm volatile("s_waitcnt vmcnt(2) lgkmcnt(0)\n\ts_barrier" ::: "memory"); } else if (c1 < 128) { asm volatile("s_waitcnt vmcnt(1) lgkmcnt(0)\n\ts_barrier" ::: "memory"); } \
            else { asm volatile("s_waitcnt vmcnt(0) lgkmcnt(0)\n\ts_barrier" ::: "memory"); } } while (0)
#define END_WAIT() asm volatile("s_waitcnt vmcnt(2) lgkmcnt(0)\n\ts_barrier" ::: "memory")
#define ROTATE() do { cm1 = c0; c0 = c1; c1 = c2; c2 = c3; c3 = (c3 < 128) ? NSA_NEXT(c3) : 128; sp = s0; s0 = s1; s1 = (s1 == 2) ? 0 : s1 + 1; } while (0)
#define ROWMAX(C0, C1, mx) do { float a_ = MX3(C0[0], C0[1], C1[0]), b_ = MX3(C0[2], C0[3], C1[1]); a_ = MX3(a_, C1[2], C1[3]); \
            _Pragma("unroll") for (int r = 4; r < 16; r += 4) { a_ = MX3(a_, C0[r], C0[r + 1]); b_ = MX3(b_, C0[r + 2], C0[r + 3]); a_ = MX3(a_, C1[r], C1[r + 1]); b_ = MX3(b_, C1[r + 2], C1[r + 3]); } \
            mx = pl32_max(__builtin_fmaxf(a_, b_)); } while (0)
        int cm1 = 0, c0 = 0, c1 = NSA_NEXT(0), c2 = (c1 < 128) ? NSA_NEXT(c1) : 128, c3 = (c2 < 128) ? NSA_NEXT(c2) : 128;
        int sp = 1, s0 = 2, s1 = 0;
        (void)cm1;
        if (c1 < 128) { dma_k(NSA_KSRC(c1), LDU, ringa, wave, lane); dma_v(NSA_KSRC(c1) + 128, LDU, ringa, wave, lane); }
        if (c2 < 128) dma_k(NSA_KSRC(c2), LDU, ringa + SLOT_BYTES, wave, lane);
        bf16x8_t kf[8]; v4i16_t vl[8], vh[8]; u32x4_t pw0, pw1, pw2, pw3;
        f32x16_t pA0, pA1, pB0, pB1, o[2];
        { const f32x16_t z = {0.f, 0.f, 0.f, 0.f, 0.f, 0.f, 0.f, 0.f, 0.f, 0.f, 0.f, 0.f, 0.f, 0.f, 0.f, 0.f}; o[0] = z; o[1] = z; }
        float m = ref_s + SM_THR, l = 0.f; bool inwin = false;
        { const LASP unsigned char* kb = kfl + 2 * SLOT_BYTES;
          KLD(0, kb); KLD(1, kb); KLD(2, kb); KLD(3, kb); KLD(4, kb); KLD(5, kb); KLD(6, kb); KLD(7, kb);
          const float ci = -m; const f32x16_t cin = {ci, ci, ci, ci, ci, ci, ci, ci, ci, ci, ci, ci, ci, ci, ci, ci};
          pA0 = MFMA32(kf[0], q[0], cin); pA1 = MFMA32(kf[1], q[0], cin); pA0 = MFMA32(kf[2], q[1], pA0); pA1 = MFMA32(kf[3], q[1], pA1);
          pA0 = MFMA32(kf[4], q[2], pA0); pA1 = MFMA32(kf[5], q[2], pA1); pA0 = MFMA32(kf[6], q[3], pA0); pA1 = MFMA32(kf[7], q[3], pA1);
          if (3 > cur) xf4<false>(pA0, pA1, t - 4 * h, 0x7fffffffu, tab4);
          float mx; ROWMAX(pA0, pA1, mx);
          if (__any(mx > SM_THR)) { const float d = mx > SM_THR ? mx : 0.f; m += d;
#pragma unroll
              for (int r = 0; r < 16; ++r) { pA0[r] -= d; pA1[r] -= d; } }
#pragma unroll
          for (int r = 0; r < 16; ++r) { pA0[r] = EX(pA0[r]); pA1[r] = EX(pA1[r]); } }
        asm volatile("s_waitcnt vmcnt(0) lgkmcnt(0)\n\ts_barrier" ::: "memory");
        if (c3 < 128) dma_k(NSA_KSRC(c3), LDU, ringa + 2 * SLOT_BYTES, wave, lane);
        if (c1 < 128) { const LASP unsigned char* kb = kfl; KLD(0, kb); KLD(1, kb); KLD(2, kb); KLD(3, kb); KLD(4, kb); KLD(5, kb); KLD(6, kb); KLD(7, kb); }
        asm volatile("s_waitcnt lgkmcnt(0)\n\ts_barrier" ::: "memory");
        ROTATE();
#define NSA_STEP(C0, C1, P0, P1, BIAS) do { \
            const int j_ = c0 & 63; \
            const bool sel_ = (c0 >= 64) || ((mysel >> j_) & 1u); \
            const float ci_ = sel_ ? -m : NEG_BIG; \
            dma_k(NSA_KSRC(c3), LDU, ringa + s0 * SLOT_BYTES, wave, lane);        \
            dma_v(NSA_KSRC(c1) + 128, LDU, ringa + s1 * SLOT_BYTES, wave, lane); \
            const LASP unsigned char* vbp = vfl + sp * SLOT_BYTES; \
            __builtin_amdgcn_s_waitcnt(0xC07F);        \
            f32x2_t sacc = {P0[0], P0[1]}; \
            { const f32x16_t cin_ = {ci_, ci_, ci_, ci_, ci_, ci_, ci_, ci_, ci_, ci_, ci_, ci_, ci_, ci_, ci_, ci_}; C1 = cin_; }        \
            SBAR(); \
            VRD(0, 0, 0); SBAR(); C0 = MFMA32(kf[0], q[0], C1); sacc += (f32x2_t){P0[2], P0[3]}; sacc += (f32x2_t){P0[4], P0[5]}; PIN(sacc); pw0[0] = PKW(P0, 0); pw0[1] = PKW(P0, 2); PIN(pw0); SBAR(); \
            VRD(1, 0, 1); SBAR(); C1 = MFMA32(kf[1], q[0], C1); sacc += (f32x2_t){P0[6], P0[7]}; sacc += (f32x2_t){P0[8], P0[9]}; PIN(sacc); pw0[2] = PKW(P0, 4); pw0[3] = PKW(P0, 6); PIN(pw0); SBAR(); \
            VRD(2, 1, 0); SBAR(); C0 = MFMA32(kf[2], q[1], C0); sacc += (f32x2_t){P0[10], P0[11]}; sacc += (f32x2_t){P0[12], P0[13]}; PIN(sacc); pw1[0] = PKW(P0, 8); pw1[1] = PKW(P0, 10); PIN(pw1); SBAR(); \
            VRD(3, 1, 1); SBAR(); C1 = MFMA32(kf[3], q[1], C1); sacc += (f32x2_t){P0[14], P0[15]}; sacc += (f32x2_t){P1[0], P1[1]}; PIN(sacc); pw1[2] = PKW(P0, 12); pw1[3] = PKW(P0, 14); PIN(pw1); SBAR(); \
            VRD(4, 2, 0); SBAR(); C0 = MFMA32(kf[4], q[2], C0); sacc += (f32x2_t){P1[2], P1[3]}; sacc += (f32x2_t){P1[4], P1[5]}; PIN(sacc); pw2[0] = PKW(P1, 0); pw2[1] = PKW(P1, 2); PIN(pw2); SBAR(); \
            VRD(5, 2, 1); SBAR(); C1 = MFMA32(kf[5], q[2], C1); sacc += (f32x2_t){P1[6], P1[7]}; sacc += (f32x2_t){P1[8], P1[9]}; PIN(sacc); pw2[2] = PKW(P1, 4); pw2[3] = PKW(P1, 6); PIN(pw2); SBAR(); \
            VRD(6, 3, 0); SBAR(); C0 = MFMA32(kf[6], q[3], C0); sacc += (f32x2_t){P1[10], P1[11]}; sacc += (f32x2_t){P1[12], P1[13]}; PIN(sacc); pw3[0] = PKW(P1, 8); pw3[1] = PKW(P1, 10); PIN(pw3); SBAR(); \
            VRD(7, 3, 1); SBAR(); C1 = MFMA32(kf[7], q[3], C1); sacc += (f32x2_t){P1[14], P1[15]}; PIN(sacc); pw3[2] = PKW(P1, 12); pw3[3] = PKW(P1, 14); PIN(pw3); SBAR(); \
            l += sacc.x + sacc.y; \
            if (BIAS) xf4b(C0, C1, t - 64 * j_ - 4 * h, tab4);        \
            float mx_; ROWMAX(C0, C1, mx_); \
            bool resc_ = false; float f_ = 1.f; \
            if (__builtin_expect(__any(mx_ > SM_THR), 0)) { const float d_ = mx_ > SM_THR ? mx_ : 0.f; f_ = EX(-d_); m += d_; l *= f_; resc_ = true; \
                _Pragma("unroll") for (int r = 0; r < 16; ++r) { asm volatile("v_sub_f32 %0, %0, %1" : "+v"(C0[r]) : "v"(d_)); asm volatile("v_sub_f32 %0, %0, %1" : "+v"(C1[r]) : "v"(d_)); } } \
            __builtin_amdgcn_s_waitcnt(0xC07F);        \
            SBAR(); \
            o[0] = MFMA32(VFR(0), PWF(0), o[0]); C0[0] = EX(C0[0]); C0[1] = EX(C0[1]); C0[2] = EX(C0[2]); C0[3] = EX(C0[3]); PIN(C0); SBAR(); \
            o[1] = MFMA32(VFR(1), PWF(0), o[1]); C0[4] = EX(C0[4]); C0[5] = EX(C0[5]); C0[6] = EX(C0[6]); C0[7] = EX(C0[7]); PIN(C0); SBAR(); \
            { const LASP unsigned char* kb_ = kfl + s1 * SLOT_BYTES; KLD(0, kb_); KLD(1, kb_); SBAR(); }        \
            o[0] = MFMA32(VFR(2), PWF(1), o[0]); C0[8] = EX(C0[8]); C0[9] = EX(C0[9]); C0[10] = EX(C0[10]); C0[11] = EX(C0[11]); PIN(C0); SBAR(); \
            { const LASP unsigned char* kb_ = kfl + s1 * SLOT_BYTES; KLD(2, kb_); KLD(3, kb_); SBAR(); }        \
            o[1] = MFMA32(VFR(3), PWF(1), o[1]); C0[12] = EX(C0[12]); C0[13] = EX(C0[13]); C0[14] = EX(C0[14]); C0[15] = EX(C0[15]); PIN(C0); SBAR(); \
            { const LASP unsigned char* kb_ = kfl + s1 * SLOT_BYTES; KLD(4, kb_); KLD(5, kb_); SBAR(); }        \
            o[0] = MFMA32(VFR(4), PWF(2), o[0]); C1[0] = EX(C1[0]); C1[1] = EX(C1[1]); C1[2] = EX(C1[2]); C1[3] = EX(C1[3]); PIN(C1); SBAR(); \
            { const LASP unsigned char* kb_ = kfl + s1 * SLOT_BYTES; KLD(6, kb_); KLD(7, kb_); SBAR(); }        \
            o[1] = MFMA32(VFR(5), PWF(2), o[1]); C1[4] = EX(C1[4]); C1[5] = EX(C1[5]); C1[6] = EX(C1[6]); C1[7] = EX(C1[7]); PIN(C1); SBAR(); \
            o[0] = MFMA32(VFR(6), PWF(3), o[0]); C1[8] = EX(C1[8]); C1[9] = EX(C1[9]); C1[10] = EX(C1[10]); C1[11] = EX(C1[11]); PIN(C1); SBAR(); \
            o[1] = MFMA32(VFR(7), PWF(3), o[1]); C1[12] = EX(C1[12]); C1[13] = EX(C1[13]); C1[14] = EX(C1[14]); C1[15] = EX(C1[15]); PIN(C1); SBAR(); \
            if (resc_) { _Pragma("unroll") for (int r = 0; r < 16; ++r) { asm volatile("v_mul_f32 %0, %0, %1" : "+v"(o[0][r]) : "v"(f_)); asm volatile("v_mul_f32 %0, %0, %1" : "+v"(o[1][r]) : "v"(f_)); } } \
            END_WAIT(); \
            ROTATE(); } while (0)
#define NSA_STEP_GEN(C0, C1, P0, P1, KIND) do { \
            const int j_ = c0 & 63; const bool win_ = c0 >= 64, sw_ = win_ && !inwin; \
            const bool sel_ = win_ || ((mysel >> j_) & 1u); \
            const float mq_ = sw_ ? ref_w + SM_THR : m; \
            const float ci_ = sel_ ? -mq_ : NEG_BIG; \
            if (c3 < 128) dma_k(NSA_KSRC(c3), LDU, ringa + s0 * SLOT_BYTES, wave, lane); \
            if (c1 < 128) dma_v(NSA_KSRC(c1) + 128, LDU, ringa + s1 * SLOT_BYTES, wave, lane); \
            { VFr1 vf_; pv_read1(vf_, vfl + sp * SLOT_BYTES);        \
              float sacc = 0.f; _Pragma("unroll") for (int r = 0; r < 16; ++r) sacc += P0[r] + P1[r]; l += sacc; \
              bf16x8_t pf_[4]; pf_[0] = pack8(P0, 0); pf_[1] = pack8(P0, 8); pf_[2] = pack8(P1, 0); pf_[3] = pack8(P1, 8); \
              pv_mma1(o, vf_, pf_); } \
            if (sw_) { const float fs_ = NSA_GATE(1) / pl32_sum(l); l = 0.f; m = mq_; \
                _Pragma("unroll") for (int r = 0; r < 16; ++r) { oal[r * 64] = fmaf(fs_, o[0][r], oal[r * 64]); oal[(16 + r) * 64] = fmaf(fs_, o[1][r], oal[(16 + r) * 64]); o[0][r] = 0.f; o[1][r] = 0.f; } \
                inwin = true; } \
            { const f32x16_t cin_ = {ci_, ci_, ci_, ci_, ci_, ci_, ci_, ci_, ci_, ci_, ci_, ci_, ci_, ci_, ci_, ci_}; C1 = cin_; } \
            C0 = MFMA32(kf[0], q[0], C1); C1 = MFMA32(kf[1], q[0], C1); C0 = MFMA32(kf[2], q[1], C0); C1 = MFMA32(kf[3], q[1], C1); \
            C0 = MFMA32(kf[4], q[2], C0); C1 = MFMA32(kf[5], q[2], C1); C0 = MFMA32(kf[6], q[3], C0); C1 = MFMA32(kf[7], q[3], C1); \
            if (c1 < 128) { const LASP unsigned char* kb_ = kfl + s1 * SLOT_BYTES; KLD(0, kb_); KLD(1, kb_); KLD(2, kb_); KLD(3, kb_); KLD(4, kb_); KLD(5, kb_); KLD(6, kb_); KLD(7, kb_); } \
            if (KIND) xf4<true>(C0, C1, t - 64 * j_ - 4 * h, win_ ? (unsigned)WINDOW : 0x7fffffffu, tab4);        \
            else xf4<false>(C0, C1, t - 64 * j_ - 4 * h, 0u, tab4);                                               \
            float mx_; ROWMAX(C0, C1, mx_); \
            if (__any(mx_ > SM_THR)) { const float d_ = mx_ > SM_THR ? mx_ : 0.f, f_ = EX(-d_); m += d_; l *= f_; \
                _Pragma("unroll") for (int r = 0; r < 16; ++r) { C0[r] -= d_; C1[r] -= d_; o[0][r] *= f_; o[1][r] *= f_; } } \
            _Pragma("unroll") for (int r = 0; r < 16; ++r) { C0[r] = EX(C0[r]); C1[r] = EX(C1[r]); } \
            END_WAIT3(); \
            ROTATE(); } while (0)
#define NSA_DRAIN(P0, P1) do { VFr1 vf_; pv_read1(vf_, vfl + sp * SLOT_BYTES); float sacc = 0.f; _Pragma("unroll") for (int r = 0; r < 16; ++r) sacc += P0[r] + P1[r]; l += sacc; \
            bf16x8_t pf_[4]; pf_[0] = pack8(P0, 0); pf_[1] = pack8(P0, 8); pf_[2] = pack8(P1, 0); pf_[3] = pack8(P1, 8); \
            pv_mma1(o, vf_, pf_); } while (0)
#define NSA_ISGEN(code) (((code) >= 64) ? (!inwin || !(((code) & 63) + 3 <= cur && ((code) & 63) + 8 > cur)) : (((code) & 63) + 3 > cur))
#define NSA_NEAR(code) ((((code) & 63) + 3 > cur) ? 3 : 0)
#define NSA_KIND(code) (((code) < 64) ? NSA_NEAR(code) : ((((code) & 63) + 8 == cur) ? 2 : (inwin ? NSA_NEAR(code) : 1)))
#define NSA_ISSEQ(code) ((code) >= 64 && (!inwin || ((code) & 63) + 8 == cur))
#define NSA_ISMASK(code) ((code) >= 64 && ((code) & 63) + 8 == cur)
        bool lastA = true;
        for (;;) {
            if (c0 >= 128) break;
            { const int kind_ = NSA_KIND(c0); if (kind_ == 0 || kind_ == 3) { const bool near_ = kind_ == 3; NSA_STEP(pB0, pB1, pA0, pA1, near_); } else NSA_STEP_GEN(pB0, pB1, pA0, pA1, true); }
            lastA = false;
            if (c0 >= 128) break;
            { const int kind_ = NSA_KIND(c0); if (kind_ == 0 || kind_ == 3) { const bool near_ = kind_ == 3; NSA_STEP(pA0, pA1, pB0, pB1, near_); } else NSA_STEP_GEN(pA0, pA1, pB0, pB1, true); }
            lastA = true;
        }
        if (lastA) NSA_DRAIN(pA0, pA1); else NSA_DRAIN(pB0, pB1);
#undef NSA_STEP
#undef NSA_STEP_GEN
#undef NSA_ISSEQ
#undef NSA_ISGEN
#undef NSA_ISMASK
#undef NSA_DRAIN
#undef NSA_NEXT
#undef NSA_KSRC
#undef KLD
#undef VRD
#undef VFR
#undef PKW
#undef PWF
#undef ROWMAX
#undef END_WAIT
#undef END_WAIT3
#undef ROTATE
        const float fw = NSA_GATE(2) / pl32_sum(l);
        bf16_t* orow = (bf16_t*)(p.ws + OFF_ATT) + ((size_t)b * SEQ + t) * D_MODEL + hq * 64 + 4 * h;
#pragma unroll
        for (int db = 0; db < 2; ++db)
#pragma unroll
            for (int rg = 0; rg < 4; ++rg) { float v_[4];
#pragma unroll
                for (int e = 0; e < 4; ++e) v_[e] = fmaf(fw, o[db][4 * rg + e], oal[(16 * db + 4 * rg + e) * 64]);
                uint2 w; w.x = pg8::cvt_pk_bf16(v_[0], v_[1]); w.y = pg8::cvt_pk_bf16(v_[2], v_[3]); if (DRY == 0) *(uint2*)(orow + 32 * db + 8 * rg) = w; else asm volatile("" :: "v"(w.x), "v"(w.y)); }
        asm volatile("s_waitcnt lgkmcnt(0)" ::: "memory");
    }
}

#undef NSA_GATE
__device__ void diff_unit(const P& p, int b, int hd, int qb, LASP unsigned char* lds, int ew_it, bool fresh) {
    const int tid = ltid(), wave = __builtin_amdgcn_readfirstlane(tid >> 6), lane = tid & 63, r32 = lane & 31, h = lane >> 5;
    const int q0w = qb * 256 + wave * 32, t = q0w + r32;
    const bf16_t* Ub = (const bf16_t*)(p.ws + OFF_U) + (size_t)b * SEQ * LDU;
    LASP unsigned char* ring = lds + AL_RING;
    LASP float* tabw = (LASP float*)(lds + AL_TAB);
    LASP f32x4_t* tab4 = (LASP f32x4_t*)(lds + AL_TAB4);
    const int vlane = SLOT_V + ((lane >> 4) & 1) * 32 + (lane & 3) * 8 + (4 * h + ((lane & 15) >> 2)) * 64;
    const float c = 0.17677669529663687f * LOG2E;
    float ewv[32];
    const bool ew_on = (unsigned)ew_it < (unsigned)EW_ITEMS;
    if (ew_on) ew_load(p, ew_it, lane, ewv);
    if (fresh && tid < 128) { const float* biasd = (const float*)(p.ws + OFF_BIASD) + (8 + hd) * 2048; tabw[tid] = (biasd[tid] - biasd[127]) * LOG2E; }
    bf16x8_t q[4];
    { const bf16_t* qp = Ub + (size_t)t * LDU + C_QB + hd * 64 + 8 * h;
#pragma unroll
      for (int s = 0; s < 4; ++s) q[s] = q_scaled(qp + 16 * s, c); }
    AttnSt sa, sb; st_init(sa, self_score<2>(q, Ub + (size_t)t * LDU + C_KB + hd * 64, h)); st_init(sb, self_score<2>(q + 2, Ub + (size_t)t * LDU + C_KB + hd * 64 + 32, h));
    const bf16_t* ksrc = Ub + C_KB + hd * 64; const bf16_t* vsrc = Ub + C_VB + hd * 64;
    const int ntile = 4 * qb + 4;
    dma_tile(ksrc, vsrc, LDU, ring, wave, lane);
    dma_tile(ksrc + (size_t)64 * LDU, vsrc + (size_t)64 * LDU, LDU, ring + SLOT_BYTES, wave, lane);
    DMA_WAIT_BAR(2);
    if (fresh && tid < T4_N) t4_fill(tab4, tabw, tid);
    if (ew_on) ew_store(p, ew_it, lane, ewv);
    asm volatile("s_waitcnt lgkmcnt(0)\n\ts_barrier" ::: "memory");
    int sl = 0;
#pragma nounroll
    for (int j = 0; j < ntile; ++j) {
        const int sl1 = sl == 2 ? 0 : sl + 1, sl2 = sl1 == 2 ? 0 : sl1 + 1;
        if (j + 2 < ntile) dma_tile(ksrc + (size_t)(j + 2) * 64 * LDU, vsrc + (size_t)(j + 2) * 64 * LDU, LDU, ring + sl2 * SLOT_BYTES, wave, lane);
        if (64 * j <= q0w + 31) {
            const LASP unsigned char* kt = ring + sl * SLOT_BYTES; const LASP unsigned char* vt = kt + vlane;
            const bool far = (64 * j + 63 + 113 <= q0w);
            f32x16_t pa0, pa1, pb0, pb1; bf16x8_t pfa[4], pfb[4];
            qk_tile<2, 0>(pa0, pa1, -sa.m, kt, q, r32, h); qk_tile<2, 2>(pb0, pb1, -sb.m, kt, q + 2, r32, h);
            if (!far) xf4_2<false>(pa0, pa1, pb0, pb1, t - 64 * j - 4 * h, tab4);
            sm_only(sa, pa0, pa1, pfa); sm_only(sb, pb0, pb1, pfb);
            pv_tile2(sa.o, sb.o, vt, pfa, pfb);
        }
        if (j + 2 < ntile) DMA_WAIT_BAR(2); else DMA_WAIT_BAR(0);
        sl = sl1;
    }
    float la = sa.l; la = pl32_sum(la);
    float lb = sb.l; lb = pl32_sum(lb);
    float lam;
    { const float a_ = lane < 32 ? p.lq1[lane] * p.lk1[lane] : 0.f, c2_ = lane < 32 ? p.lq2[lane] * p.lk2[lane] : 0.f; lam = expf(wave_sum(a_)) - expf(wave_sum(c2_)) + 0.2f; }
    const float fa = 1.0f / la, fb = lam / lb;
    float ss = 0.f;
#pragma unroll
    for (int r = 0; r < 16; ++r) { sa.o[0][r] = sa.o[0][r] * fa - sb.o[0][r] * fb; sa.o[1][r] = sa.o[1][r] * fa - sb.o[1][r] * fb; ss += sa.o[0][r] * sa.o[0][r] + sa.o[1][r] * sa.o[1][r]; }
    ss = pl32_sum(ss);
    const float rn = 0.8f / sqrtf(ss * (1.0f / 64.0f) + EPS);
    bf16_t* orow = (bf16_t*)(p.ws + OFF_ATT) + ((size_t)b * SEQ + t) * D_MODEL + 512 + hd * 64 + 4 * h;
#pragma unroll
    for (int db = 0; db < 2; ++db)
#pragma unroll
        for (int rg = 0; rg < 4; ++rg) { const float4 gsl = *(const float4*)(p.subln + 32 * db + 8 * rg + 4 * h);
            uint2 w; w.x = pg8::cvt_pk_bf16(sa.o[db][4 * rg] * rn * gsl.x, sa.o[db][4 * rg + 1] * rn * gsl.y); w.y = pg8::cvt_pk_bf16(sa.o[db][4 * rg + 2] * rn * gsl.z, sa.o[db][4 * rg + 3] * rn * gsl.w);
            *(uint2*)(orow + 32 * db + 8 * rg) = w; }
}

__device__ void f_attn(const P& p, int bid, int nb, LASP unsigned char* lds) {
#ifndef DRY_MODE
#define DRY_MODE 0
#endif
    if (DRY_MODE) for (int u = bid; u < 1024; u += nb) { const int vb0_ = u & 255, vb = ((vb0_ & 7) << 5) | (vb0_ >> 3), i = u >> 8; const int pair = vb >> 3, s = vb & 7;
        const unsigned ctab = (s == 0) ? 0x1f1a0800u : (s == 1) ? 0x1e180901u : (s == 2) ? 0x1d160a02u : (s == 3) ? 0x1c140b03u : (s == 4) ? 0x1b130c04u : (s == 5) ? 0x19120d05u : (s == 6) ? 0x17110e06u : 0x15100f07u;
        const int cur = (int)((ctab >> (8 * (3 - i))) & 0xffu);
        nsa_unit<DRY_MODE>(p, pair >> 1, pair & 1, cur, lds, -1, true); __syncthreads(); }
    int tabkey = -1;
    for (int u = bid; u < 2048; u += nb) {
        const int ew_it = u * 8 + __builtin_amdgcn_readfirstlane(ltid() >> 6);
        const int vb0_ = u & 255, vb = ((vb0_ & 7) << 5) | (vb0_ >> 3), i = u >> 8;
        if (i < 4) { const int pair = vb >> 3, s = vb & 7;
            const unsigned ctab = (s == 0) ? 0x1f1a0800u : (s == 1) ? 0x1e180901u : (s == 2) ? 0x1d160a02u : (s == 3) ? 0x1c140b03u : (s == 4) ? 0x1b130c04u : (s == 5) ? 0x19120d05u : (s == 6) ? 0x17110e06u : 0x15100f07u;
            const int cur = (int)((ctab >> (8 * (3 - i))) & 0xffu);
            const int key = pair & 1; nsa_unit<0>(p, pair >> 1, pair & 1, cur, lds, ew_it, key != tabkey); tabkey = key; }
        else { const int pair = vb >> 1, s = vb & 1, k = i - 4; const int qb = s ? ((k == 0) ? 6 : (k == 1) ? 5 : (k == 2) ? 2 : 1) : ((k == 0) ? 7 : (k == 1) ? 4 : (k == 2) ? 3 : 0);
            const int key = 8 + (pair & 7); diff_unit(p, pair >> 3, pair & 7, qb, lds, ew_it, key != tabkey); tabkey = key; }
        __syncthreads();
    }
}

template <bool DUMMY> __device__ void f_route(const P& p, int bid, int nb, float* sm, int* lctl) {
    const int tid = ltid(), wave = tid >> 6, lane = tid & 63, fr = lane & 15, fq = lane >> 4;
    const bf16_t* RH = (const bf16_t*)(p.ws + OFF_RW_HI); const bf16_t* RL = (const bf16_t*)(p.ws + OFF_RW_LO);
    const bf16_t* HBr = (const bf16_t*)(p.ws + OFF_HB);
    unsigned* cnt = (unsigned*)(p.ws + OFF_CTL) + CTL_CNT + (DUMMY ? 64 : 0);
    int* list = (int*)(p.ws + (DUMMY ? OFF_ATT + 32 * MiB : OFF_LIST)); float* slr = (float*)(p.ws + (DUMMY ? OFF_ATT + 36 * MiB : OFF_SLR));
    unsigned* tok_ep = (unsigned*)(p.ws + (DUMMY ? OFF_ATT + 40 * MiB : OFF_TOK_EP)); float* tok_w = (float*)(p.ws + (DUMMY ? OFF_ATT + 41 * MiB : OFF_TOK_W));
    float* lgs = sm + 24576 + wave * 800;
    int* lcnt = lctl + LC_LCNT; int* gbase = lctl + LC_GBASE;
    for (int t0 = bid * 128; t0 < T_TOK; t0 += nb * 128) {
        if (tid < 32) lcnt[tid] = 0;
        const int tok0 = t0 + wave * 16;
        f32x4_t acc[3]; acc[0] = (f32x4_t){0.f, 0.f, 0.f, 0.f}; acc[1] = acc[0]; acc[2] = acc[0];
        float ss = 0.f;
        const bf16_t* hrow = HBr + (size_t)(tok0 + fr) * D_MODEL + 8 * fq;
        LASP unsigned char* rb = (LASP unsigned char*)sm;
#define RT_DMA(c, boff) do { _Pragma("unroll") for (int q_ = 0; q_ < 6; ++q_) { const int idx_ = wave + 8 * q_, hl_ = idx_ / 24, rem_ = idx_ % 24, ks_ = rem_ / 3, nt_ = rem_ % 3; \
            const bf16_t* src_ = (hl_ ? RL : RH) + (size_t)(nt_ * 16 + (lane >> 2)) * D_MODEL + (c) * 256 + 32 * ks_ + 8 * (lane & 3); \
            __builtin_amdgcn_global_load_lds((const unsigned*)src_, (LASP unsigned*)(rb + (boff) + idx_ * 1024), 16, 0, 0); } } while (0)
#define RT_LDA(S, c) do { _Pragma("unroll") for (int k_ = 0; k_ < 8; ++k_) S[k_] = *(const u32x4_t*)(hrow + (c) * 256 + k_ * 32); } while (0)
#define RT_COMP(S, boff) do { _Pragma("unroll") for (int k_ = 0; k_ < 8; ++k_) { const u32x4_t wh = S[k_]; \
            _Pragma("unroll") for (int j = 0; j < 4; ++j) { const float v0 = __uint_as_float(wh[j] << 16), v1 = __uint_as_float(wh[j] & 0xffff0000u); ss = fmaf(v0, v0, ss); ss = fmaf(v1, v1, ss); } \
            const bf16x8_t ahi = __builtin_bit_cast(bf16x8_t, wh); \
            _Pragma("unroll") for (int n = 0; n < 3; ++n) { const bf16x8_t bh_ = *(const LASP bf16x8_t*)(rb + (boff) + (k_ * 3 + n) * 1024 + (fr * 4 + fq) * 16), bl_ = *(const LASP bf16x8_t*)(rb + (boff) + 24576 + (k_ * 3 + n) * 1024 + (fr * 4 + fq) * 16); \
                acc[n] = __builtin_amdgcn_mfma_f32_16x16x32_bf16(ahi, bh_, acc[n], 0, 0, 0); acc[n] = __builtin_amdgcn_mfma_f32_16x16x32_bf16(ahi, bl_, acc[n], 0, 0, 0); } } } while (0)
#define RT_BAR(N) asm volatile("s_waitcnt vmcnt(" #N ") lgkmcnt(0)\n\ts_barrier" ::: "memory")
        u32x4_t A0[8], A1[8];
        RT_DMA(0, 0); RT_LDA(A0, 0);
        RT_DMA(1, 49152); RT_LDA(A1, 1);
        RT_BAR(14);
        RT_COMP(A0, 0);
        RT_BAR(0);
        RT_DMA(2, 0); RT_LDA(A0, 2);
        RT_COMP(A1, 49152);
        RT_BAR(0);
        RT_DMA(3, 49152); RT_LDA(A1, 3);
        RT_COMP(A0, 0);
        RT_BAR(0);
        RT_COMP(A1, 49152);
        RT_BAR(0);
#undef RT_DMA
#undef RT_LDA
#undef RT_COMP
#undef RT_BAR
        ss = pl32_sum(pl16_sum(ss));
        const float rs = 1.0f / sqrtf(ss * (1.0f / D_MODEL) + EPS);
#pragma unroll
        for (int n = 0; n < 3; ++n)
#pragma unroll
            for (int i = 0; i < 4; ++i) lgs[(4 * fq + i) * 48 + n * 16 + fr] = acc[n][i];
        if (fq == 0) lgs[768 + fr] = rs;
        __syncthreads();
        int e_[2] = {0, 0}; int rk[2] = {0, 0}; float w_[2] = {0.f, 0.f}; float myrs = 0.f;
        if (lane < 16) {
            const float* l = lgs + lane * 48; myrs = lgs[768 + lane];
            float g[4]; int gi = 0;
#pragma unroll
            for (int i = 0; i < 4; ++i) g[i] = l[i] * myrs + p.bg[i];
            float mx = g[0];
#pragma unroll
            for (int i = 1; i < 4; ++i) if (g[i] > mx) { mx = g[i]; gi = i; }
            float den = 0.f;
#pragma unroll
            for (int i = 0; i < 4; ++i) den += expf(g[i] - mx);
            const float gprob = 1.0f / den;
            float el[8];
#pragma unroll
            for (int i = 0; i < 8; ++i) el[i] = l[4 + gi * 8 + i] * myrs + p.be[gi * 8 + i];
            float emx = el[0]; int e0 = 0;
#pragma unroll
            for (int i = 1; i < 8; ++i) if (el[i] > emx) { emx = el[i]; e0 = i; }
            float e2 = -INFINITY; int e1 = 0;
#pragma unroll
            for (int i = 0; i < 8; ++i) if (i != e0 && el[i] > e2) { e2 = el[i]; e1 = i; }
            float eden = 0.f;
#pragma unroll
            for (int i = 0; i < 8; ++i) eden += expf(el[i] - emx);
            const float pa = 1.0f / eden, pb = expf(e2 - emx) / eden;
            e_[0] = gi * 8 + e0; e_[1] = gi * 8 + e1; w_[0] = gprob * pa / (pa + pb); w_[1] = gprob * pb / (pa + pb);
            rk[0] = atomicAdd(&lcnt[e_[0]], 1); rk[1] = atomicAdd(&lcnt[e_[1]], 1);
        }
        __syncthreads();
        if (tid < 32) gbase[tid] = lcnt[tid] ? (int)atomicAdd(&cnt[tid], (unsigned)lcnt[tid]) : 0;
        __syncthreads();
        if (lane < 16) { const int tok = tok0 + lane;
#pragma unroll
            for (int k = 0; k < 2; ++k) { const int pos = gbase[e_[k]] + rk[k]; list[(size_t)e_[k] * T_TOK + pos] = tok; slr[(size_t)e_[k] * T_TOK + pos] = myrs;
                tok_ep[tok * 2 + k] = ((unsigned)e_[k] << 16) | (unsigned)pos; tok_w[tok * 2 + k] = w_[k]; } }
        __syncthreads();
    }
}
__device__ void f_moe_tables(const P& p, int* lctl) {
    const int tid = ltid();
    const unsigned* cnt = (const unsigned*)(p.ws + OFF_CTL) + CTL_CNT;
    if (tid < 32) lctl[LC_NCNT + tid] = (int)cnt[tid];
    __syncthreads();
    if (tid == 0) { int acc = 0; for (int e = 0; e < 32; ++e) { lctl[LC_TBASE + e] = acc; const int nt_ = (lctl[LC_NCNT + e] + 255) >> 8; for (int i = 0; i < nt_; ++i) lctl[LC_TILE_E + acc + i] = e; acc += nt_; } lctl[LC_TBASE + 32] = acc; }
    __syncthreads();
}
__device__ void f_final(const P& p, int bid, int nb, const int* lctl) {
    const int tid = ltid(), wave = tid >> 6, lane = tid & 63;
    const bf16_t* HBp = (const bf16_t*)(p.ws + OFF_HB); const bf16_t* YC = (const bf16_t*)(p.ws + OFF_YC);
    const unsigned* tok_ep = (const unsigned*)(p.ws + OFF_TOK_EP); const float* tok_w = (const float*)(p.ws + OFF_TOK_W);
    float4 gf[4];
#pragma unroll
    for (int j = 0; j < 4; ++j) gf[j] = *((const float4*)p.ln_final + lane + 64 * j);
    for (int tok = bid * 8 + wave; tok < T_TOK; tok += nb * 8) {
        const unsigned ep0 = tok_ep[tok * 2], ep1 = tok_ep[tok * 2 + 1]; const float w0 = tok_w[tok * 2], w1 = tok_w[tok * 2 + 1];
        const size_t s0 = (size_t)lctl[LC_TBASE + (ep0 >> 16)] * 256 + (ep0 & 0xffffu), s1 = (size_t)lctl[LC_TBASE + (ep1 >> 16)] * 256 + (ep1 & 0xffffu);
        const uint2* hr = (const uint2*)(HBp + (size_t)tok * D_MODEL) + lane; const uint2* y0 = (const uint2*)(YC + s0 * D_MODEL) + lane; const uint2* y1 = (const uint2*)(YC + s1 * D_MODEL) + lane;
        float4 z[4]; float ss = 0.f;
#pragma unroll
        for (int j = 0; j < 4; ++j) { const uint2 hh = hr[64 * j]; const uint2 a = y0[64 * j], b = y1[64 * j];
            z[j].x = __uint_as_float(hh.x << 16) + w0 * __uint_as_float(a.x << 16) + w1 * __uint_as_float(b.x << 16);
            z[j].y = __uint_as_float(hh.x & 0xffff0000u) + w0 * __uint_as_float(a.x & 0xffff0000u) + w1 * __uint_as_float(b.x & 0xffff0000u);
            z[j].z = __uint_as_float(hh.y << 16) + w0 * __uint_as_float(a.y << 16) + w1 * __uint_as_float(b.y << 16);
            z[j].w = __uint_as_float(hh.y & 0xffff0000u) + w0 * __uint_as_float(a.y & 0xffff0000u) + w1 * __uint_as_float(b.y & 0xffff0000u);
            ss += (z[j].x * z[j].x + z[j].y * z[j].y) + (z[j].z * z[j].z + z[j].w * z[j].w); }
        const float rs = 1.0f / sqrtf(wave_sum(ss) * (1.0f / D_MODEL) + EPS);
        float4* o = (float4*)(p.out + (size_t)tok * D_MODEL) + lane;
#pragma unroll
        for (int j = 0; j < 4; ++j) o[64 * j] = make_float4(z[j].x * rs * gf[j].x, z[j].y * rs * gf[j].y, z[j].z * rs * gf[j].z, z[j].w * rs * gf[j].w);
    }
}

#define XB_TMO      128
#define XB_XCNT(j)  (256  + 64 * (j))
#define XB_XSUB(j)  (1280 + 64 * (j))
#define XB_XGEN(j)  (2304 + 64 * (j))
#define XB_TOP      3328
#define XB_TOPGEN   3392
#define XCD_BAR_WORDS 3456
#define XB_SPIN_CAP (1u << 26)
#define LAS __attribute__((address_space(3)))

__device__ __forceinline__ unsigned xb_ld(unsigned* p)              { return __hip_atomic_load(p, __ATOMIC_RELAXED, __HIP_MEMORY_SCOPE_AGENT); }
__device__ __forceinline__ unsigned xb_add(unsigned* p, unsigned v) { return __hip_atomic_fetch_add(p, v, __ATOMIC_RELAXED, __HIP_MEMORY_SCOPE_AGENT); }
__device__ __forceinline__ unsigned xb_xcc_id() { return (unsigned)__builtin_amdgcn_s_getreg((3 << 11) | 20) & 0xFu; }
#define XB_SPIN(cond, bar) do { unsigned _sp = 0; while (cond) { __builtin_amdgcn_s_sleep(1); \
    if ((++_sp & 255u) == 0u) { if (xb_ld(&(bar)[XB_TMO])) break; if (_sp > XB_SPIN_CAP) { atomicAdd(&(bar)[XB_TMO], 1u); break; } } } } while (0)

struct XcdBarrier {
    unsigned* bar; unsigned x;
    volatile LAS unsigned* st;
};

__device__ __forceinline__ XcdBarrier xcd_barrier_post(unsigned* bar, volatile LAS unsigned* st) {
    XcdBarrier b; b.bar = bar; b.x = xb_xcc_id(); b.st = st;
    if (threadIdx.x == 0) (void)xb_add(&bar[XB_XCNT(b.x)], 1u);
    return b;
}
__device__ __forceinline__ void xcd_barrier_complete(unsigned* bar, unsigned x, unsigned& nloc, unsigned& nx) {
    const unsigned G = gridDim.x * gridDim.y * gridDim.z;
    unsigned sum, cnt, mine, sp = 0u;
    for (;;) {
        sum = 0u; cnt = 0u; mine = 0u;
#pragma unroll
        for (unsigned j = 0; j < 16; ++j) { const unsigned c = xb_ld(&bar[XB_XCNT(j)]); sum += c; cnt += (c > 0u) ? 1u : 0u; mine = (j == x) ? c : mine; }
        if (sum == G) break;
        __builtin_amdgcn_s_sleep(1);
        if ((++sp & 255u) == 0u) { if (xb_ld(&bar[XB_TMO])) break; if (sp > XB_SPIN_CAP) { atomicAdd(&bar[XB_TMO], 1u); break; } }
    }
    nloc = mine > 0u ? mine : 1u; nx = cnt > 0u ? cnt : 1u;
}

__device__ __forceinline__ void xcd_barrier(const XcdBarrier& b) {
    asm volatile("s_waitcnt vmcnt(0)" ::: "memory");
    __syncthreads();
    if (threadIdx.x == 0) {
        unsigned* bar = b.bar;
        __builtin_amdgcn_s_waitcnt(0);
        unsigned nloc = b.st[0], nx = b.st[1];
        if (nloc == 0u) { xcd_barrier_complete(bar, b.x, nloc, nx); b.st[0] = nloc; b.st[1] = nx; }
        const unsigned old = xb_add(&bar[XB_XSUB(b.x)], 1u);
        const unsigned gen = old / nloc;
        if (old + 1u == (gen + 1u) * nloc) {
            __builtin_amdgcn_fence(__ATOMIC_RELEASE, "agent");
            asm volatile("s_waitcnt vmcnt(0)" ::: "memory");
            const unsigned og = xb_add(&bar[XB_TOP], 1u);
            const unsigned tg = og / nx;
            if (og + 1u == (tg + 1u) * nx) xb_add(&bar[XB_TOPGEN], 1u);
            else XB_SPIN(xb_ld(&bar[XB_TOPGEN]) == tg, bar);
            __builtin_amdgcn_fence(__ATOMIC_ACQUIRE, "agent");
            xb_add(&bar[XB_XGEN(b.x)], 1u);
            asm volatile("s_waitcnt vmcnt(0)" ::: "memory");
        } else {
            XB_SPIN(xb_ld(&bar[XB_XGEN(b.x)]) == gen, bar);
            __builtin_amdgcn_fence(__ATOMIC_ACQUIRE, "agent");
            asm volatile("s_waitcnt vmcnt(0)" ::: "memory");
        }
    }
    __syncthreads();
}


extern __shared__ __attribute__((aligned(16))) unsigned char dyn_smem[];
__global__ void __launch_bounds__(NT, 2) k_mega(P p) {
    float* sm = (float*)dyn_smem;
    LASP unsigned char* ring = (LASP unsigned char*)dyn_smem;
    const int bid = blockIdx.x, nb = gridDim.x;
    int* lctl = (int*)(dyn_smem + LDS_CTL_OFF);
    for (int i = threadIdx.x; i < 1024; i += NT) lctl[i] = 0;
    __syncthreads();
    XcdBarrier bar = xcd_barrier_post((unsigned*)(p.ws + OFF_CTL), (volatile LAS unsigned*)(dyn_smem + LDS_CTL_OFF));
    f_prologue(p, bid, nb, sm);
    xcd_barrier(bar);
    { pg8::Gemm g{(const bf16_t*)(p.ws + OFF_XN), (const bf16_t*)(p.ws + OFF_WIN_T), T_TOK, LDU, D_MODEL}; pg8::StaticOrder S; S.init(T_TOK, LDU, nb, bid);
      pg8::EpiBf16Lean E{(bf16_t*)(p.ws + OFF_U), LDU, 0xffff};
      pg8::gemm_phase<pg8::EpiBf16Lean, pg8::StaticOrder, true, true>(ring, g, S, E); }
    xcd_barrier(bar);
    f_cmp(p, bid, nb, ring);
    xcd_barrier(bar);
    f_attn(p, bid, nb, ring);
    xcd_barrier(bar);
    { pg8::Gemm g{(const bf16_t*)(p.ws + OFF_ATT), (const bf16_t*)(p.ws + OFF_WOUT_T), T_TOK, D_MODEL, D_MODEL}; pg8::StaticOrder S; S.init(T_TOK, D_MODEL, nb, bid);
      pg8::EpiResF32 E{p.x, (bf16_t*)(p.ws + OFF_HB), D_MODEL};
      pg8::gemm_phase<pg8::EpiResF32, pg8::StaticOrder, true, true>(ring, g, S, E); }
    xcd_barrier(bar);
    f_route<false>(p, bid, nb, sm, lctl);
    xcd_barrier(bar);
    f_moe_tables(p, lctl);
    const int vcu = (nb % 8 == 0) ? (bid % 8) * (nb / 8) + bid / 8 : bid;
    const pg8::MoeTab tb{(const LASP int*)lctl + LC_NCNT, (const LASP int*)lctl + LC_TBASE, (const LASP int*)lctl + LC_TILE_E};
    { pg8::Gemm g{(const bf16_t*)(p.ws + OFF_HB), (const bf16_t*)(p.ws + OFF_W13_T), 0, 512, D_MODEL};
      pg8::MoeOrderP S{{tb, 1, lctl[LC_TBASE + 32], nb, vcu, (const int*)(p.ws + OFF_LIST), (unsigned)(D_MODEL * 2)}, (unsigned*)(p.ws + OFF_CTL + CTL_PANEL)};
      pg8::EpiSwiglu E{(bf16_t*)(p.ws + OFF_HG), (const float*)(p.ws + OFF_SLR), tb};
      pg8::gemm_phase_g<pg8::EpiSwiglu, pg8::MoeOrderP, true, true>(ring, g, S, E); }
    __syncthreads();
    { pg8::Gemm g{(const bf16_t*)(p.ws + OFF_HG), (const bf16_t*)(p.ws + OFF_WD_T), 0, D_MODEL, EXP_FF};
      const int ntot = lctl[LC_TBASE + 32];
      pg8::MoeOrderC S{{tb, 2, ntot, nb, vcu, nullptr, 0u}, (const unsigned*)(p.ws + OFF_CTL + CTL_PANEL), 16u, (2 * ntot) % nb, 3};
      pg8::EpiBf16Lean E{(bf16_t*)(p.ws + OFF_YC), D_MODEL, 3};
      pg8::gemm_phase<pg8::EpiBf16Lean, pg8::MoeOrderC, true, true>(ring, g, S, E); }
    xcd_barrier(bar);
    f_final(p, bid, nb, lctl);
}

extern "C" void kernel_launch(void* const* d_in, const int* in_sizes, int n_in, void* d_out, int out_size, void* d_ws, size_t ws_size, hipStream_t stream) {
    if (ws_size < WS_NEED) { fprintf(stderr, "kernel_launch: workspace too small (%zu < %zu)\n", ws_size, WS_NEED); return; }
    P p{};
    const float** f = (const float**)&p;
    for (int i = 0; i < 25; ++i) f[i] = (const float*)d_in[i];
    p.out = (float*)d_out; p.ws = (unsigned char*)d_ws;
    static int grid = 0;
    if (!grid) {
        int dev = 0, cus = 0, per_cu = 0;
        (void)hipGetDevice(&dev);
        (void)hipDeviceGetAttribute(&cus, hipDeviceAttributeMultiprocessorCount, dev);
        if (hipFuncSetAttribute((const void*)k_mega, hipFuncAttributeMaxDynamicSharedMemorySize, LDS_TOTAL) != hipSuccess) { fprintf(stderr, "kernel_launch: hipFuncSetAttribute failed\n"); grid = -1; return; }
        (void)hipOccupancyMaxActiveBlocksPerMultiprocessor(&per_cu, (const void*)k_mega, NT, LDS_TOTAL);
        if (per_cu < 1) fprintf(stderr, "kernel_launch: occupancy query reports %d blocks per CU\n", per_cu);
        grid = cus;
    }
    if (grid < 0) return;
    (void)hipMemsetAsync(p.ws + OFF_CTL, 0, 64 * 1024 + 320 * 256, stream);
    hipLaunchKernelGGL(k_mega, dim3(grid), dim3(NT), LDS_TOTAL, stream, p);
}
```

```cpp
#include <hip/hip_runtime.h>
#include <cstdio>
#include <cstdint>
#include <cmath>


typedef unsigned short bf16_t;
__device__ __forceinline__ int ltid() { int t = threadIdx.x; asm volatile("" : "+v"(t)); return t; }

constexpr int D_MODEL = 1024, BATCH = 16, SEQ = 2048, T_TOK = BATCH * SEQ;
constexpr int NSA_HEADS = 8, NSA_G = 2, NSA_HD = 64, CMP_LEN = 32, CMP_STRIDE = 16, CMP_HID = 128, N_CMP = 127;
constexpr int SEL_BLOCK = 64, SEL_TOPN = 8, WINDOW = 512, N_SEL = SEQ / SEL_BLOCK;
constexpr int DIFF_HEADS = 8, DIFF_HD = 32;
constexpr int D_IN = 2840, LDU = 3072;
constexpr int C_QA = 0, C_KC = 512, C_VC = 640, C_KS = 768, C_VS = 896, C_KW = 1024, C_VW = 1152, C_GATE = 1280, C_QB = 1304, C_KB = 1816, C_VB = 2328;
constexpr int N_EXP = 32, EPG = 8, N_GRP = 4, EXP_FF = 256;
constexpr float EPS = 1e-6f;
constexpr int NT = 512;

constexpr size_t MiB = 1024 * 1024;
constexpr size_t OFF_CTL = 0;
constexpr size_t OFF_RSTD = 64 * 1024;
constexpr size_t OFF_BIASD = 192 * 1024;
constexpr size_t OFF_HID = 1 * MiB;
constexpr size_t OFF_KCMP = 5 * MiB;
constexpr size_t OFF_VCMP = 5 * MiB + 512 * 1024;
constexpr size_t OFF_U = 8 * MiB;
constexpr size_t OFF_ATT = 200 * MiB;
constexpr size_t OFF_H = 264 * MiB;
constexpr size_t OFF_XN = OFF_ATT;
constexpr size_t OFF_WIN_T = 392 * MiB;
constexpr size_t OFF_WOUT_T = 398 * MiB;
constexpr size_t OFF_RW_HI = 6 * MiB;
constexpr size_t OFF_RW_LO = 6 * MiB + 128 * 1024;
constexpr size_t OFF_TOK_EP = 6 * MiB + 512 * 1024;
constexpr size_t OFF_TOK_W = 6 * MiB + 768 * 1024;
constexpr size_t OFF_LIST = 400 * MiB;
constexpr size_t OFF_SLR = 404 * MiB;
constexpr size_t OFF_W13_T = 408 * MiB;
constexpr size_t OFF_WD_T = 440 * MiB;
constexpr size_t OFF_HB = OFF_U;
constexpr size_t OFF_YC = OFF_U + 64 * MiB;
constexpr size_t OFF_HG = OFF_ATT + 16 * MiB;
constexpr size_t OFF_W1T = 7 * MiB;
constexpr size_t OFF_W2T = 1 * MiB;
constexpr size_t OFF_B1 = 1 * MiB + 64 * 1024;
constexpr size_t CTL_PANEL = 65536;
constexpr int CTL_CNT = 8192;
constexpr size_t WS_NEED = 456 * MiB;

struct P {
    const float *x, *rel_bias, *ln_mix, *w_in, *pos_k, *pos_v, *ck1, *ck2, *cv1, *cv2, *lq1, *lk1, *lq2, *lk2, *subln, *w_out, *ln_ffn, *wg, *bg, *we, *be,
        *w_gate, *w_up, *w_down, *ln_final;
    float* out;
    unsigned char* ws;
};

__device__ __forceinline__ float bf2f(bf16_t v) { return __uint_as_float((unsigned)v << 16); }
__device__ __forceinline__ bf16_t f2bf(float f) { unsigned u = __float_as_uint(f); u += 0x7fffu + ((u >> 16) & 1u); return (bf16_t)(u >> 16); }
#define DPP_F(v, ctrl) __uint_as_float((unsigned)__builtin_amdgcn_update_dpp(0, (int)__float_as_uint(v), ctrl, 0xf, 0xf, true))
__device__ __forceinline__ float pl16_sum(float v) { const auto rr = __builtin_amdgcn_permlane16_swap(__float_as_uint(v), __float_as_uint(v), false, false); return __uint_as_float(rr[0]) + __uint_as_float(rr[1]); }
__device__ __forceinline__ float pl16_max(float v) { const auto rr = __builtin_amdgcn_permlane16_swap(__float_as_uint(v), __float_as_uint(v), false, false); return fmaxf(__uint_as_float(rr[0]), __uint_as_float(rr[1])); }
__device__ __forceinline__ float pl32_sum(float v) { const auto rr = __builtin_amdgcn_permlane32_swap(__float_as_uint(v), __float_as_uint(v), false, false); return __uint_as_float(rr[0]) + __uint_as_float(rr[1]); }
__device__ __forceinline__ float pl32_max(float v) { const auto rr = __builtin_amdgcn_permlane32_swap(__float_as_uint(v), __float_as_uint(v), false, false); return fmaxf(__uint_as_float(rr[0]), __uint_as_float(rr[1])); }
__device__ __forceinline__ float pl32_other(float v) { const unsigned u = __float_as_uint(v); const auto rr = __builtin_amdgcn_permlane32_swap(u, u, false, false); return __uint_as_float(rr[0] != u ? rr[0] : rr[1]); }
__device__ __forceinline__ float wave_sum(float v) {
    v += DPP_F(v, 0xB1); v += DPP_F(v, 0x4E); v += DPP_F(v, 0x141); v += DPP_F(v, 0x140);
    return pl32_sum(pl16_sum(v));
}
__device__ __forceinline__ float wave_max(float v) {
    v = fmaxf(v, DPP_F(v, 0xB1)); v = fmaxf(v, DPP_F(v, 0x4E)); v = fmaxf(v, DPP_F(v, 0x141)); v = fmaxf(v, DPP_F(v, 0x140));
    return pl32_max(pl16_max(v));
}
__device__ __forceinline__ int t5_bucket(int n) {
    if (n < 16) return n;
    const float nf = (float)n;
    int large = 16 + (int)(logf(nf / 16.0f) / 2.0794415416798357f * 16.0f);
    return large < 31 ? large : 31;
}
__device__ __forceinline__ float gelu_tanh(float x) { return 0.5f * x * (1.0f + tanhf(0.7978845608028654f * (x + 0.044715f * x * x * x))); }
__device__ __forceinline__ float sigmoidf_(float x) { return 1.0f / (1.0f + expf(-x)); }

namespace pg8 {
#define PG8_LAS __attribute__((address_space(3)))
typedef unsigned short bf16_t;
typedef short bf16x8 __attribute__((ext_vector_type(8)));
typedef float f32x4 __attribute__((ext_vector_type(4)));
typedef unsigned u32x4 __attribute__((ext_vector_type(4)));
constexpr int BM = 256, BK = 64, HALF = 128, HTB = HALF * BK * 2  , STAGE_BYTES = 8 * HTB, NXCD = 8, WGM = 8;

__host__ __device__ __forceinline__ int lds_byte(int r, int c) { const int st = (r >> 4) * 2 + (c >> 5), rr = r & 15, cc = c & 31, ob = rr * 64 + cc * 2; return st * 1024 + (ob ^ (((ob >> 9) & 1) << 5)); }
__host__ __device__ __forceinline__ void stage_rc(int b, int& R, int& C) { const int st = b / 1024, sb = b % 1024, swz = sb ^ (((sb >> 9) & 1) << 5); R = (st >> 1) * 16 + swz / 64; C = (st & 1) * 32 + (swz % 64) / 2; }
__host__ __device__ __forceinline__ int perm32(int rho) { const int n = rho >> 4, i = rho & 15; return 8 * (i >> 2) + 4 * n + (i & 3); }

struct Unit { int pm, pn; };
struct Gemm { const bf16_t* A; const bf16_t* Bt; int M, N, K; };

struct StaticOrder {
    int nM, nN, nwg, G, c;
    __host__ __device__ void init(int M, int N, int G_, int c_) { nM = M / BM; nN = N / BM; nwg = nM * nN; G = G_; c = c_; }
    __host__ __device__ bool next(int i, Unit& u) const {
        const long L = (long)i * G + c; if (L >= nwg) return false;
        int wgid = (int)L; { const int q = nwg / NXCD, r = nwg % NXCD, xcd = wgid % NXCD, off = wgid / NXCD; wgid = (xcd < r ? xcd * (q + 1) : r * (q + 1) + (xcd - r) * q) + off; }
        const int nig = WGM * nN, gid = wgid / nig, fm = gid * WGM, gsz = (nM - fm) < WGM ? (nM - fm) : WGM;
        u.pm = fm + ((wgid % nig) % gsz); u.pn = (wgid % nig) / gsz; return true;
    }
    __device__ __forceinline__ void a_ready(const Unit&) const {}
    __device__ __forceinline__ unsigned peek(const Unit&) const { return 0u; }
    __device__ __forceinline__ void a_ready(const Unit&, unsigned) const {}
    __device__ __forceinline__ void done(const Unit&) const {}
};

__device__ __forceinline__ unsigned cvt_pk_bf16(float lo, float hi) { unsigned r; asm volatile("v_cvt_pk_bf16_f32 %0, %1, %2" : "=v"(r) : "v"(lo), "v"(hi)); return r; }
typedef float f32x2 __attribute__((ext_vector_type(2)));
__device__ __forceinline__ f32x2 gelu_pk(f32x2 v) {
    const f32x2 av = __builtin_elementwise_abs(v), d = av * 0.2316418882f + 1.0f;
    f32x2 t; t.x = __builtin_amdgcn_rcpf(d.x); t.y = __builtin_amdgcn_rcpf(d.y);
    f32x2 q = t * 0.5307027145f + (-0.7265760135f); q = q * t + 0.7107068705f; q = q * t + (-0.142248368f); q = q * t + 0.127414796f; q = q * t;
    const f32x2 s = (v * v) * (-0.72134752044f);
    f32x2 e; e.x = __builtin_amdgcn_exp2f(s.x); e.y = __builtin_amdgcn_exp2f(s.y);
    const f32x2 m = v * (q * e), r = v - m;
    f32x2 o; o.x = v.x < 0.f ? m.x : r.x; o.y = v.y < 0.f ? m.y : r.y; return o;
}

template <int ACT  > struct EpiBf16 {
    static constexpr bool PERM = true, AFTER_DRAIN = false; static_assert(ACT == 0 || ACT == 1, "EpiBf16: ACT is 0 (none) or 1 (gelu_pk)");
    bf16_t* O; int ldc; const float* bias; int split_cols; size_t split_stride; float scale0;
    __device__ __forceinline__ void operator()(const f32x4 (&acc)[2][2][4][2], const Unit& u, int wr, int wc, int fr, int fq) const {
        const int row0 = u.pm * BM + wr * 64 + fr; int colt = u.pn * BM; bf16_t* base = O;
        float sc = 1.f; if (split_cols) { const int t = colt / split_cols; base += (size_t)t * split_stride; colt -= t * split_cols; if (t == 0) sc = scale0; }
        const int col0 = colt + wc * 32 + 8 * fq, bcol0 = u.pn * BM + wc * 32 + 8 * fq;
        f32x4 bv[2][2];
#pragma unroll
        for (int bj = 0; bj < 2; ++bj)
#pragma unroll
            for (int n = 0; n < 2; ++n) bv[bj][n] = bias ? *(const f32x4*)(bias + bcol0 + bj * HALF + 4 * n) : (f32x4){0.f, 0.f, 0.f, 0.f};
#pragma unroll
        for (int ai = 0; ai < 2; ++ai)
#pragma unroll
            for (int m = 0; m < 4; ++m) { bf16_t* rowp = base + (size_t)(row0 + ai * HALF + m * 16) * ldc + col0;
#pragma unroll
                for (int bj = 0; bj < 2; ++bj) { f32x4 v0 = acc[ai][bj][m][0] + bv[bj][0], v1 = acc[ai][bj][m][1] + bv[bj][1];
                    if (ACT == 1) { f32x2 a = gelu_pk((f32x2){v0[0], v0[1]}), b = gelu_pk((f32x2){v0[2], v0[3]}), c = gelu_pk((f32x2){v1[0], v1[1]}), d = gelu_pk((f32x2){v1[2], v1[3]});
                        v0 = (f32x4){a.x, a.y, b.x, b.y}; v1 = (f32x4){c.x, c.y, d.x, d.y}; }
                    v0 = v0 * sc; v1 = v1 * sc; u32x4 w; w.x = cvt_pk_bf16(v0[0], v0[1]); w.y = cvt_pk_bf16(v0[2], v0[3]); w.z = cvt_pk_bf16(v1[0], v1[1]); w.w = cvt_pk_bf16(v1[2], v1[3]);
                    *(u32x4*)(rowp + bj * HALF) = w; } }
    }
};
template <class Epi, class Sched, bool ALIGN_EPI = false, bool SP2 = false>
__device__ __forceinline__ void gemm_phase(PG8_LAS unsigned char* lds, const Gemm g, const Sched& S, const Epi& E) {
    const int tid = ltid(), wid = __builtin_amdgcn_readfirstlane(tid >> 6), lane = tid & 63, wr = wid >> 2, wc = wid & 3, fr = lane & 15, fq = lane >> 4;
    const int K = g.K, nt = K / BK;
    unsigned voffA[2], voffB[2];
#pragma unroll
    for (int i = 0; i < 2; ++i) { int R, C; stage_rc(tid * 16 + i * 8192, R, C); const int Rb = Epi::PERM ? ((R & ~31) + perm32(R & 31)) : R;
        voffA[i] = (unsigned)(R * K + C) * 2u; voffB[i] = (unsigned)(Rb * K + C) * 2u; }
    const size_t kstep = (size_t)(BK * 2);
    const size_t hstep = (size_t)HALF * K * 2;
    const size_t tstep = 2 * hstep;
    const unsigned ldsw = (unsigned)wid * 1024u;
    const int aoff = lds_byte(wr * 64 + fr, fq * 8), boff = lds_byte(wc * 32 + fr, fq * 8);
#define PG8_SA(b, h) (((b) * 2 + (h)) * HTB)
#define PG8_SB(b, h) ((4 + (b) * 2 + (h)) * HTB)
#define PG8_STAGE(bufoff, gbase, voff) do { _Pragma("unroll") for (int _i = 0; _i < 2; ++_i) \
        __builtin_amdgcn_global_load_lds((const unsigned*)((const char*)(gbase) + (voff)[_i]), (PG8_LAS unsigned*)(lds + (bufoff) + ldsw + _i * 8192), 16, 0, 0); } while (0)
#define PG8_LDA(dst, b, h) do { _Pragma("unroll") for (int m = 0; m < 4; ++m) _Pragma("unroll") for (int k = 0; k < 2; ++k) dst[m][k] = *(const PG8_LAS bf16x8*)(lds + PG8_SA(b, h) + aoff + m * 2048 + k * 1024); } while (0)
#define PG8_LDB(dst, b, h) do { _Pragma("unroll") for (int n = 0; n < 2; ++n) _Pragma("unroll") for (int k = 0; k < 2; ++k) dst[n][k] = *(const PG8_LAS bf16x8*)(lds + PG8_SB(b, h) + boff + n * 2048 + k * 1024); } while (0)
#define PG8_MMA(ai, bj, At, Bt) do { __builtin_amdgcn_s_setprio(1); _Pragma("unroll") for (int m = 0; m < 4; ++m) _Pragma("unroll") for (int n = 0; n < 2; ++n) _Pragma("unroll") for (int k = 0; k < 2; ++k) \
        acc[ai][bj][m][n] = __builtin_amdgcn_mfma_f32_16x16x32_bf16(Bt[n][k], At[m][k], acc[ai][bj][m][n], 0, 0, 0); __builtin_amdgcn_s_setprio(0); } while (0)
#define PG8_WAIT_V(n) asm volatile("s_waitcnt vmcnt(" #n ")" ::: "memory")
#define PG8_WAIT_L(n) asm volatile("s_waitcnt lgkmcnt(" #n ")" ::: "memory")
#define PG8_BAR __builtin_amdgcn_s_barrier()
#define PG8_SCHED __builtin_amdgcn_sched_barrier(0)
    Unit cur, nxt; int ui = 0;
    if (!S.next(0, cur)) return;
    f32x4 acc[2][2][4][2];
#pragma unroll
    for (int a = 0; a < 2; ++a)
#pragma unroll
        for (int b = 0; b < 2; ++b)
#pragma unroll
            for (int m = 0; m < 4; ++m)
#pragma unroll
                for (int n = 0; n < 2; ++n) acc[a][b][m][n] = (f32x4){0.f, 0.f, 0.f, 0.f};
    bf16x8 At[4][2], B0[2][2], B1[2][2];
    const char* cA = (const char*)g.A + (size_t)cur.pm * tstep; const char* cB = (const char*)g.Bt + (size_t)cur.pn * tstep;
    S.a_ready(cur);
    if constexpr (SP2) {
        PG8_STAGE(PG8_SB(0, 0), cB, voffB); PG8_STAGE(PG8_SB(0, 1), cB + hstep, voffB); PG8_STAGE(PG8_SA(0, 0), cA, voffA); PG8_STAGE(PG8_SA(0, 1), cA + hstep, voffA);
        if (wr == 1) PG8_BAR;
        PG8_WAIT_V(2); PG8_BAR;
        PG8_STAGE(PG8_SB(1, 0), cB + kstep, voffB); PG8_STAGE(PG8_SA(1, 0), cA + kstep, voffA); PG8_STAGE(PG8_SB(1, 1), cB + hstep + kstep, voffB);
        PG8_WAIT_V(6); PG8_BAR;
    } else {
        PG8_STAGE(PG8_SB(0, 0), cB, voffB); PG8_STAGE(PG8_SA(0, 0), cA, voffA); PG8_STAGE(PG8_SB(0, 1), cB + hstep, voffB); PG8_STAGE(PG8_SA(0, 1), cA + hstep, voffA);
        if (wr == 1) PG8_BAR;
        PG8_WAIT_V(4); PG8_BAR;
        PG8_STAGE(PG8_SB(1, 0), cB + kstep, voffB); PG8_STAGE(PG8_SA(1, 0), cA + kstep, voffA); PG8_STAGE(PG8_SB(1, 1), cB + hstep + kstep, voffB);
        PG8_WAIT_V(6); PG8_BAR;
    }
    for (;;) {
        const bool has_next = S.next(ui + 1, nxt);
        const unsigned pk_ = has_next ? S.peek(nxt) : 0u;
        const char* nA = has_next ? (const char*)g.A + (size_t)nxt.pm * tstep : cA; const char* nB = has_next ? (const char*)g.Bt + (size_t)nxt.pn * tstep : cB;
#pragma nounroll
        for (int t = 0; t < nt; t += 2) {
            const bool last = (t == nt - 2);
            const char* a1 = cA + (size_t)(t + 1) * kstep;
            const char* a2 = last ? nA : cA + (size_t)(t + 2) * kstep; const char* b2 = last ? nB : cB + (size_t)(t + 2) * kstep;
            const char* a3 = a2 + kstep; const char* b3 = b2 + kstep;
            if (last && has_next) S.a_ready(nxt, pk_);
            if constexpr (SP2) {
            PG8_LDB(B0, 0, 0); PG8_LDB(B1, 0, 1); PG8_SCHED; PG8_LDA(At, 0, 0); PG8_STAGE(PG8_SA(1, 1), a1 + hstep, voffA);
            PG8_WAIT_V(8); PG8_WAIT_L(0); PG8_BAR; PG8_MMA(0, 0, At, B0); PG8_MMA(0, 1, At, B1); PG8_BAR; PG8_SCHED;
            PG8_LDA(At, 0, 1); PG8_STAGE(PG8_SB(0, 0), b2, voffB); PG8_STAGE(PG8_SB(0, 1), b2 + hstep, voffB); PG8_STAGE(PG8_SA(0, 0), a2, voffA);
            PG8_WAIT_V(8); PG8_WAIT_L(0); PG8_BAR; PG8_MMA(1, 0, At, B0); PG8_MMA(1, 1, At, B1); PG8_BAR; PG8_SCHED;
            PG8_LDB(B0, 1, 0); PG8_LDB(B1, 1, 1); PG8_SCHED; PG8_LDA(At, 1, 0); PG8_STAGE(PG8_SA(0, 1), a2 + hstep, voffA);
            PG8_WAIT_V(8); PG8_WAIT_L(0); PG8_BAR; PG8_MMA(0, 0, At, B0); PG8_MMA(0, 1, At, B1); PG8_BAR; PG8_SCHED;
            PG8_LDA(At, 1, 1); PG8_STAGE(PG8_SB(1, 0), b3, voffB); PG8_STAGE(PG8_SB(1, 1), b3 + hstep, voffB); PG8_STAGE(PG8_SA(1, 0), a3, voffA);
            PG8_WAIT_V(8); PG8_WAIT_L(0); PG8_BAR; PG8_MMA(1, 0, At, B0); PG8_MMA(1, 1, At, B1); PG8_BAR; PG8_SCHED;
            } else {
            PG8_LDB(B0, 0, 0); PG8_SCHED; PG8_LDA(At, 0, 0); PG8_STAGE(PG8_SA(1, 1), a1 + hstep, voffA);
            PG8_WAIT_L(8); PG8_BAR; PG8_WAIT_L(0); PG8_MMA(0, 0, At, B0); PG8_BAR; PG8_SCHED;
            PG8_LDB(B1, 0, 1); PG8_STAGE(PG8_SB(0, 0), b2, voffB);
            PG8_BAR; PG8_WAIT_L(0); PG8_MMA(0, 1, At, B1); PG8_BAR;
            PG8_LDA(At, 0, 1); PG8_STAGE(PG8_SA(0, 0), a2, voffA);
            PG8_BAR; PG8_WAIT_L(0); PG8_MMA(1, 0, At, B0); PG8_BAR; PG8_SCHED;
            PG8_STAGE(PG8_SB(0, 1), b2 + hstep, voffB);
            PG8_WAIT_V(6); PG8_BAR; PG8_MMA(1, 1, At, B1); PG8_BAR;
            PG8_LDB(B0, 1, 0); PG8_SCHED; PG8_LDA(At, 1, 0); PG8_STAGE(PG8_SA(0, 1), a2 + hstep, voffA);
            PG8_WAIT_L(8); PG8_BAR; PG8_WAIT_L(0); PG8_MMA(0, 0, At, B0); PG8_BAR; PG8_SCHED;
            PG8_LDB(B1, 1, 1); PG8_STAGE(PG8_SB(1, 0), b3, voffB);
            PG8_BAR; PG8_WAIT_L(0); PG8_MMA(0, 1, At, B1); PG8_BAR;
            PG8_LDA(At, 1, 1); PG8_STAGE(PG8_SA(1, 0), a3, voffA);
            PG8_BAR; PG8_WAIT_L(0); PG8_MMA(1, 0, At, B0); PG8_BAR; PG8_SCHED;
            PG8_STAGE(PG8_SB(1, 1), b3 + hstep, voffB);
            PG8_WAIT_V(6); PG8_BAR; PG8_MMA(1, 1, At, B1); PG8_BAR;
            }
        }
        if constexpr (ALIGN_EPI) { if (wr == 0) PG8_BAR; }
        if constexpr (!Epi::AFTER_DRAIN) { int fr2 = fr, fq2 = fq; asm volatile("" : "+v"(fr2), "+v"(fq2)); E(acc, cur, wr, wc, fr2, fq2); S.done(cur); }
        if (!has_next) break;
#pragma unroll
        for (int a = 0; a < 2; ++a)
#pragma unroll
            for (int b = 0; b < 2; ++b)
#pragma unroll
                for (int m = 0; m < 4; ++m)
#pragma unroll
                    for (int n = 0; n < 2; ++n) acc[a][b][m][n] = (f32x4){0.f, 0.f, 0.f, 0.f};
        cur = nxt; cA = nA; cB = nB; ++ui;
        if constexpr (ALIGN_EPI) { if (wr == 1) PG8_BAR; }
    }
    PG8_WAIT_V(0);
    if constexpr (!ALIGN_EPI) { if (wr == 0) PG8_BAR; }
    PG8_BAR;
    if constexpr (Epi::AFTER_DRAIN) { E.fused(acc, cur, wr, wc, fr, fq, lds, wid, lane); S.done(cur); }
#undef PG8_SA
#undef PG8_SB
#undef PG8_STAGE
#undef PG8_LDA
#undef PG8_LDB
#undef PG8_MMA
#undef PG8_WAIT_V
#undef PG8_WAIT_L
#undef PG8_BAR
#undef PG8_SCHED
}
}

namespace pg8 {
struct EpiResF32 {
    static constexpr bool PERM = true, AFTER_DRAIN = false;
    const float* base; bf16_t* hb; int ldc;
    __device__ __forceinline__ void operator()(const f32x4 (&acc)[2][2][4][2], const Unit& u, int wr, int wc, int fr, int fq) const {
        const int row0 = u.pm * BM + wr * 64 + fr, col0 = u.pn * BM + wc * 32 + 8 * fq;
#pragma unroll
        for (int ai = 0; ai < 2; ++ai)
#pragma unroll
            for (int m = 0; m < 4; ++m) { const size_t off = (size_t)(row0 + ai * HALF + m * 16) * ldc + col0;
#pragma unroll
                for (int bj = 0; bj < 2; ++bj) { const f32x4 h0 = *(const f32x4*)(base + off + bj * HALF) + acc[ai][bj][m][0], h1 = *(const f32x4*)(base + off + bj * HALF + 4) + acc[ai][bj][m][1];
                    u32x4 w; w.x = cvt_pk_bf16(h0[0], h0[1]); w.y = cvt_pk_bf16(h0[2], h0[3]); w.z = cvt_pk_bf16(h1[0], h1[1]); w.w = cvt_pk_bf16(h1[2], h1[3]);
                    *(u32x4*)(hb + off + bj * HALF) = w; } }
    }
};

template <int NT_ = 0> struct EpiBf16LeanT {
    static constexpr bool PERM = true, AFTER_DRAIN = false;
    bf16_t* O; int ldc; int pnmask;
    __device__ __forceinline__ void operator()(const f32x4 (&acc)[2][2][4][2], const Unit& u, int wr, int wc, int fr, int fq) const {
        bf16_t* base = O + (size_t)(u.pm * BM + wr * 64 + fr) * ldc + (u.pn & pnmask) * BM + wc * 32 + 8 * fq;
#pragma unroll
        for (int ai = 0; ai < 2; ++ai)
#pragma unroll
            for (int m = 0; m < 4; ++m) { bf16_t* rowp = base + (size_t)(ai * HALF + m * 16) * ldc;
#pragma unroll
                for (int bj = 0; bj < 2; ++bj) { const f32x4 v0 = acc[ai][bj][m][0], v1 = acc[ai][bj][m][1];
                    u32x4 w; w.x = cvt_pk_bf16(v0[0], v0[1]); w.y = cvt_pk_bf16(v0[2], v0[3]); w.z = cvt_pk_bf16(v1[0], v1[1]); w.w = cvt_pk_bf16(v1[2], v1[3]);
                    if (NT_) __builtin_nontemporal_store(w, (u32x4*)(rowp + bj * HALF)); else *(u32x4*)(rowp + bj * HALF) = w; } }
    }
};
typedef EpiBf16LeanT<0> EpiBf16Lean;

template <class Epi, class Sched, bool ALIGN_EPI, bool GATHER>
__device__ __forceinline__ void gemm_phase_g(PG8_LAS unsigned char* lds, const Gemm g, const Sched& S, const Epi& E) {
    const int tid = ltid(), wid = __builtin_amdgcn_readfirstlane(tid >> 6), lane = tid & 63, wr = wid >> 2, wc = wid & 3, fr = lane & 15, fq = lane >> 4;
    const int K = g.K, nt = K / BK;
    unsigned voffB[2];
#pragma unroll
    for (int i = 0; i < 2; ++i) { int R, C; stage_rc(tid * 16 + i * 8192, R, C); const int Rb = Epi::PERM ? ((R & ~31) + perm32(R & 31)) : R; voffB[i] = (unsigned)(Rb * K + C) * 2u; }
    const size_t kstep = (size_t)(BK * 2), hstep = (size_t)HALF * K * 2, tstep = 2 * hstep;
    const unsigned ldsw = (unsigned)wid * 1024u;
    const int aoff = lds_byte(wr * 64 + fr, fq * 8), boff = lds_byte(wc * 32 + fr, fq * 8);
#define PG8_SA(b, h) (((b) * 2 + (h)) * HTB)
#define PG8_SB(b, h) ((4 + (b) * 2 + (h)) * HTB)
#define PG8_STAGE(bufoff, gbase, voff) do { _Pragma("unroll") for (int _i = 0; _i < 2; ++_i) \
        __builtin_amdgcn_global_load_lds((const unsigned*)((const char*)(gbase) + (voff)[_i]), (PG8_LAS unsigned*)(lds + (bufoff) + ldsw + _i * 8192), 16, 0, 0); } while (0)
#define PG8_LDA(dst, b, h) do { _Pragma("unroll") for (int m = 0; m < 4; ++m) _Pragma("unroll") for (int k = 0; k < 2; ++k) dst[m][k] = *(const PG8_LAS bf16x8*)(lds + PG8_SA(b, h) + aoff + m * 2048 + k * 1024); } while (0)
#define PG8_LDB(dst, b, h) do { _Pragma("unroll") for (int n = 0; n < 2; ++n) _Pragma("unroll") for (int k = 0; k < 2; ++k) dst[n][k] = *(const PG8_LAS bf16x8*)(lds + PG8_SB(b, h) + boff + n * 2048 + k * 1024); } while (0)
#define PG8_MMA(ai, bj, At, Bt) do { __builtin_amdgcn_s_setprio(1); _Pragma("unroll") for (int m = 0; m < 4; ++m) _Pragma("unroll") for (int n = 0; n < 2; ++n) _Pragma("unroll") for (int k = 0; k < 2; ++k) \
        acc[ai][bj][m][n] = __builtin_amdgcn_mfma_f32_16x16x32_bf16(Bt[n][k], At[m][k], acc[ai][bj][m][n], 0, 0, 0); __builtin_amdgcn_s_setprio(0); } while (0)
#define PG8_WAIT_V(n) asm volatile("s_waitcnt vmcnt(" #n ")" ::: "memory")
#define PG8_WAIT_L(n) asm volatile("s_waitcnt lgkmcnt(" #n ")" ::: "memory")
#define PG8_BAR __builtin_amdgcn_s_barrier()
#define PG8_SCHED __builtin_amdgcn_sched_barrier(0)
#define PG8_OFFS(u, o) do { _Pragma("unroll") for (int _h = 0; _h < 2; ++_h) _Pragma("unroll") for (int _i = 0; _i < 2; ++_i) { int R_, C_; stage_rc(tid * 16 + _i * 8192, R_, C_); \
        if constexpr (GATHER) o[_h][_i] = S.rowoff(u, _h * HALF + R_) + (unsigned)C_ * 2u; else o[_h][_i] = (unsigned)((_h * HALF + R_) * K + C_) * 2u; } } while (0)
    Unit cur, nxt; int ui = 0;
    if (!S.next(0, cur)) return;
    E.prefetch(lds, cur, 0, wid, lane);
    f32x4 acc[2][2][4][2];
#pragma unroll
    for (int a = 0; a < 2; ++a)
#pragma unroll
        for (int b = 0; b < 2; ++b)
#pragma unroll
            for (int m = 0; m < 4; ++m)
#pragma unroll
                for (int n = 0; n < 2; ++n) acc[a][b][m][n] = (f32x4){0.f, 0.f, 0.f, 0.f};
    bf16x8 At[4][2], B0[2][2], B1[2][2];
    unsigned vo[2][2], nvo[2][2];
    const char* cA = GATHER ? (const char*)g.A : (const char*)g.A + (size_t)cur.pm * tstep; const char* cB = (const char*)g.Bt + (size_t)cur.pn * tstep;
    PG8_OFFS(cur, vo);
    PG8_STAGE(PG8_SB(0, 0), cB, voffB); PG8_STAGE(PG8_SB(0, 1), cB + hstep, voffB); PG8_STAGE(PG8_SA(0, 0), cA, vo[0]); PG8_STAGE(PG8_SA(0, 1), cA, vo[1]);
    if (wr == 1) PG8_BAR;
    PG8_WAIT_V(2); PG8_BAR;
    PG8_STAGE(PG8_SB(1, 0), cB + kstep, voffB); PG8_STAGE(PG8_SA(1, 0), cA + kstep, vo[0]); PG8_STAGE(PG8_SB(1, 1), cB + hstep + kstep, voffB);
    PG8_WAIT_V(6); PG8_BAR;
    for (;;) {
        const bool has_next = S.next(ui + 1, nxt);
        const char* nA = has_next ? (GATHER ? (const char*)g.A : (const char*)g.A + (size_t)nxt.pm * tstep) : cA; const char* nB = has_next ? (const char*)g.Bt + (size_t)nxt.pn * tstep : cB;
        if constexpr (GATHER) { if (has_next) { PG8_OFFS(nxt, nvo); } else { nvo[0][0] = vo[0][0]; nvo[0][1] = vo[0][1]; nvo[1][0] = vo[1][0]; nvo[1][1] = vo[1][1]; } }
#pragma nounroll
        for (int t = 0; t < nt; t += 2) {
            const bool last = (t == nt - 2);
            const char* a1 = cA + (size_t)(t + 1) * kstep;
            const char* a2 = last ? nA : cA + (size_t)(t + 2) * kstep; const char* b2 = last ? nB : cB + (size_t)(t + 2) * kstep;
            const char* a3 = a2 + kstep; const char* b3 = b2 + kstep;
            PG8_LDB(B0, 0, 0); PG8_LDB(B1, 0, 1); PG8_SCHED; PG8_LDA(At, 0, 0); PG8_STAGE(PG8_SA(1, 1), a1, vo[1]);
            if constexpr (GATHER) { if (last) { vo[0][0] = nvo[0][0]; vo[0][1] = nvo[0][1]; vo[1][0] = nvo[1][0]; vo[1][1] = nvo[1][1]; } }
            PG8_WAIT_V(8); PG8_WAIT_L(0); PG8_BAR; PG8_MMA(0, 0, At, B0); PG8_MMA(0, 1, At, B1); PG8_BAR; PG8_SCHED;
            PG8_LDA(At, 0, 1); PG8_STAGE(PG8_SB(0, 0), b2, voffB); PG8_STAGE(PG8_SB(0, 1), b2 + hstep, voffB); PG8_STAGE(PG8_SA(0, 0), a2, vo[0]);
            PG8_WAIT_V(8); PG8_WAIT_L(0); PG8_BAR; PG8_MMA(1, 0, At, B0); PG8_MMA(1, 1, At, B1); PG8_BAR; PG8_SCHED;
            PG8_LDB(B0, 1, 0); PG8_LDB(B1, 1, 1); PG8_SCHED; PG8_LDA(At, 1, 0); PG8_STAGE(PG8_SA(0, 1), a2, vo[1]);
            PG8_WAIT_V(8); PG8_WAIT_L(0); PG8_BAR; PG8_MMA(0, 0, At, B0); PG8_MMA(0, 1, At, B1); PG8_BAR; PG8_SCHED;
            PG8_LDA(At, 1, 1); PG8_STAGE(PG8_SB(1, 0), b3, voffB); PG8_STAGE(PG8_SB(1, 1), b3 + hstep, voffB); PG8_STAGE(PG8_SA(1, 0), a3, vo[0]);
            PG8_WAIT_V(8); PG8_WAIT_L(0); PG8_BAR; PG8_MMA(1, 0, At, B0); PG8_MMA(1, 1, At, B1); PG8_BAR; PG8_SCHED;
        }
        if constexpr (ALIGN_EPI) { if (wr == 0) PG8_BAR; }
        if (has_next) E.prefetch(lds, nxt, (ui + 1) & 1, wid, lane);
        { int fr2 = fr, fq2 = fq; asm volatile("" : "+v"(fr2), "+v"(fq2)); Unit cu_ = cur; cu_.pn |= (ui & 1) << 30; E(acc, cu_, wr, wc, fr2, fq2); S.done(cur); }
        if (!has_next) break;
#pragma unroll
        for (int a = 0; a < 2; ++a)
#pragma unroll
            for (int b = 0; b < 2; ++b)
#pragma unroll
                for (int m = 0; m < 4; ++m)
#pragma unroll
                    for (int n = 0; n < 2; ++n) acc[a][b][m][n] = (f32x4){0.f, 0.f, 0.f, 0.f};
        cur = nxt; cA = nA; cB = nB; ++ui;
        if constexpr (ALIGN_EPI) { if (wr == 1) PG8_BAR; }
    }
    PG8_WAIT_V(0);
    if constexpr (!ALIGN_EPI) { if (wr == 0) PG8_BAR; }
    PG8_BAR;
#undef PG8_SA
#undef PG8_SB
#undef PG8_STAGE
#undef PG8_LDA
#undef PG8_LDB
#undef PG8_MMA
#undef PG8_WAIT_V
#undef PG8_WAIT_L
#undef PG8_BAR
#undef PG8_SCHED
#undef PG8_OFFS
}

struct MoeTab { const PG8_LAS int* ncnt; const PG8_LAS int* tbase; const PG8_LAS int* tile_e; };
struct MoeOrder {
    MoeTab tb; int sh  , ntot, G, c; const int* list; unsigned rowbytes;
    __device__ __forceinline__ bool next(int i, Unit& u) const {
        const int L = i * G + c; if (L >= (ntot << sh)) return false;
        const int pm = L >> sh, pl = L & ((1 << sh) - 1); u.pm = pm; u.pn = (tb.tile_e[pm] << sh) + pl; return true;
    }
    __device__ __forceinline__ unsigned rowoff(const Unit& u, int r) const {
        const int e = tb.tile_e[u.pm]; int pos = (u.pm - tb.tbase[e]) * BM + r; const int n = tb.ncnt[e]; pos = pos < n ? pos : n - 1;
        return (unsigned)list[(size_t)e * 32768 + pos] * rowbytes;
    }
    __device__ __forceinline__ void a_ready(const Unit&) const {}
    __device__ __forceinline__ unsigned peek(const Unit&) const { return 0u; }
    __device__ __forceinline__ void a_ready(const Unit&, unsigned) const {}
    __device__ __forceinline__ void done(const Unit&) const {}
};
struct MoeOrderP : MoeOrder {
    unsigned* ready;
    __device__ __forceinline__ void done(const Unit& u) const {
        asm volatile("s_waitcnt vmcnt(0)" ::: "memory");
        if ((threadIdx.x & 63) == 0) __hip_atomic_fetch_add(ready + 64 * u.pm, 1u, __ATOMIC_RELAXED, __HIP_MEMORY_SCOPE_AGENT);
    }
};
struct MoeOrderC : MoeOrder {
    const unsigned* ready; unsigned need; int nh, sk;
    __device__ __forceinline__ bool next(int i, Unit& u) const {
        const int nl = G - nh, heavy = c < nh, ra = heavy ? nl + c : c - nh;
        int L;
        if (heavy) L = sk * nl + i * G + ra; else L = (i < sk) ? i * nl + ra : sk * nl + (i - sk) * G + ra;
        if (L >= (ntot << sh)) return false;
        const int pm = L >> sh, pl = L & ((1 << sh) - 1); u.pm = pm; u.pn = (tb.tile_e[pm] << sh) + pl; return true;
    }
    __device__ __forceinline__ unsigned peek(const Unit& u) const {
        unsigned v = 0u; if (threadIdx.x < 64) v = __hip_atomic_load(ready + 64 * u.pm, __ATOMIC_RELAXED, __HIP_MEMORY_SCOPE_AGENT); return v;
    }
    __device__ __forceinline__ void a_ready(const Unit& u, unsigned peeked) const {
        if (threadIdx.x < 64) {
            unsigned polls = 0, pa = peeked;
            while ((unsigned)__builtin_amdgcn_readfirstlane(pa) < need) {
                if (++polls > (1u << 22)) break;
                __builtin_amdgcn_s_sleep(2); pa = __hip_atomic_load(ready + 64 * u.pm, __ATOMIC_RELAXED, __HIP_MEMORY_SCOPE_AGENT); }
        }
        asm volatile("" ::: "memory"); __builtin_amdgcn_s_barrier(); asm volatile("" ::: "memory");
    }
    __device__ __forceinline__ void a_ready(const Unit& u) const { a_ready(u, 0u); }
};
struct EpiSwiglu {
    static constexpr bool PERM = true, AFTER_DRAIN = false;
    bf16_t* HG; const float* slr; MoeTab tb;
    static constexpr int RS_OFF = 8 * HTB;
    __device__ __forceinline__ void prefetch(PG8_LAS unsigned char* lds, const Unit& u, int buf, int wid, int lane) const {
        if (wid < 4) { const int e = tb.tile_e[u.pm], ne = tb.ncnt[e]; int pos = (u.pm - tb.tbase[e]) * BM + wid * 64 + lane; pos = pos < ne ? pos : ne - 1;
            __builtin_amdgcn_global_load_lds((const unsigned*)(slr + (size_t)e * 32768 + pos), (PG8_LAS unsigned*)(lds + RS_OFF + buf * 1024 + wid * 256), 4, 0, 0); }
    }
    PG8_LAS unsigned char* lds;
    __device__ __forceinline__ void operator()(const f32x4 (&acc)[2][2][4][2], const Unit& u, int wr, int wc, int fr, int fq) const {
        const int e = tb.tile_e[u.pm], pl = u.pn & 1, ne = tb.ncnt[e], pos0 = (u.pm - tb.tbase[e]) * BM; (void)ne; (void)pos0;
        const PG8_LAS float* rsb = (const PG8_LAS float*)(lds + RS_OFF + ((u.pn >> 30) & 1) * 1024);
#pragma unroll
        for (int ai = 0; ai < 2; ++ai)
#pragma unroll
            for (int m = 0; m < 4; ++m) {
                const int r = ai * HALF + wr * 64 + m * 16 + fr;
                const float rs = rsb[r];
                bf16_t* dst = HG + (size_t)(u.pm * BM + r) * 256 + pl * 128 + wc * 32 + 8 * fq;
                u32x4 w;
#pragma unroll
                for (int n = 0; n < 2; ++n) { const f32x4 gt = acc[ai][0][m][n] * rs, up = acc[ai][1][m][n] * rs; float hv[4];
#pragma unroll
                    for (int j = 0; j < 4; ++j) hv[j] = gt[j] * __builtin_amdgcn_rcpf(1.0f + __expf(-gt[j])) * up[j];
                    w[2 * n] = cvt_pk_bf16(hv[0], hv[1]); w[2 * n + 1] = cvt_pk_bf16(hv[2], hv[3]); }
                asm volatile("global_store_dwordx4 %0, %1, off sc1\n\ts_nop 1" :: "v"(dst), "v"(w) : "memory");
            }
    }
};
}
#define LASP __attribute__((address_space(3)))
constexpr int T16_N = 177, AL_T16 = 135168 + 4096;
constexpr int RING_BYTES = 135168, LDS_CTL_OFF = RING_BYTES, LDS_TOTAL = RING_BYTES + 4096 + 4 * T16_N * 16;
constexpr int LC_NCNT = 16, LC_TBASE = 48, LC_TILE_E = 96, LC_LCNT = 448, LC_GBASE = 480;

__device__ __forceinline__ unsigned pk2bf(float lo, float hi) { return (unsigned)f2bf(lo) | ((unsigned)f2bf(hi) << 16); }
__device__ __forceinline__ void tr_item(const float* __restrict__ W, int K, int ldw, int nsrc, const float* __restrict__ gk, bf16_t* dst, int k0, int n0, int lane) {
    const int n = n0 + lane; const bool ok = n < nsrc;
    const float* src = W + (size_t)k0 * ldw + (ok ? n : 0);
    float v[32];
#pragma unroll
    for (int i = 0; i < 32; ++i) v[i] = src[(size_t)i * ldw];
    if (gk) {
#pragma unroll
        for (int i = 0; i < 32; ++i) v[i] *= gk[k0 + i];
    }
    uint4* o = (uint4*)(dst + (size_t)lane * K + k0);
#pragma unroll
    for (int c = 0; c < 4; ++c) { uint4 w; w.x = pk2bf(v[8 * c], v[8 * c + 1]); w.y = pk2bf(v[8 * c + 2], v[8 * c + 3]); w.z = pk2bf(v[8 * c + 4], v[8 * c + 5]); w.w = pk2bf(v[8 * c + 6], v[8 * c + 7]);
        if (!ok) w = make_uint4(0u, 0u, 0u, 0u); o[c] = w; }
}
__device__ void f_expert_weights(const P& p, int bid, int nb) {
    const int tid = ltid(), wave = tid >> 6, lane = tid & 63;
    bf16_t* W13 = (bf16_t*)(p.ws + OFF_W13_T); bf16_t* WD = (bf16_t*)(p.ws + OFF_WD_T);
    constexpr int I_EXP = 32 * 128;
    for (int it = bid * 8 + wave; it < 3 * I_EXP; it += nb * 8) {
        int r = it;
        if (r < 2 * I_EXP) { const int up = r >= I_EXP; if (up) r -= I_EXP; const int e = r >> 7, q = r & 127, kb = q >> 2, nbk = q & 3, n0 = 64 * nbk;
            const float* src = (up ? p.w_up : p.w_gate) + (size_t)e * D_MODEL * EXP_FF;
            tr_item(src, D_MODEL, EXP_FF, EXP_FF, p.ln_ffn, W13 + ((size_t)e * 512 + 256 * (n0 >> 7) + 128 * up + (n0 & 127)) * D_MODEL, 32 * kb, n0, lane); }
        else { r -= 2 * I_EXP; const int e = r >> 7, q = r & 127, kb = q >> 4, nbk = q & 15, n0 = 64 * nbk;
            tr_item(p.w_down + (size_t)e * EXP_FF * D_MODEL, EXP_FF, D_MODEL, D_MODEL, nullptr, WD + ((size_t)e * D_MODEL + n0) * EXP_FF, 32 * kb, n0, lane); }
    }
}
constexpr int EW_ITEMS = 3 * 32 * 128;
__device__ __forceinline__ void ew_load(const P& p, int it, int lane, float (&v)[32]) {
    constexpr int I_EXP = 32 * 128;
    const float* src; int ldw;
    if (it < 2 * I_EXP) { const int up = it >= I_EXP; const int r = it - up * I_EXP; const int e = r >> 7, q = r & 127, kb = q >> 2, nbk = q & 3;
        src = (up ? p.w_up : p.w_gate) + (size_t)e * D_MODEL * EXP_FF + (size_t)(32 * kb) * EXP_FF + 64 * nbk + lane; ldw = EXP_FF; }
    else { const int r = it - 2 * I_EXP; const int e = r >> 7, q = r & 127, kb = q >> 4, nbk = q & 15;
        src = p.w_down + (size_t)e * EXP_FF * D_MODEL + (size_t)(32 * kb) * D_MODEL + 64 * nbk + lane; ldw = D_MODEL; }
#pragma unroll
    for (int i = 0; i < 32; ++i) v[i] = src[(size_t)i * ldw];
}
__device__ __forceinline__ void ew_store(const P& p, int it, int lane, float (&v)[32]) {
    constexpr int I_EXP = 32 * 128;
    bf16_t* W13 = (bf16_t*)(p.ws + OFF_W13_T); bf16_t* WD = (bf16_t*)(p.ws + OFF_WD_T);
    bf16_t* dst;
    if (it < 2 * I_EXP) { const int up = it >= I_EXP; const int r = it - up * I_EXP; const int e = r >> 7, q = r & 127, kb = q >> 2, nbk = q & 3, n0 = 64 * nbk;
        const float* gk = p.ln_ffn + 32 * kb;
#pragma unroll
        for (int i = 0; i < 32; ++i) v[i] *= gk[i];
        dst = W13 + ((size_t)e * 512 + 256 * (n0 >> 7) + 128 * up + (n0 & 127) + lane) * D_MODEL + 32 * kb; }
    else { const int r = it - 2 * I_EXP; const int e = r >> 7, q = r & 127, kb = q >> 4, nbk = q & 15;
        dst = WD + ((size_t)e * D_MODEL + 64 * nbk + lane) * EXP_FF + 32 * kb; }
    pg8::u32x4* o = (pg8::u32x4*)dst;
#pragma unroll
    for (int c = 0; c < 4; ++c) { pg8::u32x4 w; w.x = pg8::cvt_pk_bf16(v[8 * c], v[8 * c + 1]); w.y = pg8::cvt_pk_bf16(v[8 * c + 2], v[8 * c + 3]); w.z = pg8::cvt_pk_bf16(v[8 * c + 4], v[8 * c + 5]); w.w = pg8::cvt_pk_bf16(v[8 * c + 6], v[8 * c + 7]); o[c] = w; }
}
__device__ void f_prologue(const P& p, int bid, int nb, float* sm) {
    const int tid = ltid(), wave = tid >> 6, lane = tid & 63;
    const int gw = bid * 8 + wave, ngw = nb * 8;
    bf16_t* WIN_T = (bf16_t*)(p.ws + OFF_WIN_T); bf16_t* WOUT_T = (bf16_t*)(p.ws + OFF_WOUT_T);
    constexpr int I_IN = 32 * (LDU / 64), I_OUT = 32 * 16;
    for (int it = gw; it < I_IN + I_OUT; it += ngw) {
        if (it < I_IN) { const int kb = it / (LDU / 64), nbk = it % (LDU / 64); tr_item(p.w_in, D_MODEL, D_IN, D_IN, p.ln_mix, WIN_T + (size_t)(64 * nbk) * D_MODEL, 32 * kb, 64 * nbk, lane); }
        else { const int r = it - I_IN, kb = r >> 4, nbk = r & 15; tr_item(p.w_out, D_MODEL, D_MODEL, D_MODEL, nullptr, WOUT_T + (size_t)(64 * nbk) * D_MODEL, 32 * kb, 64 * nbk, lane); }
    }
    { bf16_t* W1T = (bf16_t*)(p.ws + OFF_W1T); bf16_t* W2T = (bf16_t*)(p.ws + OFF_W2T); float* B1 = (float*)(p.ws + OFF_B1);
      for (int it = gw; it < 2 * 128 + 2 * 4; it += ngw) {
          if (it < 256) { const int kv = it >> 7, q = it & 127, kb = q >> 1, nbk = q & 1;
              const float* src = (kv ? p.cv1 : p.ck1) + (size_t)(32 * kb) * 128 + 64 * nbk + lane; const int n = 64 * nbk + lane;
              float v[32];
#pragma unroll
              for (int i = 0; i < 32; ++i) v[i] = src[(size_t)i * 128];
#pragma unroll
              for (int c = 0; c < 4; ++c) { const int k = 32 * kb + 8 * c; uint4 w; w.x = pk2bf(v[8 * c], v[8 * c + 1]); w.y = pk2bf(v[8 * c + 2], v[8 * c + 3]); w.z = pk2bf(v[8 * c + 4], v[8 * c + 5]); w.w = pk2bf(v[8 * c + 6], v[8 * c + 7]);
                  *(uint4*)(W1T + (size_t)kv * 128 * 2048 + (size_t)(((((n >> 5) * 128 + (k >> 4)) * 2 + ((k >> 3) & 1)) * 32 + (n & 31)) * 8)) = w; } }
          else { const int r = it - 256, kv = r >> 2, kb = r & 3; tr_item(kv ? p.cv2 : p.ck2, 128, 64, 64, nullptr, W2T + (size_t)kv * 64 * 128, 32 * kb, 0, lane); }
      }
      for (int o = gw; o < 256; o += ngw) { const int kv = o >> 7, n = o & 127; const float* w1 = kv ? p.cv1 : p.ck1; const float* pos = kv ? p.pos_v : p.pos_k;
          float a = 0.f; for (int k = lane; k < 2048; k += 64) a = fmaf(pos[k], w1[(size_t)k * 128 + n], a);
          a = wave_sum(a); if (lane == 0) B1[o] = a; } }
    { bf16_t* RH = (bf16_t*)(p.ws + OFF_RW_HI); bf16_t* RL = (bf16_t*)(p.ws + OFF_RW_LO);
      for (int i = bid * NT + tid; i < 48 * 1024; i += nb * NT) { const int c = i >> 10, k = i & 1023;
          const float w = (c < 4 ? p.wg[k * 4 + c] : (c < 36 ? p.we[k * 32 + (c - 4)] : 0.f)) * p.ln_ffn[k];
          const bf16_t hi = f2bf(w); RH[i] = hi; RL[i] = f2bf(w - bf2f(hi)); } }
    bf16_t* XN = (bf16_t*)(p.ws + OFF_XN);
    for (int row = gw; row < T_TOK; row += ngw) {
        const float4* xr = (const float4*)(p.x + (size_t)row * D_MODEL) + lane;
        float4 v[4]; float s = 0.f;
#pragma unroll
        for (int j = 0; j < 4; ++j) { const pg8::f32x4 t_ = __builtin_nontemporal_load((const pg8::f32x4*)(xr + 64 * j)); v[j] = make_float4(t_[0], t_[1], t_[2], t_[3]); s += (v[j].x * v[j].x + v[j].y * v[j].y) + (v[j].z * v[j].z + v[j].w * v[j].w); }
        const float rs = 1.0f / sqrtf(wave_sum(s) * (1.0f / D_MODEL) + EPS);
        uint2* o8 = (uint2*)(XN + (size_t)row * D_MODEL) + lane;
#pragma unroll
        for (int j = 0; j < 4; ++j) o8[64 * j] = make_uint2(pk2bf(v[j].x * rs, v[j].y * rs), pk2bf(v[j].z * rs, v[j].w * rs));
    }
    float* biasd = (float*)(p.ws + OFF_BIASD);
    for (int i = bid * NT + tid; i < 16 * 2048; i += nb * NT) { const int h = i >> 11, d = i & 2047; biasd[i] = p.rel_bias[t5_bucket(d) * 16 + h]; }
    bf16_t* kc = (bf16_t*)(p.ws + OFF_KCMP); bf16_t* vc = (bf16_t*)(p.ws + OFF_VCMP);
    for (int i = bid * NT + tid; i < 32 * 64; i += nb * NT) { const int bg = i >> 6, d = i & 63; kc[(bg * 128 + 127) * 64 + d] = 0; vc[(bg * 128 + 127) * 64 + d] = 0; }
}

typedef short bf16x8_t __attribute__((ext_vector_type(8)));
typedef float f32x4_t __attribute__((ext_vector_type(4)));
typedef float f32x2_t __attribute__((ext_vector_type(2)));
typedef float f32x16_t __attribute__((ext_vector_type(16)));
typedef short v4i16_t __attribute__((ext_vector_type(4)));
#define MFMA32(a, b, c) __builtin_amdgcn_mfma_f32_32x32x16_bf16(a, b, c, 0, 0, 0)
constexpr int SLOT_V = 8192, SLOT_BYTES = 16384, NSLOT = 3;
constexpr int AL_RING = 0, AL_TAB = NSLOT * SLOT_BYTES, AL_SEL = AL_TAB + 2048, AL_TAB4 = AL_SEL + 512, T4_N = 257, T4_OFF = 64, AL_IMP = AL_TAB4 + 4 * T4_N * 16;
constexpr float LOG2E = 1.4426950408889634f, NEG_BIG = -1.0e30f;
typedef unsigned u32x4_t __attribute__((ext_vector_type(4)));
__device__ __forceinline__ void dma_tile(const bf16_t* k0, const bf16_t* v0, int pitch, LASP unsigned char* slot, int wave, int lane) {
    const bf16_t* ks = k0 + (size_t)(8 * wave + (lane >> 3)) * pitch + (((lane & 7) ^ ((4 * wave + (lane >> 4)) & 7)) * 8);
    const bf16_t* vs = v0 + (size_t)(16 * (wave & 3) + (lane >> 2)) * pitch + (wave >> 2) * 32 + (lane & 3) * 8;
    __builtin_amdgcn_global_load_lds((const unsigned*)ks, (LASP unsigned*)(slot + wave * 1024), 16, 0, 0);
    __builtin_amdgcn_global_load_lds((const unsigned*)vs, (LASP unsigned*)(slot + SLOT_V + wave * 1024), 16, 0, 0);
}
__device__ __forceinline__ void glds16(const void* gsrc, unsigned lds_dst) { unsigned keep;
    asm volatile("s_mov_b32 %0, m0\n\ts_mov_b32 m0, %2\n\ts_nop 0\n\tglobal_load_lds_dwordx4 %1, off\n\ts_mov_b32 m0, %0" : "=&s"(keep) : "v"(gsrc), "s"(lds_dst) : "memory"); }
__device__ __forceinline__ void dma_k(const bf16_t* k0, int pitch, unsigned slot, int wave, int lane) { glds16(k0 + (size_t)(8 * wave + (lane >> 3)) * pitch + (((lane & 7) ^ ((4 * wave + (lane >> 4)) & 7)) * 8), (unsigned)__builtin_amdgcn_readfirstlane(slot + wave * 1024)); }
__device__ __forceinline__ void dma_v(const bf16_t* v0, int pitch, unsigned slot, int wave, int lane) { glds16(v0 + (size_t)(16 * (wave & 3) + (lane >> 2)) * pitch + (wave >> 2) * 32 + (lane & 3) * 8, (unsigned)__builtin_amdgcn_readfirstlane(slot + SLOT_V + wave * 1024)); }
#define DMA_WAIT_BAR(N) asm volatile("s_waitcnt vmcnt(" #N ") lgkmcnt(0)\n\ts_barrier" ::: "memory")
#define KRD(dst, ka, off) asm volatile("ds_read_b128 %0, %1 offset:%2" : "=&v"(dst) : "v"(ka), "i"(off) : "memory")
#define LGKM_WAIT2(n, a, b) asm volatile("s_waitcnt lgkmcnt(" #n ")" : "+v"(a), "+v"(b) :: "memory")
#define KFRAG_OFF(r32, h) ((r32) * 128 + (((((r32) >> 1) & 6) << 4) | ((((h) ^ ((r32) >> 1)) & 1) << 4)))
template <int NS, int S0>
__device__ __forceinline__ void qk_tile(f32x16_t& p0, f32x16_t& p1, float init, const LASP unsigned char* kt, const bf16x8_t* q, int r32, int h) {
    const unsigned ka = (unsigned)(uintptr_t)kt + (unsigned)KFRAG_OFF(r32, h);
    bf16x8_t a0[NS], a1[NS];
    { const unsigned k0_ = ka ^ ((S0 + 0) << 5), k1_ = ka ^ ((S0 + 1) << 5); KRD(a0[0], k0_, 0); KRD(a1[0], k0_, 4096); KRD(a0[1], k1_, 0); KRD(a1[1], k1_, 4096); }
    if constexpr (NS == 4) { const unsigned k2_ = ka ^ ((S0 + 2) << 5), k3_ = ka ^ ((S0 + 3) << 5); KRD(a0[2], k2_, 0); KRD(a1[2], k2_, 4096); KRD(a0[3], k3_, 0); KRD(a1[3], k3_, 4096); }
    { const f32x16_t iv = {init, init, init, init, init, init, init, init, init, init, init, init, init, init, init, init}; p0 = iv; p1 = iv; }
    if constexpr (NS == 4) {
        LGKM_WAIT2(6, a0[0], a1[0]); p0 = MFMA32(a0[0], q[0], p0); p1 = MFMA32(a1[0], q[0], p1);
        LGKM_WAIT2(4, a0[1], a1[1]); p0 = MFMA32(a0[1], q[1], p0); p1 = MFMA32(a1[1], q[1], p1);
        LGKM_WAIT2(2, a0[2], a1[2]); p0 = MFMA32(a0[2], q[2], p0); p1 = MFMA32(a1[2], q[2], p1);
        LGKM_WAIT2(0, a0[3], a1[3]); p0 = MFMA32(a0[3], q[3], p0); p1 = MFMA32(a1[3], q[3], p1);
    } else {
        LGKM_WAIT2(2, a0[0], a1[0]); p0 = MFMA32(a0[0], q[0], p0); p1 = MFMA32(a1[0], q[0], p1);
        LGKM_WAIT2(0, a0[1], a1[1]); p0 = MFMA32(a0[1], q[1], p0); p1 = MFMA32(a1[1], q[1], p1);
    }
}
__device__ __forceinline__ void xf_gen(f32x16_t& p0, f32x16_t& p1, int dqh, unsigned wlim, const LASP float* tab) {
#pragma unroll
    for (int g4 = 0; g4 < 4; ++g4) {
        float b0[4], b1[4];
#pragma unroll
        for (int i = 0; i < 4; ++i) { const int kk = i + 8 * g4; const unsigned d0 = (unsigned)(dqh - kk), d1 = (unsigned)(dqh - kk - 32); b0[i] = tab[d0 < 127u ? d0 : 127u]; b1[i] = tab[d1 < 127u ? d1 : 127u]; }
#pragma unroll
        for (int i = 0; i < 4; ++i) { const int r = 4 * g4 + i, kk = i + 8 * g4; const unsigned d0 = (unsigned)(dqh - kk), d1 = (unsigned)(dqh - kk - 32);
            const float s0 = p0[r] + b0[i], s1 = p1[r] + b1[i]; p0[r] = d0 < wlim ? s0 : NEG_BIG; p1[r] = d1 < wlim ? s1 : NEG_BIG; }
        __builtin_amdgcn_sched_barrier(0);
    }
}
template <bool MASK>
__device__ __forceinline__ void xf4(f32x16_t& p0, f32x16_t& p1, int dqh, unsigned wlim, const LASP f32x4_t* tab4) {
    const LASP f32x4_t* tq = tab4 + ((dqh < -8 ? -8 : (dqh > 192 ? 192 : dqh)) + T4_OFF - 56);
#pragma unroll
    for (int G = 0; G < 4; ++G) {
        const int D0 = dqh - 8 * G, D1 = D0 - 32;
        const f32x4_t e0 = tq[56 - 8 * G], e1 = tq[24 - 8 * G];
        if (MASK) { _Pragma("unroll") for (int i = 0; i < 4; ++i) { const int r = 4 * G + i; const float s0 = p0[r] + e0[i], s1 = p1[r] + e1[i];
            p0[r] = (unsigned)(D0 - i) < wlim ? s0 : NEG_BIG; p1[r] = (unsigned)(D1 - i) < wlim ? s1 : NEG_BIG; } }
        else { const f32x4_t u0 = (f32x4_t){p0[4 * G], p0[4 * G + 1], p0[4 * G + 2], p0[4 * G + 3]} + e0, u1 = (f32x4_t){p1[4 * G], p1[4 * G + 1], p1[4 * G + 2], p1[4 * G + 3]} + e1;
            _Pragma("unroll") for (int i = 0; i < 4; ++i) { p0[4 * G + i] = u0[i]; p1[4 * G + i] = u1[i]; } }
        if (G & 1) __builtin_amdgcn_sched_barrier(0);
    }
}
__device__ __forceinline__ void xf4b(f32x16_t& p0, f32x16_t& p1, int dqh, const LASP f32x4_t* tab4) {
    const LASP f32x4_t* tq = tab4 + ((dqh < -8 ? -8 : (dqh > 192 ? 192 : dqh)) + T4_OFF - 56);
#pragma unroll
    for (int G = 0; G < 4; ++G) {
        const int D0 = dqh - 8 * G, D1 = D0 - 32;
        const f32x4_t e0 = tq[56 - 8 * G], e1 = tq[24 - 8 * G];
        const f32x4_t u0 = (f32x4_t){p0[4 * G], p0[4 * G + 1], p0[4 * G + 2], p0[4 * G + 3]} + e0, u1 = (f32x4_t){p1[4 * G], p1[4 * G + 1], p1[4 * G + 2], p1[4 * G + 3]} + e1;
#pragma unroll
        for (int i = 0; i < 4; ++i) { p0[4 * G + i] = u0[i]; p1[4 * G + i] = u1[i]; }
    }
}
template <bool MASK>
__device__ __forceinline__ void xf4_2(f32x16_t& a0, f32x16_t& a1, f32x16_t& b0, f32x16_t& b1, int dqh, const LASP f32x4_t* tab4) {
    const LASP f32x4_t* tq = tab4 + ((dqh < -8 ? -8 : (dqh > 192 ? 192 : dqh)) + T4_OFF - 56);
#pragma unroll
    for (int G = 0; G < 4; ++G) {
        const int D0 = dqh - 8 * G, D1 = D0 - 32;
        const f32x4_t e0 = tq[56 - 8 * G], e1 = tq[24 - 8 * G];
        if (MASK) { _Pragma("unroll") for (int i = 0; i < 4; ++i) { const int r = 4 * G + i; const bool v0 = (D0 - i) >= 0, v1 = (D1 - i) >= 0;
            const float sa0 = a0[r] + e0[i], sa1 = a1[r] + e1[i], sb0 = b0[r] + e0[i], sb1 = b1[r] + e1[i];
            a0[r] = v0 ? sa0 : NEG_BIG; a1[r] = v1 ? sa1 : NEG_BIG; b0[r] = v0 ? sb0 : NEG_BIG; b1[r] = v1 ? sb1 : NEG_BIG; } }
        else { const f32x4_t ua0 = (f32x4_t){a0[4 * G], a0[4 * G + 1], a0[4 * G + 2], a0[4 * G + 3]} + e0, ua1 = (f32x4_t){a1[4 * G], a1[4 * G + 1], a1[4 * G + 2], a1[4 * G + 3]} + e1;
            const f32x4_t ub0 = (f32x4_t){b0[4 * G], b0[4 * G + 1], b0[4 * G + 2], b0[4 * G + 3]} + e0, ub1 = (f32x4_t){b1[4 * G], b1[4 * G + 1], b1[4 * G + 2], b1[4 * G + 3]} + e1;
            _Pragma("unroll") for (int i = 0; i < 4; ++i) { a0[4 * G + i] = ua0[i]; a1[4 * G + i] = ua1[i]; b0[4 * G + i] = ub0[i]; b1[4 * G + i] = ub1[i]; } }
        if (G & 1) __builtin_amdgcn_sched_barrier(0);
    }
}
__device__ __forceinline__ void t16_fill(LASP f32x4_t* t16, const LASP float* tab, int idx) {
    const int D = idx - 1; f32x4_t e;
#pragma unroll
    for (int i = 0; i < 4; ++i) { const int d = D - 16 * i; e[i] = d < 0 ? NEG_BIG : tab[d > 127 ? 127 : d]; }
    t16[idx] = e;
}
__device__ __forceinline__ void t4_fill(LASP f32x4_t* t4, const LASP float* tab, int idx) {
    const int D = idx - T4_OFF; f32x4_t e;
#pragma unroll
    for (int i = 0; i < 4; ++i) { const int d = D - i; e[i] = d < 0 ? NEG_BIG : tab[d > 127 ? 127 : d]; }
    t4[idx] = e;
}
__device__ __forceinline__ float max16(const f32x16_t& a) {
    float m0 = fmaxf(fmaxf(a[0], a[1]), a[2]), m1 = fmaxf(fmaxf(a[3], a[4]), a[5]), m2 = fmaxf(fmaxf(a[6], a[7]), a[8]), m3 = fmaxf(fmaxf(a[9], a[10]), a[11]);
    m0 = fmaxf(fmaxf(m0, a[12]), a[13]); m1 = fmaxf(fmaxf(m1, a[14]), a[15]);
    return fmaxf(fmaxf(m0, m1), fmaxf(m2, m3));
}
__device__ __forceinline__ float sum16(const f32x16_t& a) { return ((a[0] + a[1]) + (a[2] + a[3])) + ((a[4] + a[5]) + (a[6] + a[7])) + (((a[8] + a[9]) + (a[10] + a[11])) + ((a[12] + a[13]) + (a[14] + a[15]))); }
__device__ __forceinline__ bf16x8_t pack8(const f32x16_t& a, int b) {
    u32x4_t w; w[0] = pg8::cvt_pk_bf16(a[b], a[b + 1]); w[1] = pg8::cvt_pk_bf16(a[b + 2], a[b + 3]); w[2] = pg8::cvt_pk_bf16(a[b + 4], a[b + 5]); w[3] = pg8::cvt_pk_bf16(a[b + 6], a[b + 7]);
    return __builtin_bit_cast(bf16x8_t, w);
}
constexpr float SM_THR = 8.0f;
struct AttnSt { float m, l; f32x16_t o[2]; };
__device__ __forceinline__ void st_init(AttnSt& s, float m0) { s.m = m0 + SM_THR; s.l = 0.f;     const f32x16_t z = {0.f, 0.f, 0.f, 0.f, 0.f, 0.f, 0.f, 0.f, 0.f, 0.f, 0.f, 0.f, 0.f, 0.f, 0.f, 0.f}; s.o[0] = z; s.o[1] = z; }
#define TRRD(dst, va, off) asm volatile("ds_read_b64_tr_b16 %0, %1 offset:%2" : "=&v"(dst) : "v"(va), "i"(off) : "memory")
#define LGKM_WAIT4(n, a, b, c, d, e, f, g, hh) asm volatile("s_waitcnt lgkmcnt(" #n ")" : "+v"(a), "+v"(b), "+v"(c), "+v"(d), "+v"(e), "+v"(f), "+v"(g), "+v"(hh) :: "memory")
#define VFRAG(l, hgh) ((bf16x8_t){l[0], l[1], l[2], l[3], hgh[0], hgh[1], hgh[2], hgh[3]})
__device__ __forceinline__ void pv_tile(f32x16_t (&o)[2], const LASP unsigned char* vb, const bf16x8_t (&pf)[4]) {
    const unsigned va = (unsigned)(uintptr_t)vb;
    v4i16_t l0[4], h0[4], l1[4], h1[4];
    TRRD(l0[0], va, 0); TRRD(h0[0], va, 512); TRRD(l1[0], va, 4096); TRRD(h1[0], va, 4608); TRRD(l0[1], va, 1024); TRRD(h0[1], va, 1536); TRRD(l1[1], va, 5120); TRRD(h1[1], va, 5632);
    TRRD(l0[2], va, 2048); TRRD(h0[2], va, 2560); TRRD(l1[2], va, 6144); TRRD(h1[2], va, 6656); TRRD(l0[3], va, 3072); TRRD(h0[3], va, 3584); TRRD(l1[3], va, 7168); TRRD(h1[3], va, 7680);
    LGKM_WAIT4(8, l0[0], h0[0], l1[0], h1[0], l0[1], h0[1], l1[1], h1[1]);
    o[0] = MFMA32(VFRAG(l0[0], h0[0]), pf[0], o[0]); o[1] = MFMA32(VFRAG(l1[0], h1[0]), pf[0], o[1]);
    o[0] = MFMA32(VFRAG(l0[1], h0[1]), pf[1], o[0]); o[1] = MFMA32(VFRAG(l1[1], h1[1]), pf[1], o[1]);
    LGKM_WAIT4(0, l0[2], h0[2], l1[2], h1[2], l0[3], h0[3], l1[3], h1[3]);
    o[0] = MFMA32(VFRAG(l0[2], h0[2]), pf[2], o[0]); o[1] = MFMA32(VFRAG(l1[2], h1[2]), pf[2], o[1]);
    o[0] = MFMA32(VFRAG(l0[3], h0[3]), pf[3], o[0]); o[1] = MFMA32(VFRAG(l1[3], h1[3]), pf[3], o[1]);
}
struct VFr1 { v4i16_t l0[4], h0[4], l1[4], h1[4]; };
__device__ __forceinline__ void pv_read1(VFr1& f, const LASP unsigned char* vb) {
    const unsigned va = (unsigned)(uintptr_t)vb;
    TRRD(f.l0[0], va, 0); TRRD(f.h0[0], va, 512); TRRD(f.l1[0], va, 4096); TRRD(f.h1[0], va, 4608); TRRD(f.l0[1], va, 1024); TRRD(f.h0[1], va, 1536); TRRD(f.l1[1], va, 5120); TRRD(f.h1[1], va, 5632);
    TRRD(f.l0[2], va, 2048); TRRD(f.h0[2], va, 2560); TRRD(f.l1[2], va, 6144); TRRD(f.h1[2], va, 6656); TRRD(f.l0[3], va, 3072); TRRD(f.h0[3], va, 3584); TRRD(f.l1[3], va, 7168); TRRD(f.h1[3], va, 7680);
}
__device__ __forceinline__ void pv_mma1(f32x16_t (&o)[2], VFr1& f, const bf16x8_t (&pf)[4]) {
    LGKM_WAIT4(8, f.l0[0], f.h0[0], f.l1[0], f.h1[0], f.l0[1], f.h0[1], f.l1[1], f.h1[1]);
    o[0] = MFMA32(VFRAG(f.l0[0], f.h0[0]), pf[0], o[0]); o[1] = MFMA32(VFRAG(f.l1[0], f.h1[0]), pf[0], o[1]);
    o[0] = MFMA32(VFRAG(f.l0[1], f.h0[1]), pf[1], o[0]); o[1] = MFMA32(VFRAG(f.l1[1], f.h1[1]), pf[1], o[1]);
    LGKM_WAIT4(0, f.l0[2], f.h0[2], f.l1[2], f.h1[2], f.l0[3], f.h0[3], f.l1[3], f.h1[3]);
    o[0] = MFMA32(VFRAG(f.l0[2], f.h0[2]), pf[2], o[0]); o[1] = MFMA32(VFRAG(f.l1[2], f.h1[2]), pf[2], o[1]);
    o[0] = MFMA32(VFRAG(f.l0[3], f.h0[3]), pf[3], o[0]); o[1] = MFMA32(VFRAG(f.l1[3], f.h1[3]), pf[3], o[1]);
}
__device__ __forceinline__ void pv_tile2(f32x16_t (&oa)[2], f32x16_t (&ob)[2], const LASP unsigned char* vb, const bf16x8_t (&pfa)[4], const bf16x8_t (&pfb)[4]) {
    const unsigned va = (unsigned)(uintptr_t)vb;
    v4i16_t l0[4], h0[4], l1[4], h1[4];
    TRRD(l0[0], va, 0); TRRD(h0[0], va, 512); TRRD(l0[1], va, 1024); TRRD(h0[1], va, 1536); TRRD(l0[2], va, 2048); TRRD(h0[2], va, 2560); TRRD(l0[3], va, 3072); TRRD(h0[3], va, 3584);
    TRRD(l1[0], va, 4096); TRRD(h1[0], va, 4608); TRRD(l1[1], va, 5120); TRRD(h1[1], va, 5632); TRRD(l1[2], va, 6144); TRRD(h1[2], va, 6656); TRRD(l1[3], va, 7168); TRRD(h1[3], va, 7680);
    LGKM_WAIT4(8, l0[0], h0[0], l0[1], h0[1], l0[2], h0[2], l0[3], h0[3]);
#pragma unroll
    for (int ks = 0; ks < 4; ++ks) { const bf16x8_t a = VFRAG(l0[ks], h0[ks]); oa[0] = MFMA32(a, pfa[ks], oa[0]); ob[0] = MFMA32(a, pfb[ks], ob[0]); }
    LGKM_WAIT4(0, l1[0], h1[0], l1[1], h1[1], l1[2], h1[2], l1[3], h1[3]);
#pragma unroll
    for (int ks = 0; ks < 4; ++ks) { const bf16x8_t a = VFRAG(l1[ks], h1[ks]); oa[1] = MFMA32(a, pfa[ks], oa[1]); ob[1] = MFMA32(a, pfb[ks], ob[1]); }
}
template <bool MASKQ>
__device__ __forceinline__ void sm_pv(AttnSt& st, f32x16_t& p0, f32x16_t& p1, const LASP unsigned char* vb, bool sel) {
    float mx = pl32_max(fmaxf(max16(p0), max16(p1)));
    if (MASKQ) mx = sel ? mx : NEG_BIG;
    if (__any(mx > SM_THR)) {
        const float d = mx > SM_THR ? mx : 0.f, f = __builtin_amdgcn_exp2f(-d);
        st.m += d; st.l *= f;
#pragma unroll
        for (int r = 0; r < 16; ++r) { st.o[0][r] *= f; st.o[1][r] *= f; p0[r] -= d; p1[r] -= d; }
    }
#pragma unroll
    for (int r = 0; r < 16; ++r) { p0[r] = __builtin_amdgcn_exp2f(p0[r]); p1[r] = __builtin_amdgcn_exp2f(p1[r]); }
    float rs = sum16(p0) + sum16(p1);
    if (MASKQ) rs = sel ? rs : 0.f;
    st.l += rs;
    bf16x8_t pf[4]; pf[0] = pack8(p0, 0); pf[1] = pack8(p0, 8); pf[2] = pack8(p1, 0); pf[3] = pack8(p1, 8);
    if (MASKQ) {
#pragma unroll
        for (int k = 0; k < 4; ++k) { u32x4_t w = __builtin_bit_cast(u32x4_t, pf[k]); w[0] = sel ? w[0] : 0u; w[1] = sel ? w[1] : 0u; w[2] = sel ? w[2] : 0u; w[3] = sel ? w[3] : 0u; pf[k] = __builtin_bit_cast(bf16x8_t, w); }
    }
    pv_tile(st.o, vb, pf);
}
__device__ __forceinline__ void sm_only(AttnSt& st, f32x16_t& p0, f32x16_t& p1, bf16x8_t (&pf)[4]) {
    const float mx = pl32_max(fmaxf(max16(p0), max16(p1)));
    if (__any(mx > SM_THR)) {
        const float d = mx > SM_THR ? mx : 0.f, f = __builtin_amdgcn_exp2f(-d);
        st.m += d; st.l *= f;
#pragma unroll
        for (int r = 0; r < 16; ++r) { st.o[0][r] *= f; st.o[1][r] *= f; p0[r] -= d; p1[r] -= d; }
    }
#pragma unroll
    for (int r = 0; r < 16; ++r) { p0[r] = __builtin_amdgcn_exp2f(p0[r]); p1[r] = __builtin_amdgcn_exp2f(p1[r]); }
    st.l += sum16(p0) + sum16(p1);
    pf[0] = pack8(p0, 0); pf[1] = pack8(p0, 8); pf[2] = pack8(p1, 0); pf[3] = pack8(p1, 8);
}
__device__ __forceinline__ bf16x8_t q_scaled(const bf16_t* qp, float c) {
    const u32x4_t v = *(const u32x4_t*)qp; u32x4_t w;
#pragma unroll
    for (int i = 0; i < 4; ++i) w[i] = pg8::cvt_pk_bf16(__uint_as_float(v[i] << 16) * c, __uint_as_float(v[i] & 0xffff0000u) * c);
    return __builtin_bit_cast(bf16x8_t, w);
}

template <int NS>
__device__ __forceinline__ float self_score(const bf16x8_t* q, const bf16_t* krow, int h) {
    float s = 0.f;
#pragma unroll
    for (int i = 0; i < NS; ++i) { const u32x4_t kv = *(const u32x4_t*)(krow + 16 * i + 8 * h); const u32x4_t qv = __builtin_bit_cast(u32x4_t, q[i]);
#pragma unroll
        for (int e = 0; e < 4; ++e) { s = fmaf(__uint_as_float(qv[e] << 16), __uint_as_float(kv[e] << 16), s); s = fmaf(__uint_as_float(qv[e] & 0xffff0000u), __uint_as_float(kv[e] & 0xffff0000u), s); } }
    return pl32_sum(s);
}

__device__ void f_cmp(const P& p, int bid, int nb, LASP unsigned char* lds) {
    const int tid = ltid(), wave = __builtin_amdgcn_readfirstlane(tid >> 6), lane = tid & 63, r32 = lane & 31, h = lane >> 5;
    const bf16_t* U = (const bf16_t*)(p.ws + OFF_U);
    constexpr int HSTR = 136;
    LASP float* red = (LASP float*)lds;
    LASP bf16_t* hid = (LASP bf16_t*)lds;
    for (int unit = bid; unit < 256; unit += nb) {
        const int pr = unit >> 2, ct = unit & 3, kv = pr & 1, bg = pr >> 1, b = bg >> 1, g = bg & 1;
        const int col0 = (kv ? C_VC : C_KC) + g * 64;
        const bf16_t* W1T = (const bf16_t*)(p.ws + OFF_W1T) + (size_t)kv * 128 * 2048; const bf16_t* W2T = (const bf16_t*)(p.ws + OFF_W2T) + (size_t)kv * 64 * 128;
        const float* B1 = (const float*)(p.ws + OFF_B1) + kv * 128;
        const int tokb = 16 * (ct * 32 + r32) + 4 * wave;
        const bf16_t* Ub = U + (size_t)b * SEQ * LDU + col0 + 8 * h;
        const bf16_t* wp = W1T + (size_t)(((16 * wave) * 2 + h) * 32 + r32) * 8;
        f32x16_t acc[4];
#pragma unroll
        for (int nbk = 0; nbk < 4; ++nbk) acc[nbk] = (f32x16_t){0.f, 0.f, 0.f, 0.f, 0.f, 0.f, 0.f, 0.f, 0.f, 0.f, 0.f, 0.f, 0.f, 0.f, 0.f, 0.f};
#pragma unroll 4
        for (int s = 0; s < 16; ++s) {
            int tok = tokb + (s >> 2); tok = tok < SEQ ? tok : SEQ - 1;
            const bf16x8_t a = *(const bf16x8_t*)(Ub + (size_t)tok * LDU + (s & 3) * 16);
#pragma unroll
            for (int nbk = 0; nbk < 4; ++nbk) { const bf16x8_t bb = *(const bf16x8_t*)(wp + (size_t)(nbk * 128 + s) * 512); acc[nbk] = MFMA32(a, bb, acc[nbk]); }
        }
#pragma unroll
        for (int nbk = 0; nbk < 4; ++nbk)
#pragma unroll
            for (int r = 0; r < 16; ++r) red[((wave * 4 + nbk) * 16 + r) * 64 + lane] = acc[nbk][r];
        __syncthreads();
        { const int nbk = wave & 3, r0 = 8 * (wave >> 2); const int n = nbk * 32 + r32; const float b1 = B1[n];
            float hv[8];
#pragma unroll
            for (int rr = 0; rr < 8; ++rr) { const int r = r0 + rr; float v = b1;
#pragma unroll
                for (int w = 0; w < 8; ++w) v += red[((w * 4 + nbk) * 16 + r) * 64 + lane];
                const float u = 0.7978845608028654f * (v + 0.044715f * v * v * v);
                const float th = 1.0f - 2.0f / (__expf(2.0f * u) + 1.0f);
                hv[rr] = 0.5f * v * (1.0f + th); }
            __syncthreads();
#pragma unroll
            for (int rr = 0; rr < 8; ++rr) { const int r = r0 + rr; hid[((r & 3) + 8 * (r >> 2) + 4 * h) * HSTR + n] = f2bf(hv[rr]); } }
        __syncthreads();
        if (wave < 2) {
            f32x16_t a2 = {0.f, 0.f, 0.f, 0.f, 0.f, 0.f, 0.f, 0.f, 0.f, 0.f, 0.f, 0.f, 0.f, 0.f, 0.f, 0.f};
#pragma unroll
            for (int s = 0; s < 8; ++s) { const bf16x8_t a = *(const LASP bf16x8_t*)(hid + r32 * HSTR + 16 * s + 8 * h); const bf16x8_t bb = *(const bf16x8_t*)(W2T + (size_t)(wave * 32 + r32) * 128 + 16 * s + 8 * h);
                a2 = MFMA32(a, bb, a2); }
            bf16_t* dst = (bf16_t*)(p.ws + (kv ? OFF_VCMP : OFF_KCMP)) + (size_t)bg * 128 * 64 + wave * 32 + r32;
#pragma unroll
            for (int r = 0; r < 16; ++r) { const int row = ct * 32 + (r & 3) + 8 * (r >> 2) + 4 * h; dst[row * 64] = row < N_CMP ? f2bf(a2[r]) : (bf16_t)0; }
        }
        __syncthreads();
    }
}

template <int DRY> __device__ void nsa_unit(const P& p, int b, int g, int cur, LASP unsigned char* lds, int ew_it, bool fresh) {
    const int tid = ltid(), wave = __builtin_amdgcn_readfirstlane(tid >> 6), lane = tid & 63, r32 = lane & 31, h = lane >> 5;
    const int rh = wave >> 1, th = wave & 1, hq = g * 4 + rh, bg = b * 2 + g;
    const int t0 = cur * 64, tl = th * 32 + r32, t = t0 + tl;
    const bf16_t* U = (const bf16_t*)(p.ws + OFF_U);
    const bf16_t* Ub = U + (size_t)b * SEQ * LDU;
    LASP unsigned char* ring = lds + AL_RING;
    LASP float* tabw = (LASP float*)(lds + AL_TAB) + rh * 128;
    const LASP f32x4_t* tab4 = (const LASP f32x4_t*)(lds + AL_TAB4) + rh * T4_N;
    LASP unsigned* selm = (LASP unsigned*)(lds + AL_SEL);
    LASP float* impsh = (LASP float*)(lds + AL_IMP);
    const int vlane = SLOT_V + ((lane >> 4) & 1) * 32 + (lane & 3) * 8 + (4 * h + ((lane & 15) >> 2)) * 64;
    const float c = 0.125f * LOG2E;
    { if (fresh) { const float* biasd = (const float*)(p.ws + OFF_BIASD) + (g * 4 + (tid >> 7)) * 2048; ((LASP float*)(lds + AL_TAB))[tid] = (biasd[tid & 127] - biasd[127]) * LOG2E; } if (tid == 0) selm[64] = 0u; }
    bf16x8_t q[4];
    { const bf16_t* qp = Ub + (size_t)t * LDU + C_QA + hq * 64 + 8 * h;
#pragma unroll
      for (int s = 0; s < 4; ++s) q[s] = q_scaled(qp + 16 * s, c); }
    const float ref_s = self_score<4>(q, Ub + (size_t)t * LDU + C_KS + g * 64, h), ref_w = self_score<4>(q, Ub + (size_t)t * LDU + C_KW + g * 64, h);
#define NSA_GATE(i) (1.0f / (1.0f + __expf(-bf2f(Ub[(size_t)t * LDU + C_GATE + hq * 3 + (i)]))))
    f32x16_t oacc[2];
    {
        const bf16_t* kc = (const bf16_t*)(p.ws + OFF_KCMP) + (size_t)bg * 128 * 64; const bf16_t* vc = (const bf16_t*)(p.ws + OFF_VCMP) + (size_t)bg * 128 * 64;
        dma_tile(kc, vc, 64, ring, wave, lane); dma_tile(kc + 64 * 64, vc + 64 * 64, 64, ring + SLOT_BYTES, wave, lane);
        dma_tile(Ub + C_KS + g * 64, Ub + C_VS + g * 64, LDU, ring + 2 * SLOT_BYTES, wave, lane);
        DMA_WAIT_BAR(2);
        if (fresh) { for (int i_ = tid; i_ < 4 * T16_N; i_ += NT) t16_fill((LASP f32x4_t*)(lds + AL_T16) + (i_ / T16_N) * T16_N, (const LASP float*)(lds + AL_TAB) + (i_ / T16_N) * 128, i_ % T16_N);
            asm volatile("s_waitcnt lgkmcnt(0)\n\ts_barrier" ::: "memory"); }
        if (fresh) for (int i_ = tid; i_ < 4 * T4_N; i_ += NT) t4_fill((LASP f32x4_t*)(lds + AL_TAB4) + (i_ / T4_N) * T4_N, (const LASP float*)(lds + AL_TAB) + (i_ / T4_N) * 128, i_ % T4_N);
        f32x16_t x0, x1, x2, x3;
        qk_tile<4, 0>(x0, x1, 0.f, ring, q, r32, h); qk_tile<4, 0>(x2, x3, 0.f, ring + SLOT_BYTES, q, r32, h);
        const float* dummy = nullptr; (void)dummy;
        const int dq = t - 31 - 64 * h;
#define CMP_XF(X, OFF) do { _Pragma("unroll") for (int G = 0; G < 4; ++G) { int i_ = dq - (OFF) - 128 * G + 1; i_ = i_ < 0 ? 0 : (i_ > T16_N - 1 ? T16_N - 1 : i_); const f32x4_t e_ = t16[i_]; \
            const f32x4_t u_ = (f32x4_t){X[4 * G], X[4 * G + 1], X[4 * G + 2], X[4 * G + 3]} + e_; X[4 * G] = u_[0]; X[4 * G + 1] = u_[1]; X[4 * G + 2] = u_[2]; X[4 * G + 3] = u_[3]; } } while (0)
        const LASP f32x4_t* t16 = (const LASP f32x4_t*)(lds + AL_T16) + rh * T16_N;
        CMP_XF(x0, 0); CMP_XF(x1, 512); CMP_XF(x2, 1024); CMP_XF(x3, 1536);
#undef CMP_XF
        float mx = fmaxf(fmaxf(max16(x0), max16(x1)), fmaxf(max16(x2), max16(x3)));
        mx = pl32_max(mx);
#pragma unroll
        for (int r = 0; r < 16; ++r) { x0[r] = __builtin_amdgcn_exp2f(x0[r] - mx); x1[r] = __builtin_amdgcn_exp2f(x1[r] - mx); x2[r] = __builtin_amdgcn_exp2f(x2[r] - mx); x3[r] = __builtin_amdgcn_exp2f(x3[r] - mx); }
        float l = (sum16(x0) + sum16(x1)) + (sum16(x2) + sum16(x3));
        l = pl32_sum(l);
        const float inv = (t >= 31) ? 1.0f / l : 0.f;
#pragma unroll
        for (int r = 0; r < 16; ++r) { x0[r] *= inv; x1[r] *= inv; x2[r] *= inv; x3[r] *= inv; }
        {
            LASP float* dst = impsh + tl * 129 + rh * 32 + h;
            float carry = 0.f;
#define IMP_TILE(X, T) do { _Pragma("unroll") for (int G = 0; G < 4; ++G) { const float s4 = (X[4 * G] + X[4 * G + 1]) + (X[4 * G + 2] + X[4 * G + 3]); \
                const float lp = pl32_other(X[4 * G + 3]); dst[2 * (4 * T + G)] = s4 + (h ? lp : carry); carry = lp; } } while (0)
            IMP_TILE(x0, 0); IMP_TILE(x1, 1); IMP_TILE(x2, 2); IMP_TILE(x3, 3);
#undef IMP_TILE
        }
        { const f32x16_t z = {0.f, 0.f, 0.f, 0.f, 0.f, 0.f, 0.f, 0.f, 0.f, 0.f, 0.f, 0.f, 0.f, 0.f, 0.f, 0.f}; oacc[0] = z; oacc[1] = z; }
        { bf16x8_t pf[4]; pf[0] = pack8(x0, 0); pf[1] = pack8(x0, 8); pf[2] = pack8(x1, 0); pf[3] = pack8(x1, 8); pv_tile(oacc, ring + vlane, pf);
          pf[0] = pack8(x2, 0); pf[1] = pack8(x2, 8); pf[2] = pack8(x3, 0); pf[3] = pack8(x3, 8); pv_tile(oacc, ring + SLOT_BYTES + vlane, pf); }
#pragma unroll
        for (int r = 0; r < 16; ++r) { const float g0_ = NSA_GATE(0); oacc[0][r] *= g0_; oacc[1][r] *= g0_; }
        float ewv[32];
        const bool ew_on = (unsigned)ew_it < (unsigned)EW_ITEMS;
        if (ew_on) ew_load(p, ew_it, lane, ewv);
        __syncthreads();
        {
            const int tk = tid >> 3, i8 = tid & 7;
            const LASP float* row = impsh + tk * 129 + 4 * i8;
            float v[4];
#pragma unroll
            for (int k = 0; k < 4; ++k) v[k] = ((row[k] + row[32 + k]) + row[64 + k]) + row[96 + k];
            const unsigned F = 1u | (1u << cur) | (cur >= 1 ? (1u << (cur - 1)) : 0u);
            const unsigned allv = (cur >= 31) ? 0xffffffffu : ((1u << (cur + 1)) - 1u);
            unsigned cand = allv & ~F; const int nfree = SEL_TOPN - __popc(F);
            unsigned sel = F;
            if (__popc(cand) <= nfree) sel |= cand;
            else {
#pragma unroll 1
                for (int it = 0; it < nfree; ++it) {
                    float best = -1.0f; int bj = 64;
#pragma unroll
                    for (int k = 0; k < 4; ++k) { const int j = 4 * i8 + k; const bool ok = ((cand >> j) & 1u) && v[k] > best; best = ok ? v[k] : best; bj = ok ? j : bj; }
#pragma unroll
                    for (int st_ = 0; st_ < 3; ++st_) {
                        const int ctrl = st_ == 0 ? 0xB1 : (st_ == 1 ? 0x4E : 0x141);
                        float ob; int oj;
                        if (st_ == 0) { ob = DPP_F(best, 0xB1); oj = __builtin_amdgcn_update_dpp(0, bj, 0xB1, 0xf, 0xf, true); }
                        else if (st_ == 1) { ob = DPP_F(best, 0x4E); oj = __builtin_amdgcn_update_dpp(0, bj, 0x4E, 0xf, 0xf, true); }
                        else { ob = DPP_F(best, 0x141); oj = __builtin_amdgcn_update_dpp(0, bj, 0x141, 0xf, 0xf, true); }
                        (void)ctrl;
                        const bool take = (ob > best) || (ob == best && oj < bj);
                        best = take ? ob : best; bj = take ? oj : bj;
                    }
                    sel |= 1u << bj; cand &= ~(1u << bj);
                }
            }
            if (i8 == 0) { selm[tk] = sel; atomicOr((unsigned*)&selm[64], sel); }
        }
        if (ew_on) ew_store(p, ew_it, lane, ewv);
        __syncthreads();
    }
    if (DRY == 1) { asm volatile("" :: "v"(oacc[0][0]), "v"(oacc[1][0])); return; }
    const unsigned mysel = selm[tl];
    const unsigned anysel = selm[64] & ((cur >= 31) ? 0xffffffffu : ((1u << (cur + 1)) - 1u));
    {
        LASP float* oal = (LASP float*)(lds + AL_IMP) + wave * 2048 + lane;
#pragma unroll
        for (int r = 0; r < 16; ++r) { oal[r * 64] = oacc[0][r]; oal[(16 + r) * 64] = oacc[1][r]; }
        const int wlo = cur >= 8 ? cur - 8 : 0;
#define NSA_NEXT(code) (((code) < 64) ? ((anysel & ~((2u << (code)) - 1u)) ? (__ffs((int)(anysel & ~((2u << (code)) - 1u))) - 1) : 64 + wlo) : ((((code) & 63) < cur) ? (code) + 1 : 128))
#define NSA_KSRC(code) (Ub + (size_t)(DRY == 2 ? 0 : ((code) & 63)) * 64 * LDU + (((code) < 64) ? C_KS : C_KW) + g * 64)
        const unsigned ringa = (unsigned)(uintptr_t)ring;
        const LASP unsigned char* kfl = ring + KFRAG_OFF(r32, h);
        const LASP unsigned char* vfl = ring + vlane;
#define SBAR() __builtin_amdgcn_sched_barrier(0)
#define PIN(x) asm volatile("" : "+v"(x))
#define KLD(i, kb) kf[i] = *(const LASP bf16x8_t*)(uintptr_t)((((unsigned)(uintptr_t)(kb)) ^ (((i) >> 1) << 5)) + ((i) & 1) * 4096)
#define VRD(i, ks, db) do { vl[i] = __builtin_amdgcn_ds_read_tr16_b64_v4i16((LASP v4i16_t*)(vbp + (db) * 4096 + (ks) * 1024)); vh[i] = __builtin_amdgcn_ds_read_tr16_b64_v4i16((LASP v4i16_t*)(vbp + (db) * 4096 + (ks) * 1024 + 512)); } while (0)
#define VFR(i) ((bf16x8_t){vl[i][0], vl[i][1], vl[i][2], vl[i][3], vh[i][0], vh[i][1], vh[i][2], vh[i][3]})
#define PKW(P, b) pg8::cvt_pk_bf16(P[b], P[(b) + 1])
#define PWF(k) __builtin_bit_cast(bf16x8_t, pw##k)
#define EX(v) __builtin_amdgcn_exp2f(v)
#define MX3(a, b, c) __builtin_fmaxf(__builtin_fmaxf((a), (b)), (c))
#define END_WAIT3() do { if (c3 < 128) { asm volatile("s_waitcnt vmcnt(2) lgkmcnt(0)\n\ts_barrier" ::: "memory"); } else if (c1 < 128) { asm volatile("s_waitcnt vmcnt(1) lgkmcnt(0)\n\ts_barrier" ::: "memory"); } \
            else { asm volatile("s_waitcnt vmcnt(0) lgkmcnt(0)\n\ts_barrier" ::: "memory"); } } while (0)
#define END_WAIT() asm volatile("s_waitcnt vmcnt(2) lgkmcnt(0)\n\ts_barrier" ::: "memory")
#define ROTATE() do { cm1 = c0; c0 = c1; c1 = c2; c2 = c3; c3 = (c3 < 128) ? NSA_NEXT(c3) : 128; sp = s0; s0 = s1; s1 = (s1 == 2) ? 0 : s1 + 1; } while (0)
#define ROWMAX(C0, C1, mx) do { float a_ = MX3(C0[0], C0[1], C1[0]), b_ = MX3(C0[2], C0[3], C1[1]); a_ = MX3(a_, C1[2], C1[3]); \
            _Pragma("unroll") for (int r = 4; r < 16; r += 4) { a_ = MX3(a_, C0[r], C0[r + 1]); b_ = MX3(b_, C0[r + 2], C0[r + 3]); a_ = MX3(a_, C1[r], C1[r + 1]); b_ = MX3(b_, C1[r + 2], C1[r + 3]); } \
            mx = pl32_max(__builtin_fmaxf(a_, b_)); } while (0)
        int cm1 = 0, c0 = 0, c1 = NSA_NEXT(0), c2 = (c1 < 128) ? NSA_NEXT(c1) : 128, c3 = (c2 < 128) ? NSA_NEXT(c2) : 128;
        int sp = 1, s0 = 2, s1 = 0;
        (void)cm1;
        if (c1 < 128) { dma_k(NSA_KSRC(c1), LDU, ringa, wave, lane); dma_v(NSA_KSRC(c1) + 128, LDU, ringa, wave, lane); }
        if (c2 < 128) dma_k(NSA_KSRC(c2), LDU, ringa + SLOT_BYTES, wave, lane);
        bf16x8_t kf[8]; v4i16_t vl[8], vh[8]; u32x4_t pw0, pw1, pw2, pw3;
        f32x16_t pA0, pA1, pB0, pB1, o[2];
        { const f32x16_t z = {0.f, 0.f, 0.f, 0.f, 0.f, 0.f, 0.f, 0.f, 0.f, 0.f, 0.f, 0.f, 0.f, 0.f, 0.f, 0.f}; o[0] = z; o[1] = z; }
        float m = ref_s + SM_THR, l = 0.f; bool inwin = false;
        { const LASP unsigned char* kb = kfl + 2 * SLOT_BYTES;
          KLD(0, kb); KLD(1, kb); KLD(2, kb); KLD(3, kb); KLD(4, kb); KLD(5, kb); KLD(6, kb); KLD(7, kb);
          const float ci = -m; const f32x16_t cin = {ci, ci, ci, ci, ci, ci, ci, ci, ci, ci, ci, ci, ci, ci, ci, ci};
          pA0 = MFMA32(kf[0], q[0], cin); pA1 = MFMA32(kf[1], q[0], cin); pA0 = MFMA32(kf[2], q[1], pA0); pA1 = MFMA32(kf[3], q[1], pA1);
          pA0 = MFMA32(kf[4], q[2], pA0); pA1 = MFMA32(kf[5], q[2], pA1); pA0 = MFMA32(kf[6], q[3], pA0); pA1 = MFMA32(kf[7], q[3], pA1);
          if (3 > cur) xf4<false>(pA0, pA1, t - 4 * h, 0x7fffffffu, tab4);
          float mx; ROWMAX(pA0, pA1, mx);
          if (__any(mx > SM_THR)) { const float d = mx > SM_THR ? mx : 0.f; m += d;
#pragma unroll
              for (int r = 0; r < 16; ++r) { pA0[r] -= d; pA1[r] -= d; } }
#pragma unroll
          for (int r = 0; r < 16; ++r) { pA0[r] = EX(pA0[r]); pA1[r] = EX(pA1[r]); } }
        asm volatile("s_waitcnt vmcnt(0) lgkmcnt(0)\n\ts_barrier" ::: "memory");
        if (c3 < 128) dma_k(NSA_KSRC(c3), LDU, ringa + 2 * SLOT_BYTES, wave, lane);
        if (c1 < 128) { const LASP unsigned char* kb = kfl; KLD(0, kb); KLD(1, kb); KLD(2, kb); KLD(3, kb); KLD(4, kb); KLD(5, kb); KLD(6, kb); KLD(7, kb); }
        asm volatile("s_waitcnt lgkmcnt(0)\n\ts_barrier" ::: "memory");
        ROTATE();
#define NSA_STEP(C0, C1, P0, P1, BIAS) do { \
            const int j_ = c0 & 63; \
            const bool sel_ = (c0 >= 64) || ((mysel >> j_) & 1u); \
            const float ci_ = sel_ ? -m : NEG_BIG; \
            dma_k(NSA_KSRC(c3), LDU, ringa + s0 * SLOT_BYTES, wave, lane);        \
            dma_v(NSA_KSRC(c1) + 128, LDU, ringa + s1 * SLOT_BYTES, wave, lane); \
            const LASP unsigned char* vbp = vfl + sp * SLOT_BYTES; \
            __builtin_amdgcn_s_waitcnt(0xC07F);        \
            f32x2_t sacc = {P0[0], P0[1]}; \
            { const f32x16_t cin_ = {ci_, ci_, ci_, ci_, ci_, ci_, ci_, ci_, ci_, ci_, ci_, ci_, ci_, ci_, ci_, ci_}; C1 = cin_; }        \
            SBAR(); \
            VRD(0, 0, 0); SBAR(); C0 = MFMA32(kf[0], q[0], C1); sacc += (f32x2_t){P0[2], P0[3]}; sacc += (f32x2_t){P0[4], P0[5]}; PIN(sacc); pw0[0] = PKW(P0, 0); pw0[1] = PKW(P0, 2); PIN(pw0); SBAR(); \
            VRD(1, 0, 1); SBAR(); C1 = MFMA32(kf[1], q[0], C1); sacc += (f32x2_t){P0[6], P0[7]}; sacc += (f32x2_t){P0[8], P0[9]}; PIN(sacc); pw0[2] = PKW(P0, 4); pw0[3] = PKW(P0, 6); PIN(pw0); SBAR(); \
            VRD(2, 1, 0); SBAR(); C0 = MFMA32(kf[2], q[1], C0); sacc += (f32x2_t){P0[10], P0[11]}; sacc += (f32x2_t){P0[12], P0[13]}; PIN(sacc); pw1[0] = PKW(P0, 8); pw1[1] = PKW(P0, 10); PIN(pw1); SBAR(); \
            VRD(3, 1, 1); SBAR(); C1 = MFMA32(kf[3], q[1], C1); sacc += (f32x2_t){P0[14], P0[15]}; sacc += (f32x2_t){P1[0], P1[1]}; PIN(sacc); pw1[2] = PKW(P0, 12); pw1[3] = PKW(P0, 14); PIN(pw1); SBAR(); \
            VRD(4, 2, 0); SBAR(); C0 = MFMA32(kf[4], q[2], C0); sacc += (f32x2_t){P1[2], P1[3]}; sacc += (f32x2_t){P1[4], P1[5]}; PIN(sacc); pw2[0] = PKW(P1, 0); pw2[1] = PKW(P1, 2); PIN(pw2); SBAR(); \
            VRD(5, 2, 1); SBAR(); C1 = MFMA32(kf[5], q[2], C1); sacc += (f32x2_t){P1[6], P1[7]}; sacc += (f32x2_t){P1[8], P1[9]}; PIN(sacc); pw2[2] = PKW(P1, 4); pw2[3] = PKW(P1, 6); PIN(pw2); SBAR(); \
            VRD(6, 3, 0); SBAR(); C0 = MFMA32(kf[6], q[3], C0); sacc += (f32x2_t){P1[10], P1[11]}; sacc += (f32x2_t){P1[12], P1[13]}; PIN(sacc); pw3[0] = PKW(P1, 8); pw3[1] = PKW(P1, 10); PIN(pw3); SBAR(); \
            VRD(7, 3, 1); SBAR(); C1 = MFMA32(kf[7], q[3], C1); sacc += (f32x2_t){P1[14], P1[15]}; PIN(sacc); pw3[2] = PKW(P1, 12); pw3[3] = PKW(P1, 14); PIN(pw3); SBAR(); \
            l += sacc.x + sacc.y; \
            if (BIAS) xf4b(C0, C1, t - 64 * j_ - 4 * h, tab4);        \
            float mx_; ROWMAX(C0, C1, mx_); \
            bool resc_ = false; float f_ = 1.f; \
            if (__builtin_expect(__any(mx_ > SM_THR), 0)) { const float d_ = mx_ > SM_THR ? mx_ : 0.f; f_ = EX(-d_); m += d_; l *= f_; resc_ = true; \
                _Pragma("unroll") for (int r = 0; r < 16; ++r) { asm volatile("v_sub_f32 %0, %0, %1" : "+v"(C0[r]) : "v"(d_)); asm volatile("v_sub_f32 %0, %0, %1" : "+v"(C1[r]) : "v"(d_)); } } \
            __builtin_amdgcn_s_waitcnt(0xC07F);        \
            SBAR(); \
            o[0] = MFMA32(VFR(0), PWF(0), o[0]); C0[0] = EX(C0[0]); C0[1] = EX(C0[1]); C0[2] = EX(C0[2]); C0[3] = EX(C0[3]); PIN(C0); SBAR(); \
            o[1] = MFMA32(VFR(1), PWF(0), o[1]); C0[4] = EX(C0[4]); C0[5] = EX(C0[5]); C0[6] = EX(C0[6]); C0[7] = EX(C0[7]); PIN(C0); SBAR(); \
            { const LASP unsigned char* kb_ = kfl + s1 * SLOT_BYTES; KLD(0, kb_); KLD(1, kb_); SBAR(); }        \
            o[0] = MFMA32(VFR(2), PWF(1), o[0]); C0[8] = EX(C0[8]); C0[9] = EX(C0[9]); C0[10] = EX(C0[10]); C0[11] = EX(C0[11]); PIN(C0); SBAR(); \
            { const LASP unsigned char* kb_ = kfl + s1 * SLOT_BYTES; KLD(2, kb_); KLD(3, kb_); SBAR(); }        \
            o[1] = MFMA32(VFR(3), PWF(1), o[1]); C0[12] = EX(C0[12]); C0[13] = EX(C0[13]); C0[14] = EX(C0[14]); C0[15] = EX(C0[15]); PIN(C0); SBAR(); \
            { const LASP unsigned char* kb_ = kfl + s1 * SLOT_BYTES; KLD(4, kb_); KLD(5, kb_); SBAR(); }        \
            o[0] = MFMA32(VFR(4), PWF(2), o[0]); C1[0] = EX(C1[0]); C1[1] = EX(C1[1]); C1[2] = EX(C1[2]); C1[3] = EX(C1[3]); PIN(C1); SBAR(); \
            { const LASP unsigned char* kb_ = kfl + s1 * SLOT_BYTES; KLD(6, kb_); KLD(7, kb_); SBAR(); }        \
            o[1] = MFMA32(VFR(5), PWF(2), o[1]); C1[4] = EX(C1[4]); C1[5] = EX(C1[5]); C1[6] = EX(C1[6]); C1[7] = EX(C1[7]); PIN(C1); SBAR(); \
            o[0] = MFMA32(VFR(6), PWF(3), o[0]); C1[8] = EX(C1[8]); C1[9] = EX(C1[9]); C1[10] = EX(C1[10]); C1[11] = EX(C1[11]); PIN(C1); SBAR(); \
            o[1] = MFMA32(VFR(7), PWF(3), o[1]); C1[12] = EX(C1[12]); C1[13] = EX(C1[13]); C1[14] = EX(C1[14]); C1[15] = EX(C1[15]); PIN(C1); SBAR(); \
            if (resc_) { _Pragma("unroll") for (int r = 0; r < 16; ++r) { asm volatile("v_mul_f32 %0, %0, %1" : "+v"(o[0][r]) : "v"(f_)); asm volatile("v_mul_f32 %0, %0, %1" : "+v"(o[1][r]) : "v"(f_)); } } \
            END_WAIT(); \
            ROTATE(); } while (0)
#define NSA_STEP_GEN(C0, C1, P0, P1, KIND) do { \
            const int j_ = c0 & 63; const bool win_ = c0 >= 64, sw_ = win_ && !inwin; \
            const bool sel_ = win_ || ((mysel >> j_) & 1u); \
            const float mq_ = sw_ ? ref_w + SM_THR : m; \
            const float ci_ = sel_ ? -mq_ : NEG_BIG; \
            if (c3 < 128) dma_k(NSA_KSRC(c3), LDU, ringa + s0 * SLOT_BYTES, wave, lane); \
            if (c1 < 128) dma_v(NSA_KSRC(c1) + 128, LDU, ringa + s1 * SLOT_BYTES, wave, lane); \
            { VFr1 vf_; pv_read1(vf_, vfl + sp * SLOT_BYTES);        \
              float sacc = 0.f; _Pragma("unroll") for (int r = 0; r < 16; ++r) sacc += P0[r] + P1[r]; l += sacc; \
              bf16x8_t pf_[4]; pf_[0] = pack8(P0, 0); pf_[1] = pack8(P0, 8); pf_[2] = pack8(P1, 0); pf_[3] = pack8(P1, 8); \
              pv_mma1(o, vf_, pf_); } \
            if (sw_) { const float fs_ = NSA_GATE(1) / pl32_sum(l); l = 0.f; m = mq_; \
                _Pragma("unroll") for (int r = 0; r < 16; ++r) { oal[r * 64] = fmaf(fs_, o[0][r], oal[r * 64]); oal[(16 + r) * 64] = fmaf(fs_, o[1][r], oal[(16 + r) * 64]); o[0][r] = 0.f; o[1][r] = 0.f; } \
                inwin = true; } \
            { const f32x16_t cin_ = {ci_, ci_, ci_, ci_, ci_, ci_, ci_, ci_, ci_, ci_, ci_, ci_, ci_, ci_, ci_, ci_}; C1 = cin_; } \
            C0 = MFMA32(kf[0], q[0], C1); C1 = MFMA32(kf[1], q[0], C1); C0 = MFMA32(kf[2], q[1], C0); C1 = MFMA32(kf[3], q[1], C1); \
            C0 = MFMA32(kf[4], q[2], C0); C1 = MFMA32(kf[5], q[2], C1); C0 = MFMA32(kf[6], q[3], C0); C1 = MFMA32(kf[7], q[3], C1); \
            if (c1 < 128) { const LASP unsigned char* kb_ = kfl + s1 * SLOT_BYTES; KLD(0, kb_); KLD(1, kb_); KLD(2, kb_); KLD(3, kb_); KLD(4, kb_); KLD(5, kb_); KLD(6, kb_); KLD(7, kb_); } \
            if (KIND) xf4<true>(C0, C1, t - 64 * j_ - 4 * h, win_ ? (unsigned)WINDOW : 0x7fffffffu, tab4);        \
            else xf4<false>(C0, C1, t - 64 * j_ - 4 * h, 0u, tab4);                                               \
            float mx_; ROWMAX(C0, C1, mx_); \
            if (__any(mx_ > SM_THR)) { const float d_ = mx_ > SM_THR ? mx_ : 0.f, f_ = EX(-d_); m += d_; l *= f_; \
                _Pragma("unroll") for (int r = 0; r < 16; ++r) { C0[r] -= d_; C1[r] -= d_; o[0][r] *= f_; o[1][r] *= f_; } } \
            _Pragma("unroll") for (int r = 0; r < 16; ++r) { C0[r] = EX(C0[r]); C1[r] = EX(C1[r]); } \
            END_WAIT3(); \
            ROTATE(); } while (0)
#define NSA_DRAIN(P0, P1) do { VFr1 vf_; pv_read1(vf_, vfl + sp * SLOT_BYTES); float sacc = 0.f; _Pragma("unroll") for (int r = 0; r < 16; ++r) sacc += P0[r] + P1[r]; l += sacc; \
            bf16x8_t pf_[4]; pf_[0] = pack8(P0, 0); pf_[1] = pack8(P0, 8); pf_[2] = pack8(P1, 0); pf_[3] = pack8(P1, 8); \
            pv_mma1(o, vf_, pf_); } while (0)
#define NSA_ISGEN(code) (((code) >= 64) ? (!inwin || !(((code) & 63) + 3 <= cur && ((code) & 63) + 8 > cur)) : (((code) & 63) + 3 > cur))
#define NSA_NEAR(code) ((((code) & 63) + 3 > cur) ? 3 : 0)
#define NSA_KIND(code) (((code) < 64) ? NSA_NEAR(code) : ((((code) & 63) + 8 == cur) ? 2 : (inwin ? NSA_NEAR(code) : 1)))
#define NSA_ISSEQ(code) ((code) >= 64 && (!inwin || ((code) & 63) + 8 == cur))
#define NSA_ISMASK(code) ((code) >= 64 && ((code) & 63) + 8 == cur)
        bool lastA = true;
        for (;;) {
            if (c0 >= 128) break;
            { const int kind_ = NSA_KIND(c0); if (kind_ == 0 || kind_ == 3) { const bool near_ = kind_ == 3; NSA_STEP(pB0, pB1, pA0, pA1, near_); } else NSA_STEP_GEN(pB0, pB1, pA0, pA1, true); }
            lastA = false;
            if (c0 >= 128) break;
            { const int kind_ = NSA_KIND(c0); if (kind_ == 0 || kind_ == 3) { const bool near_ = kind_ == 3; NSA_STEP(pA0, pA1, pB0, pB1, near_); } else NSA_STEP_GEN(pA0, pA1, pB0, pB1, true); }
            lastA = true;
        }
        if (lastA) NSA_DRAIN(pA0, pA1); else NSA_DRAIN(pB0, pB1);
#undef NSA_STEP
#undef NSA_STEP_GEN
#undef NSA_ISSEQ
#undef NSA_ISGEN
#undef NSA_ISMASK
#undef NSA_DRAIN
#undef NSA_NEXT
#undef NSA_KSRC
#undef KLD
#undef VRD
#undef VFR
#undef PKW
#undef PWF
#undef ROWMAX
#undef END_WAIT
#undef END_WAIT3
#undef ROTATE
        const float fw = NSA_GATE(2) / pl32_sum(l);
        bf16_t* orow = (bf16_t*)(p.ws + OFF_ATT) + ((size_t)b * SEQ + t) * D_MODEL + hq * 64 + 4 * h;
#pragma unroll
        for (int db = 0; db < 2; ++db)
#pragma unroll
            for (int rg = 0; rg < 4; ++rg) { float v_[4];
#pragma unroll
                for (int e = 0; e < 4; ++e) v_[e] = fmaf(fw, o[db][4 * rg + e], oal[(16 * db + 4 * rg + e) * 64]);
                uint2 w; w.x = pg8::cvt_pk_bf16(v_[0], v_[1]); w.y = pg8::cvt_pk_bf16(v_[2], v_[3]); if (DRY == 0) *(uint2*)(orow + 32 * db + 8 * rg) = w; else asm volatile("" :: "v"(w.x), "v"(w.y)); }
        asm volatile("s_waitcnt lgkmcnt(0)" ::: "memory");
    }
}

#undef NSA_GATE
__device__ void diff_unit(const P& p, int b, int hd, int qb, LASP unsigned char* lds, int ew_it, bool fresh) {
    const int tid = ltid(), wave = __builtin_amdgcn_readfirstlane(tid >> 6), lane = tid & 63, r32 = lane & 31, h = lane >> 5;
    const int q0w = qb * 256 + wave * 32, t = q0w + r32;
    const bf16_t* Ub = (const bf16_t*)(p.ws + OFF_U) + (size_t)b * SEQ * LDU;
    LASP unsigned char* ring = lds + AL_RING;
    LASP float* tabw = (LASP float*)(lds + AL_TAB);
    LASP f32x4_t* tab4 = (LASP f32x4_t*)(lds + AL_TAB4);
    const int vlane = SLOT_V + ((lane >> 4) & 1) * 32 + (lane & 3) * 8 + (4 * h + ((lane & 15) >> 2)) * 64;
    const float c = 0.17677669529663687f * LOG2E;
    float ewv[32];
    const bool ew_on = (unsigned)ew_it < (unsigned)EW_ITEMS;
    if (ew_on) ew_load(p, ew_it, lane, ewv);
    if (fresh && tid < 128) { const float* biasd = (const float*)(p.ws + OFF_BIASD) + (8 + hd) * 2048; tabw[tid] = (biasd[tid] - biasd[127]) * LOG2E; }
    bf16x8_t q[4];
    { const bf16_t* qp = Ub + (size_t)t * LDU + C_QB + hd * 64 + 8 * h;
#pragma unroll
      for (int s = 0; s < 4; ++s) q[s] = q_scaled(qp + 16 * s, c); }
    AttnSt sa, sb; st_init(sa, self_score<2>(q, Ub + (size_t)t * LDU + C_KB + hd * 64, h)); st_init(sb, self_score<2>(q + 2, Ub + (size_t)t * LDU + C_KB + hd * 64 + 32, h));
    const bf16_t* ksrc = Ub + C_KB + hd * 64; const bf16_t* vsrc = Ub + C_VB + hd * 64;
    const int ntile = 4 * qb + 4;
    dma_tile(ksrc, vsrc, LDU, ring, wave, lane);
    dma_tile(ksrc + (size_t)64 * LDU, vsrc + (size_t)64 * LDU, LDU, ring + SLOT_BYTES, wave, lane);
    DMA_WAIT_BAR(2);
    if (fresh && tid < T4_N) t4_fill(tab4, tabw, tid);
    if (ew_on) ew_store(p, ew_it, lane, ewv);
    asm volatile("s_waitcnt lgkmcnt(0)\n\ts_barrier" ::: "memory");
    int sl = 0;
#pragma nounroll
    for (int j = 0; j < ntile; ++j) {
        const int sl1 = sl == 2 ? 0 : sl + 1, sl2 = sl1 == 2 ? 0 : sl1 + 1;
        if (j + 2 < ntile) dma_tile(ksrc + (size_t)(j + 2) * 64 * LDU, vsrc + (size_t)(j + 2) * 64 * LDU, LDU, ring + sl2 * SLOT_BYTES, wave, lane);
        if (64 * j <= q0w + 31) {
            const LASP unsigned char* kt = ring + sl * SLOT_BYTES; const LASP unsigned char* vt = kt + vlane;
            const bool far = (64 * j + 63 + 113 <= q0w);
            f32x16_t pa0, pa1, pb0, pb1; bf16x8_t pfa[4], pfb[4];
            qk_tile<2, 0>(pa0, pa1, -sa.m, kt, q, r32, h); qk_tile<2, 2>(pb0, pb1, -sb.m, kt, q + 2, r32, h);
            if (!far) xf4_2<false>(pa0, pa1, pb0, pb1, t - 64 * j - 4 * h, tab4);
            sm_only(sa, pa0, pa1, pfa); sm_only(sb, pb0, pb1, pfb);
            pv_tile2(sa.o, sb.o, vt, pfa, pfb);
        }
        if (j + 2 < ntile) DMA_WAIT_BAR(2); else DMA_WAIT_BAR(0);
        sl = sl1;
    }
    float la = sa.l; la = pl32_sum(la);
    float lb = sb.l; lb = pl32_sum(lb);
    float lam;
    { const float a_ = lane < 32 ? p.lq1[lane] * p.lk1[lane] : 0.f, c2_ = lane < 32 ? p.lq2[lane] * p.lk2[lane] : 0.f; lam = expf(wave_sum(a_)) - expf(wave_sum(c2_)) + 0.2f; }
    const float fa = 1.0f / la, fb = lam / lb;
    float ss = 0.f;
#pragma unroll
    for (int r = 0; r < 16; ++r) { sa.o[0][r] = sa.o[0][r] * fa - sb.o[0][r] * fb; sa.o[1][r] = sa.o[1][r] * fa - sb.o[1][r] * fb; ss += sa.o[0][r] * sa.o[0][r] + sa.o[1][r] * sa.o[1][r]; }
    ss = pl32_sum(ss);
    const float rn = 0.8f / sqrtf(ss * (1.0f / 64.0f) + EPS);
    bf16_t* orow = (bf16_t*)(p.ws + OFF_ATT) + ((size_t)b * SEQ + t) * D_MODEL + 512 + hd * 64 + 4 * h;
#pragma unroll
    for (int db = 0; db < 2; ++db)
#pragma unroll
        for (int rg = 0; rg < 4; ++rg) { const float4 gsl = *(const float4*)(p.subln + 32 * db + 8 * rg + 4 * h);
            uint2 w; w.x = pg8::cvt_pk_bf16(sa.o[db][4 * rg] * rn * gsl.x, sa.o[db][4 * rg + 1] * rn * gsl.y); w.y = pg8::cvt_pk_bf16(sa.o[db][4 * rg + 2] * rn * gsl.z, sa.o[db][4 * rg + 3] * rn * gsl.w);
            *(uint2*)(orow + 32 * db + 8 * rg) = w; }
}

__device__ void f_attn(const P& p, int bid, int nb, LASP unsigned char* lds) {
#ifndef DRY_MODE
#define DRY_MODE 0
#endif
    if (DRY_MODE) for (int u = bid; u < 1024; u += nb) { const int vb0_ = u & 255, vb = ((vb0_ & 7) << 5) | (vb0_ >> 3), i = u >> 8; const int pair = vb >> 3, s = vb & 7;
        const unsigned ctab = (s == 0) ? 0x1f1a0800u : (s == 1) ? 0x1e180901u : (s == 2) ? 0x1d160a02u : (s == 3) ? 0x1c140b03u : (s == 4) ? 0x1b130c04u : (s == 5) ? 0x19120d05u : (s == 6) ? 0x17110e06u : 0x15100f07u;
        const int cur = (int)((ctab >> (8 * (3 - i))) & 0xffu);
        nsa_unit<DRY_MODE>(p, pair >> 1, pair & 1, cur, lds, -1, true); __syncthreads(); }
    int tabkey = -1;
    for (int u = bid; u < 2048; u += nb) {
        const int ew_it = u * 8 + __builtin_amdgcn_readfirstlane(ltid() >> 6);
        const int vb0_ = u & 255, vb = ((vb0_ & 7) << 5) | (vb0_ >> 3), i = u >> 8;
        if (i < 4) { const int pair = vb >> 3, s = vb & 7;
            const unsigned ctab = (s == 0) ? 0x1f1a0800u : (s == 1) ? 0x1e180901u : (s == 2) ? 0x1d160a02u : (s == 3) ? 0x1c140b03u : (s == 4) ? 0x1b130c04u : (s == 5) ? 0x19120d05u : (s == 6) ? 0x17110e06u : 0x15100f07u;
            const int cur = (int)((ctab >> (8 * (3 - i))) & 0xffu);
            const int key = pair & 1; nsa_unit<0>(p, pair >> 1, pair & 1, cur, lds, ew_it, key != tabkey); tabkey = key; }
        else { const int pair = vb >> 1, s = vb & 1, k = i - 4; const int qb = s ? ((k == 0) ? 6 : (k == 1) ? 5 : (k == 2) ? 2 : 1) : ((k == 0) ? 7 : (k == 1) ? 4 : (k == 2) ? 3 : 0);
            const int key = 8 + (pair & 7); diff_unit(p, pair >> 3, pair & 7, qb, lds, ew_it, key != tabkey); tabkey = key; }
        __syncthreads();
    }
}

template <bool DUMMY> __device__ void f_route(const P& p, int bid, int nb, float* sm, int* lctl) {
    const int tid = ltid(), wave = tid >> 6, lane = tid & 63, fr = lane & 15, fq = lane >> 4;
    const bf16_t* RH = (const bf16_t*)(p.ws + OFF_RW_HI); const bf16_t* RL = (const bf16_t*)(p.ws + OFF_RW_LO);
    const bf16_t* HBr = (const bf16_t*)(p.ws + OFF_HB);
    unsigned* cnt = (unsigned*)(p.ws + OFF_CTL) + CTL_CNT + (DUMMY ? 64 : 0);
    int* list = (int*)(p.ws + (DUMMY ? OFF_ATT + 32 * MiB : OFF_LIST)); float* slr = (float*)(p.ws + (DUMMY ? OFF_ATT + 36 * MiB : OFF_SLR));
    unsigned* tok_ep = (unsigned*)(p.ws + (DUMMY ? OFF_ATT + 40 * MiB : OFF_TOK_EP)); float* tok_w = (float*)(p.ws + (DUMMY ? OFF_ATT + 41 * MiB : OFF_TOK_W));
    float* lgs = sm + 24576 + wave * 800;
    int* lcnt = lctl + LC_LCNT; int* gbase = lctl + LC_GBASE;
    for (int t0 = bid * 128; t0 < T_TOK; t0 += nb * 128) {
        if (tid < 32) lcnt[tid] = 0;
        const int tok0 = t0 + wave * 16;
        f32x4_t acc[3]; acc[0] = (f32x4_t){0.f, 0.f, 0.f, 0.f}; acc[1] = acc[0]; acc[2] = acc[0];
        float ss = 0.f;
        const bf16_t* hrow = HBr + (size_t)(tok0 + fr) * D_MODEL + 8 * fq;
        LASP unsigned char* rb = (LASP unsigned char*)sm;
#define RT_DMA(c, boff) do { _Pragma("unroll") for (int q_ = 0; q_ < 6; ++q_) { const int idx_ = wave + 8 * q_, hl_ = idx_ / 24, rem_ = idx_ % 24, ks_ = rem_ / 3, nt_ = rem_ % 3; \
            const bf16_t* src_ = (hl_ ? RL : RH) + (size_t)(nt_ * 16 + (lane >> 2)) * D_MODEL + (c) * 256 + 32 * ks_ + 8 * (lane & 3); \
            __builtin_amdgcn_global_load_lds((const unsigned*)src_, (LASP unsigned*)(rb + (boff) + idx_ * 1024), 16, 0, 0); } } while (0)
#define RT_LDA(S, c) do { _Pragma("unroll") for (int k_ = 0; k_ < 8; ++k_) S[k_] = *(const u32x4_t*)(hrow + (c) * 256 + k_ * 32); } while (0)
#define RT_COMP(S, boff) do { _Pragma("unroll") for (int k_ = 0; k_ < 8; ++k_) { const u32x4_t wh = S[k_]; \
            _Pragma("unroll") for (int j = 0; j < 4; ++j) { const float v0 = __uint_as_float(wh[j] << 16), v1 = __uint_as_float(wh[j] & 0xffff0000u); ss = fmaf(v0, v0, ss); ss = fmaf(v1, v1, ss); } \
            const bf16x8_t ahi = __builtin_bit_cast(bf16x8_t, wh); \
            _Pragma("unroll") for (int n = 0; n < 3; ++n) { const bf16x8_t bh_ = *(const LASP bf16x8_t*)(rb + (boff) + (k_ * 3 + n) * 1024 + (fr * 4 + fq) * 16), bl_ = *(const LASP bf16x8_t*)(rb + (boff) + 24576 + (k_ * 3 + n) * 1024 + (fr * 4 + fq) * 16); \
                acc[n] = __builtin_amdgcn_mfma_f32_16x16x32_bf16(ahi, bh_, acc[n], 0, 0, 0); acc[n] = __builtin_amdgcn_mfma_f32_16x16x32_bf16(ahi, bl_, acc[n], 0, 0, 0); } } } while (0)
#define RT_BAR(N) asm volatile("s_waitcnt vmcnt(" #N ") lgkmcnt(0)\n\ts_barrier" ::: "memory")
        u32x4_t A0[8], A1[8];
        RT_DMA(0, 0); RT_LDA(A0, 0);
        RT_DMA(1, 49152); RT_LDA(A1, 1);
        RT_BAR(14);
        RT_COMP(A0, 0);
        RT_BAR(0);
        RT_DMA(2, 0); RT_LDA(A0, 2);
        RT_COMP(A1, 49152);
        RT_BAR(0);
        RT_DMA(3, 49152); RT_LDA(A1, 3);
        RT_COMP(A0, 0);
        RT_BAR(0);
        RT_COMP(A1, 49152);
        RT_BAR(0);
#undef RT_DMA
#undef RT_LDA
#undef RT_COMP
#undef RT_BAR
        ss = pl32_sum(pl16_sum(ss));
        const float rs = 1.0f / sqrtf(ss * (1.0f / D_MODEL) + EPS);
#pragma unroll
        for (int n = 0; n < 3; ++n)
#pragma unroll
            for (int i = 0; i < 4; ++i) lgs[(4 * fq + i) * 48 + n * 16 + fr] = acc[n][i];
        if (fq == 0) lgs[768 + fr] = rs;
        __syncthreads();
        int e_[2] = {0, 0}; int rk[2] = {0, 0}; float w_[2] = {0.f, 0.f}; float myrs = 0.f;
        if (lane < 16) {
            const float* l = lgs + lane * 48; myrs = lgs[768 + lane];
            float g[4]; int gi = 0;
#pragma unroll
            for (int i = 0; i < 4; ++i) g[i] = l[i] * myrs + p.bg[i];
            float mx = g[0];
#pragma unroll
            for (int i = 1; i < 4; ++i) if (g[i] > mx) { mx = g[i]; gi = i; }
            float den = 0.f;
#pragma unroll
            for (int i = 0; i < 4; ++i) den += expf(g[i] - mx);
            const float gprob = 1.0f / den;
            float el[8];
#pragma unroll
            for (int i = 0; i < 8; ++i) el[i] = l[4 + gi * 8 + i] * myrs + p.be[gi * 8 + i];
            float emx = el[0]; int e0 = 0;
#pragma unroll
            for (int i = 1; i < 8; ++i) if (el[i] > emx) { emx = el[i]; e0 = i; }
            float e2 = -INFINITY; int e1 = 0;
#pragma unroll
            for (int i = 0; i < 8; ++i) if (i != e0 && el[i] > e2) { e2 = el[i]; e1 = i; }
            float eden = 0.f;
#pragma unroll
            for (int i = 0; i < 8; ++i) eden += expf(el[i] - emx);
            const float pa = 1.0f / eden, pb = expf(e2 - emx) / eden;
            e_[0] = gi * 8 + e0; e_[1] = gi * 8 + e1; w_[0] = gprob * pa / (pa + pb); w_[1] = gprob * pb / (pa + pb);
            rk[0] = atomicAdd(&lcnt[e_[0]], 1); rk[1] = atomicAdd(&lcnt[e_[1]], 1);
        }
        __syncthreads();
        if (tid < 32) gbase[tid] = lcnt[tid] ? (int)atomicAdd(&cnt[tid], (unsigned)lcnt[tid]) : 0;
        __syncthreads();
        if (lane < 16) { const int tok = tok0 + lane;
#pragma unroll
            for (int k = 0; k < 2; ++k) { const int pos = gbase[e_[k]] + rk[k]; list[(size_t)e_[k] * T_TOK + pos] = tok; slr[(size_t)e_[k] * T_TOK + pos] = myrs;
                tok_ep[tok * 2 + k] = ((unsigned)e_[k] << 16) | (unsigned)pos; tok_w[tok * 2 + k] = w_[k]; } }
        __syncthreads();
    }
}
__device__ void f_moe_tables(const P& p, int* lctl) {
    const int tid = ltid();
    const unsigned* cnt = (const unsigned*)(p.ws + OFF_CTL) + CTL_CNT;
    if (tid < 32) lctl[LC_NCNT + tid] = (int)cnt[tid];
    __syncthreads();
    if (tid < 32) {
        int base = 0; for (int e = 0; e < tid; ++e) base += (lctl[LC_NCNT + e] + 255) >> 8;
        const int nt_ = (lctl[LC_NCNT + tid] + 255) >> 8;
        lctl[LC_TBASE + tid] = base; if (tid == 31) lctl[LC_TBASE + 32] = base + nt_;
        for (int i = 0; i < nt_; ++i) lctl[LC_TILE_E + base + i] = tid; }
    __syncthreads();
}
__device__ void f_final(const P& p, int bid, int nb, const int* lctl) {
    const int tid = ltid(), wave = tid >> 6, lane = tid & 63;
    const bf16_t* HBp = (const bf16_t*)(p.ws + OFF_HB); const bf16_t* YC = (const bf16_t*)(p.ws + OFF_YC);
    const unsigned* tok_ep = (const unsigned*)(p.ws + OFF_TOK_EP); const float* tok_w = (const float*)(p.ws + OFF_TOK_W);
    float4 gf[4];
#pragma unroll
    for (int j = 0; j < 4; ++j) gf[j] = *((const float4*)p.ln_final + lane + 64 * j);
    for (int tok = bid * 8 + wave; tok < T_TOK; tok += nb * 8) {
        const unsigned ep0 = tok_ep[tok * 2], ep1 = tok_ep[tok * 2 + 1]; const float w0 = tok_w[tok * 2], w1 = tok_w[tok * 2 + 1];
        const size_t s0 = (size_t)lctl[LC_TBASE + (ep0 >> 16)] * 256 + (ep0 & 0xffffu), s1 = (size_t)lctl[LC_TBASE + (ep1 >> 16)] * 256 + (ep1 & 0xffffu);
        const uint2* hr = (const uint2*)(HBp + (size_t)tok * D_MODEL) + lane; const uint2* y0 = (const uint2*)(YC + s0 * D_MODEL) + lane; const uint2* y1 = (const uint2*)(YC + s1 * D_MODEL) + lane;
        float4 z[4]; float ss = 0.f;
#pragma unroll
        for (int j = 0; j < 4; ++j) { const unsigned long long hh_ = __builtin_nontemporal_load((const unsigned long long*)(hr + 64 * j)), a_ = __builtin_nontemporal_load((const unsigned long long*)(y0 + 64 * j)), b_ = __builtin_nontemporal_load((const unsigned long long*)(y1 + 64 * j));
            const uint2 hh = make_uint2((unsigned)hh_, (unsigned)(hh_ >> 32)), a = make_uint2((unsigned)a_, (unsigned)(a_ >> 32)), b = make_uint2((unsigned)b_, (unsigned)(b_ >> 32));
            z[j].x = __uint_as_float(hh.x << 16) + w0 * __uint_as_float(a.x << 16) + w1 * __uint_as_float(b.x << 16);
            z[j].y = __uint_as_float(hh.x & 0xffff0000u) + w0 * __uint_as_float(a.x & 0xffff0000u) + w1 * __uint_as_float(b.x & 0xffff0000u);
            z[j].z = __uint_as_float(hh.y << 16) + w0 * __uint_as_float(a.y << 16) + w1 * __uint_as_float(b.y << 16);
            z[j].w = __uint_as_float(hh.y & 0xffff0000u) + w0 * __uint_as_float(a.y & 0xffff0000u) + w1 * __uint_as_float(b.y & 0xffff0000u);
            ss += (z[j].x * z[j].x + z[j].y * z[j].y) + (z[j].z * z[j].z + z[j].w * z[j].w); }
        const float rs = 1.0f / sqrtf(wave_sum(ss) * (1.0f / D_MODEL) + EPS);
        float4* o = (float4*)(p.out + (size_t)tok * D_MODEL) + lane;
#pragma unroll
        for (int j = 0; j < 4; ++j) o[64 * j] = make_float4(z[j].x * rs * gf[j].x, z[j].y * rs * gf[j].y, z[j].z * rs * gf[j].z, z[j].w * rs * gf[j].w);
    }
}

#define XB_TMO      128
#define XB_XCNT(j)  (256  + 64 * (j))
#define XB_XSUB(j)  (1280 + 64 * (j))
#define XB_XGEN(j)  (2304 + 64 * (j))
#define XB_TOP      3328
#define XB_TOPGEN   3392
#define XCD_BAR_WORDS 3456
#define XB_SPIN_CAP (1u << 26)
#define LAS __attribute__((address_space(3)))

__device__ __forceinline__ unsigned xb_ld(unsigned* p)              { return __hip_atomic_load(p, __ATOMIC_RELAXED, __HIP_MEMORY_SCOPE_AGENT); }
__device__ __forceinline__ unsigned xb_add(unsigned* p, unsigned v) { return __hip_atomic_fetch_add(p, v, __ATOMIC_RELAXED, __HIP_MEMORY_SCOPE_AGENT); }
__device__ __forceinline__ unsigned xb_xcc_id() { return (unsigned)__builtin_amdgcn_s_getreg((3 << 11) | 20) & 0xFu; }
#define XB_SPIN(cond, bar) do { unsigned _sp = 0; while (cond) { __builtin_amdgcn_s_sleep(1); \
    if ((++_sp & 255u) == 0u) { if (xb_ld(&(bar)[XB_TMO])) break; if (_sp > XB_SPIN_CAP) { atomicAdd(&(bar)[XB_TMO], 1u); break; } } } } while (0)

struct XcdBarrier {
    unsigned* bar; unsigned x;
    volatile LAS unsigned* st;
};

__device__ __forceinline__ XcdBarrier xcd_barrier_post(unsigned* bar, volatile LAS unsigned* st) {
    XcdBarrier b; b.bar = bar; b.x = xb_xcc_id(); b.st = st;
    if (threadIdx.x == 0) (void)xb_add(&bar[XB_XCNT(b.x)], 1u);
    return b;
}
__device__ __forceinline__ void xcd_barrier_complete(unsigned* bar, unsigned x, unsigned& nloc, unsigned& nx) {
    const unsigned G = gridDim.x * gridDim.y * gridDim.z;
    unsigned sum, cnt, mine, sp = 0u;
    for (;;) {
        sum = 0u; cnt = 0u; mine = 0u;
#pragma unroll
        for (unsigned j = 0; j < 16; ++j) { const unsigned c = xb_ld(&bar[XB_XCNT(j)]); sum += c; cnt += (c > 0u) ? 1u : 0u; mine = (j == x) ? c : mine; }
        if (sum == G) break;
        __builtin_amdgcn_s_sleep(1);
        if ((++sp & 255u) == 0u) { if (xb_ld(&bar[XB_TMO])) break; if (sp > XB_SPIN_CAP) { atomicAdd(&bar[XB_TMO], 1u); break; } }
    }
    nloc = mine > 0u ? mine : 1u; nx = cnt > 0u ? cnt : 1u;
}

__device__ __forceinline__ void xcd_barrier(const XcdBarrier& b) {
    asm volatile("s_waitcnt vmcnt(0)" ::: "memory");
    __syncthreads();
    if (threadIdx.x == 0) {
        unsigned* bar = b.bar;
        __builtin_amdgcn_s_waitcnt(0);
        unsigned nloc = b.st[0], nx = b.st[1];
        if (nloc == 0u) { xcd_barrier_complete(bar, b.x, nloc, nx); b.st[0] = nloc; b.st[1] = nx; }
        const unsigned old = xb_add(&bar[XB_XSUB(b.x)], 1u);
        const unsigned gen = old / nloc;
        if (old + 1u == (gen + 1u) * nloc) {
            __builtin_amdgcn_fence(__ATOMIC_RELEASE, "agent");
            asm volatile("s_waitcnt vmcnt(0)" ::: "memory");
            const unsigned og = xb_add(&bar[XB_TOP], 1u);
            const unsigned tg = og / nx;
            if (og + 1u == (tg + 1u) * nx) xb_add(&bar[XB_TOPGEN], 1u);
            else XB_SPIN(xb_ld(&bar[XB_TOPGEN]) == tg, bar);
            __builtin_amdgcn_fence(__ATOMIC_ACQUIRE, "agent");
            xb_add(&bar[XB_XGEN(b.x)], 1u);
            asm volatile("s_waitcnt vmcnt(0)" ::: "memory");
        } else {
            XB_SPIN(xb_ld(&bar[XB_XGEN(b.x)]) == gen, bar);
            __builtin_amdgcn_fence(__ATOMIC_ACQUIRE, "agent");
            asm volatile("s_waitcnt vmcnt(0)" ::: "memory");
        }
    }
    __syncthreads();
}


extern __shared__ __attribute__((aligned(16))) unsigned char dyn_smem[];
__global__ void __launch_bounds__(NT, 2) k_mega(P p) {
    float* sm = (float*)dyn_smem;
    LASP unsigned char* ring = (LASP unsigned char*)dyn_smem;
    const int bid = blockIdx.x, nb = gridDim.x;
    int* lctl = (int*)(dyn_smem + LDS_CTL_OFF);
    for (int i = threadIdx.x; i < 1024; i += NT) lctl[i] = 0;
    __syncthreads();
    XcdBarrier bar = xcd_barrier_post((unsigned*)(p.ws + OFF_CTL), (volatile LAS unsigned*)(dyn_smem + LDS_CTL_OFF));
    f_prologue(p, bid, nb, sm);
    xcd_barrier(bar);
    { pg8::Gemm g{(const bf16_t*)(p.ws + OFF_XN), (const bf16_t*)(p.ws + OFF_WIN_T), T_TOK, LDU, D_MODEL}; pg8::StaticOrder S; S.init(T_TOK, LDU, nb, bid);
      pg8::EpiBf16LeanT<1> E{(bf16_t*)(p.ws + OFF_U), LDU, 0xffff};
      pg8::gemm_phase<pg8::EpiBf16LeanT<1>, pg8::StaticOrder, true, true>(ring, g, S, E); }
    xcd_barrier(bar);
    f_cmp(p, bid, nb, ring);
    xcd_barrier(bar);
    f_attn(p, bid, nb, ring);
    xcd_barrier(bar);
    { pg8::Gemm g{(const bf16_t*)(p.ws + OFF_ATT), (const bf16_t*)(p.ws + OFF_WOUT_T), T_TOK, D_MODEL, D_MODEL}; pg8::StaticOrder S; S.init(T_TOK, D_MODEL, nb, bid);
      pg8::EpiResF32 E{p.x, (bf16_t*)(p.ws + OFF_HB), D_MODEL};
      pg8::gemm_phase<pg8::EpiResF32, pg8::StaticOrder, true, true>(ring, g, S, E); }
    xcd_barrier(bar);
    f_route<false>(p, bid, nb, sm, lctl);
    xcd_barrier(bar);
    f_moe_tables(p, lctl);
    const int xq_ = bid % 8, yq_ = bid / 8, Yq_ = nb / 8;
    const int vcu = (nb % 8 == 0) ? ((Yq_ >= 4) ? (yq_ < 4 ? xq_ * 4 + yq_ : 32 + xq_ * (Yq_ - 4) + (yq_ - 4)) : xq_ * Yq_ + yq_) : bid;
    const pg8::MoeTab tb{(const LASP int*)lctl + LC_NCNT, (const LASP int*)lctl + LC_TBASE, (const LASP int*)lctl + LC_TILE_E};
    { pg8::Gemm g{(const bf16_t*)(p.ws + OFF_HB), (const bf16_t*)(p.ws + OFF_W13_T), 0, 512, D_MODEL};
      pg8::MoeOrderP S{{tb, 1, lctl[LC_TBASE + 32], nb, vcu, (const int*)(p.ws + OFF_LIST), (unsigned)(D_MODEL * 2)}, (unsigned*)(p.ws + OFF_CTL + CTL_PANEL)};
      pg8::EpiSwiglu E{(bf16_t*)(p.ws + OFF_HG), (const float*)(p.ws + OFF_SLR), tb, ring};
      pg8::gemm_phase_g<pg8::EpiSwiglu, pg8::MoeOrderP, true, true>(ring, g, S, E); }
    __syncthreads();
    { pg8::Gemm g{(const bf16_t*)(p.ws + OFF_HG), (const bf16_t*)(p.ws + OFF_WD_T), 0, D_MODEL, EXP_FF};
      const int ntot = lctl[LC_TBASE + 32];
      pg8::MoeOrderC S{{tb, 2, ntot, nb, vcu, nullptr, 0u}, (const unsigned*)(p.ws + OFF_CTL + CTL_PANEL), 16u, (2 * ntot) % nb, 4};
      pg8::EpiBf16Lean E{(bf16_t*)(p.ws + OFF_YC), D_MODEL, 3};
      pg8::gemm_phase<pg8::EpiBf16Lean, pg8::MoeOrderC, true, true>(ring, g, S, E); }
    xcd_barrier(bar);
    f_final(p, bid, nb, lctl);
}

extern "C" void kernel_launch(void* const* d_in, const int* in_sizes, int n_in, void* d_out, int out_size, void* d_ws, size_t ws_size, hipStream_t stream) {
    if (ws_size < WS_NEED) { fprintf(stderr, "kernel_launch: workspace too small (%zu < %zu)\n", ws_size, WS_NEED); return; }
    P p{};
    const float** f = (const float**)&p;
    for (int i = 0; i < 25; ++i) f[i] = (const float*)d_in[i];
    p.out = (float*)d_out; p.ws = (unsigned char*)d_ws;
    static int grid = 0;
    if (!grid) {
        int dev = 0, cus = 0, per_cu = 0;
        (void)hipGetDevice(&dev);
        (void)hipDeviceGetAttribute(&cus, hipDeviceAttributeMultiprocessorCount, dev);
        if (hipFuncSetAttribute((const void*)k_mega, hipFuncAttributeMaxDynamicSharedMemorySize, LDS_TOTAL) != hipSuccess) { fprintf(stderr, "kernel_launch: hipFuncSetAttribute failed\n"); grid = -1; return; }
        (void)hipOccupancyMaxActiveBlocksPerMultiprocessor(&per_cu, (const void*)k_mega, NT, LDS_TOTAL);
        if (per_cu < 1) fprintf(stderr, "kernel_launch: occupancy query reports %d blocks per CU\n", per_cu);
        grid = cus;
    }
    if (grid < 0) return;
    (void)hipMemsetAsync(p.ws + OFF_CTL, 0, 64 * 1024 + 320 * 256, stream);
    hipLaunchKernelGGL(k_mega, dim3(grid), dim3(NT), LDS_TOTAL, stream, p);
}
```
